# Optimizing an MI355X kernel written in HIP

```python
import jax
import jax.numpy as jnp
from jax import lax
import numpy as np

D_MODEL = 1024
BATCH = 4
SEQ = 4096
DEPTH = 4

D_MIX = D_MODEL
ML_WIDTH = D_MIX // 2
ML_HEADS = 4
ML_HEAD_DIM = ML_WIDTH // ML_HEADS
RG_WIDTH = D_MIX - ML_WIDTH
RG_BLOCKS = 8
RG_BLOCK_DIM = RG_WIDTH // RG_BLOCKS
RG_C = 8.0
CONV_WIDTH = 4
CHUNK = 128
D_IN = 4 * ML_WIDTH + 2 * ML_HEADS + 2 * RG_WIDTH
D_FF_DENSE = ((8 * D_MODEL // 3 + 127) // 128) * 128
N_EXPERTS = 8
TOP_K = 2
D_FF_EXPERT = 7 * D_MODEL // 2
N_DENSE = (DEPTH + 1) // 2
N_MOE = DEPTH // 2
EPS = 1e-6

kernel_name = 'hybrid_mlstm_rglru_moe'


def _rms(x):
    x = x.astype(jnp.float32)
    return x * lax.rsqrt(jnp.mean(x * x, axis=-1, keepdims=True) + EPS)


def rmsnorm(x, g):
    return (_rms(x) * g.astype(jnp.float32)).astype(x.dtype)


def mlstm_chunkwise(q, k, v, i_pre, f_pre):
    B, S, H, Dh = q.shape
    L = CHUNK
    NC = S // L

    def chunks(t):
        t = t.astype(jnp.float32).reshape((B, NC, L, H) + t.shape[3:])
        return jnp.moveaxis(t, 3, 1)

    q = chunks(q)
    k = chunks(k) * (Dh ** -0.5)
    v = chunks(v)
    log_i = chunks(i_pre)
    log_f = jax.nn.log_sigmoid(chunks(f_pre))
    b = jnp.cumsum(log_f, axis=-1)
    g = b[..., -1]

    a = g[..., None] - b + log_i
    m_loc = jnp.max(a, axis=-1)
    w = jnp.exp(a - m_loc[..., None])
    C_loc = jnp.einsum('bhcl,bhcld,bhcle->bhcde', w, k, v)
    n_loc = jnp.einsum('bhcl,bhcld->bhcd', w, k)

    def step(carry, xs):
        C, n, m = carry
        g_c, m_l, C_l, n_l = xs
        m_new = jnp.maximum(g_c + m, m_l)
        s_old = jnp.exp(g_c + m - m_new)
        s_loc = jnp.exp(m_l - m_new)
        C_new = s_old[..., None, None] * C + s_loc[..., None, None] * C_l
        n_new = s_old[..., None] * n + s_loc[..., None] * n_l
        return (C_new, n_new, m_new), (C, n, m)

    init = (jnp.zeros((B, H, Dh, Dh), jnp.float32),
            jnp.zeros((B, H, Dh), jnp.float32),
            jnp.zeros((B, H), jnp.float32))
    xs = (jnp.moveaxis(g, 2, 0), jnp.moveaxis(m_loc, 2, 0),
          jnp.moveaxis(C_loc, 2, 0), jnp.moveaxis(n_loc, 2, 0))
    _, (C_prev, n_prev, m_prev) = lax.scan(step, init, xs)
    C_prev = jnp.moveaxis(C_prev, 0, 2)
    n_prev = jnp.moveaxis(n_prev, 0, 2)
    m_prev = jnp.moveaxis(m_prev, 0, 2)

    causal = jnp.tril(jnp.ones((L, L), dtype=bool))
    d_log = b[..., :, None] - b[..., None, :] + log_i[..., None, :]
    d_log = jnp.where(causal, d_log, -jnp.inf)
    m_inter = b + m_prev[..., None]
    m_comb = jnp.maximum(m_inter, jnp.max(d_log, axis=-1))
    s_w = jnp.exp(d_log - m_comb[..., None]) * jnp.einsum('bhcld,bhcsd->bhcls', q, k)
    inter_scale = jnp.exp(m_inter - m_comb)
    num = (jnp.einsum('bhcls,bhcse->bhcle', s_w, v)
           + inter_scale[..., None] * jnp.einsum('bhcld,bhcde->bhcle', q, C_prev))
    den = jnp.sum(s_w, axis=-1) + inter_scale * jnp.einsum('bhcld,bhcd->bhcl', q, n_prev)
    h = num / jnp.maximum(jnp.abs(den), jnp.exp(-m_comb))[..., None]
    return jnp.moveaxis(h, 1, 3).reshape(B, S, H, Dh)


def causal_depthwise_conv(x, w, bias):
    K, C = w.shape
    y = lax.conv_general_dilated(x, w[:, None, :], window_strides=(1,),
                                 padding=[(K - 1, 0)],
                                 dimension_numbers=('NWC', 'WIO', 'NWC'),
                                 feature_group_count=C)
    return y + bias


def rg_lru(x, w_a, b_a, w_x, b_x, lam):
    B, S, _ = x.shape
    xf = x.astype(jnp.float32)
    xb = xf.reshape(B, S, RG_BLOCKS, RG_BLOCK_DIM)
    r = jax.nn.sigmoid(jnp.einsum('bsgi,gij->bsgj', xb, w_a.astype(jnp.float32)).reshape(B, S, RG_WIDTH)
                       + b_a.astype(jnp.float32))
    i = jax.nn.sigmoid(jnp.einsum('bsgi,gij->bsgj', xb, w_x.astype(jnp.float32)).reshape(B, S, RG_WIDTH)
                       + b_x.astype(jnp.float32))
    log_a = -RG_C * r * jax.nn.softplus(-lam.astype(jnp.float32))
    a = jnp.exp(log_a)
    u = jnp.sqrt(-jnp.expm1(2.0 * log_a)) * (i * xf)

    def combine(left, right):
        a1, b1 = left
        a2, b2 = right
        return a1 * a2, a2 * b1 + b2

    _, h = lax.associative_scan(combine, (a, u), axis=1)
    return h


def hybrid_mixer(h, w_in, ml_b_if, ml_norm_g, rg_conv_w, rg_conv_b, rg_w_a, rg_b_a,
                 rg_w_x, rg_b_x, rg_lam, rg_norm_g, w_out):
    B, S, _ = h.shape
    z = h @ w_in
    o0 = 0
    q = z[..., o0:o0 + ML_WIDTH]; o0 += ML_WIDTH
    k = z[..., o0:o0 + ML_WIDTH]; o0 += ML_WIDTH
    v = z[..., o0:o0 + ML_WIDTH]; o0 += ML_WIDTH
    o = z[..., o0:o0 + ML_WIDTH]; o0 += ML_WIDTH
    if_pre = z[..., o0:o0 + 2 * ML_HEADS].astype(jnp.float32) + ml_b_if.astype(jnp.float32); o0 += 2 * ML_HEADS
    rx = z[..., o0:o0 + RG_WIDTH]; o0 += RG_WIDTH
    rgate = z[..., o0:o0 + RG_WIDTH]

    shp = (B, S, ML_HEADS, ML_HEAD_DIM)
    ht = mlstm_chunkwise(q.reshape(shp), k.reshape(shp), v.reshape(shp),
                         if_pre[..., :ML_HEADS], if_pre[..., ML_HEADS:])
    ht = _rms(ht) * ml_norm_g.astype(jnp.float32).reshape(ML_HEADS, ML_HEAD_DIM)
    y_ml = jax.nn.sigmoid(o.astype(jnp.float32)) * ht.reshape(B, S, ML_WIDTH)

    xc = causal_depthwise_conv(rx, rg_conv_w, rg_conv_b)
    hr = rg_lru(xc, rg_w_a, rg_b_a, rg_w_x, rg_b_x, rg_lam)
    y_rg = hr * jax.nn.gelu(rgate.astype(jnp.float32), approximate=True)
    y_rg = _rms(y_rg) * rg_norm_g.astype(jnp.float32)

    y = jnp.concatenate([y_ml, y_rg], axis=-1).astype(h.dtype)
    return y @ w_out


def swiglu(x, w_gate, w_up, w_down):
    return (jax.nn.silu(x @ w_gate) * (x @ w_up)) @ w_down


def moe_swiglu(x, w_router, w_gate, w_up, w_down):
    B, S, D = x.shape
    t = x.reshape(B * S, D)
    logits = (t @ w_router).astype(jnp.float32)
    top_val, top_idx = lax.top_k(logits, TOP_K)
    top_w = jax.nn.softmax(top_val, axis=-1)
    gates = jnp.sum(jax.nn.one_hot(top_idx, N_EXPERTS, dtype=jnp.float32) * top_w[..., None], axis=1)
    out = jnp.zeros((B * S, D), jnp.float32)
    for e in range(N_EXPERTS):
        out = out + gates[:, e:e + 1] * swiglu(t, w_gate[e], w_up[e], w_down[e]).astype(jnp.float32)
    return out.astype(x.dtype).reshape(B, S, D)


def setup_inputs(seed: int = 0) -> dict:
    key = jax.random.key(seed)
    ks = jax.random.split(key, 32)

    def nrm(k, shape, scale):
        return scale * jax.random.normal(k, shape, jnp.float32)

    def gain(k, shape):
        return 1.0 + 0.02 * jax.random.normal(k, shape, jnp.float32)

    f_bias = jnp.linspace(3.0, 6.0, ML_HEADS, dtype=jnp.float32)
    ml_b_if = jnp.concatenate([nrm(ks[3], (DEPTH, ML_HEADS), 0.1),
                               f_bias + nrm(ks[4], (DEPTH, ML_HEADS), 0.1)], axis=-1)
    u = jax.random.uniform(ks[10], (DEPTH, RG_WIDTH), jnp.float32, 0.9, 0.999)
    a0 = u ** (1.0 / RG_C)
    rg_lam = jnp.log(a0) - jnp.log1p(-a0)
    return {
        'x': nrm(ks[0], (BATCH, SEQ, D_MODEL), 1.0),
        'norm_mix_g': gain(ks[1], (DEPTH, D_MODEL)),
        'w_in': nrm(ks[2], (DEPTH, D_MODEL, D_IN), D_MODEL ** -0.5),
        'ml_b_if': ml_b_if,
        'ml_norm_g': gain(ks[5], (DEPTH, ML_WIDTH)),
        'rg_conv_w': nrm(ks[6], (DEPTH, CONV_WIDTH, RG_WIDTH), CONV_WIDTH ** -0.5),
        'rg_conv_b': nrm(ks[7], (DEPTH, RG_WIDTH), 0.01),
        'rg_w_a': nrm(ks[8], (DEPTH, RG_BLOCKS, RG_BLOCK_DIM, RG_BLOCK_DIM), RG_BLOCK_DIM ** -0.5),
        'rg_b_a': nrm(ks[9], (DEPTH, RG_WIDTH), 0.01),
        'rg_w_x': nrm(ks[11], (DEPTH, RG_BLOCKS, RG_BLOCK_DIM, RG_BLOCK_DIM), RG_BLOCK_DIM ** -0.5),
        'rg_b_x': nrm(ks[12], (DEPTH, RG_WIDTH), 0.01),
        'rg_lam': rg_lam,
        'rg_norm_g': gain(ks[13], (DEPTH, RG_WIDTH)),
        'w_out': nrm(ks[14], (DEPTH, D_MIX, D_MODEL), D_MIX ** -0.5),
        'norm_ffn_g': gain(ks[15], (DEPTH, D_MODEL)),
        'ffn_w_gate': nrm(ks[16], (N_DENSE, D_MODEL, D_FF_DENSE), D_MODEL ** -0.5),
        'ffn_w_up': nrm(ks[17], (N_DENSE, D_MODEL, D_FF_DENSE), D_MODEL ** -0.5),
        'ffn_w_down': nrm(ks[18], (N_DENSE, D_FF_DENSE, D_MODEL), D_FF_DENSE ** -0.5),
        'moe_w_router': nrm(ks[19], (N_MOE, D_MODEL, N_EXPERTS), D_MODEL ** -0.5),
        'moe_w_gate': nrm(ks[20], (N_MOE, N_EXPERTS, D_MODEL, D_FF_EXPERT), D_MODEL ** -0.5),
        'moe_w_up': nrm(ks[21], (N_MOE, N_EXPERTS, D_MODEL, D_FF_EXPERT), D_MODEL ** -0.5),
        'moe_w_down': nrm(ks[22], (N_MOE, N_EXPERTS, D_FF_EXPERT, D_MODEL), D_FF_EXPERT ** -0.5),
        'norm_final_g': gain(ks[23], (D_MODEL,)),
    }


def reference(x, norm_mix_g, w_in, ml_b_if, ml_norm_g, rg_conv_w, rg_conv_b, rg_w_a, rg_b_a,
              rg_w_x, rg_b_x, rg_lam, rg_norm_g, w_out, norm_ffn_g, ffn_w_gate, ffn_w_up,
              ffn_w_down, moe_w_router, moe_w_gate, moe_w_up, moe_w_down, norm_final_g):
    h = x
    for l in range(DEPTH):
        h = h + hybrid_mixer(rmsnorm(h, norm_mix_g[l]), w_in[l], ml_b_if[l], ml_norm_g[l],
                             rg_conv_w[l], rg_conv_b[l], rg_w_a[l], rg_b_a[l], rg_w_x[l],
                             rg_b_x[l], rg_lam[l], rg_norm_g[l], w_out[l])
        u = rmsnorm(h, norm_ffn_g[l])
        j = l // 2
        if l % 2 == 0:
            h = h + swiglu(u, ffn_w_gate[j], ffn_w_up[j], ffn_w_down[j])
        else:
            h = h + moe_swiglu(u, moe_w_router[j], moe_w_gate[j], moe_w_up[j], moe_w_down[j])
    return rmsnorm(h, norm_final_g)
```

```cpp
#include <hip/hip_runtime.h>
#include <cstdio>
#include <cstdint>

constexpr int D = 1024, BATCH = 4, SEQ = 4096, T = BATCH * SEQ, DEPTH = 4;
constexpr int MLW = 512, MLH = 4, DH = 128, RGW = 512, RGB = 8, RGD = 64;
constexpr int DIN = 3080, FFD = 2816, NE = 8, FFE = 3584;
constexpr int ZQ = 0, ZK = 512, ZV = 1024, ZO = 1536, ZI = 2048, ZF = 2052, ZRX = 2056, ZRG = 2568;
constexpr float EPS = 1e-6f;
constexpr int MAXROWS = 2 * T + NE * 256;
constexpr int MAXT256 = MAXROWS / 256;

__device__ __forceinline__ float wave_sum(float v) {
#pragma unroll
    for (int o = 1; o < 64; o <<= 1) v += __shfl_xor(v, o);
    return v;
}
__device__ __forceinline__ float sigmoidf_(float x) { return 1.f / (1.f + __expf(-x)); }
__device__ __forceinline__ float gelu_tanh(float x) { const float u = 0.7978845608028654f * (x + 0.044715f * x * x * x); return 0.5f * x * (1.f + tanhf(u)); }

namespace nv {
__global__ __launch_bounds__(256) void rmsnorm(const float* __restrict__ x, const float* __restrict__ g, float* __restrict__ y, int rows) {
    const int row = blockIdx.x * 4 + (threadIdx.x >> 6), lane = threadIdx.x & 63;
    if (row >= rows) return;
    const float4* xr = (const float4*)(x + (size_t)row * D); const float4* gr = (const float4*)g; float4* yr = (float4*)(y + (size_t)row * D);
    float4 v[4]; float s = 0.f;
#pragma unroll
    for (int j = 0; j < 4; ++j) { v[j] = xr[lane + 64 * j]; s += v[j].x * v[j].x + v[j].y * v[j].y + v[j].z * v[j].z + v[j].w * v[j].w; }
    const float r = rsqrtf(wave_sum(s) * (1.f / D) + EPS);
#pragma unroll
    for (int j = 0; j < 4; ++j) { const float4 gg = gr[lane + 64 * j]; float4 o; o.x = v[j].x * r * gg.x; o.y = v[j].y * r * gg.y; o.z = v[j].z * r * gg.z; o.w = v[j].w * r * gg.w; yr[lane + 64 * j] = o; }
}

template <int MODE>
__global__ __launch_bounds__(256) void gemm(const float* __restrict__ A, int lda, const int* __restrict__ rowmap, const float* __restrict__ B, const float* __restrict__ B2, int ldb,
                                            size_t strideB, const int* __restrict__ texp, const int* __restrict__ ntile_p, float* __restrict__ C, int ldc, int N, int K) {
    __shared__ float As[16][68]; __shared__ float Bs[16][64]; __shared__ float Bs2[MODE == 2 ? 16 : 1][64];
    const int tm = blockIdx.y, tn = blockIdx.x, tid = threadIdx.x, tx = tid & 15, ty = tid >> 4;
    if (ntile_p && tm >= *ntile_p) return;
    const int e = texp ? texp[tm] : 0; B += (size_t)e * strideB; if (MODE == 2) B2 += (size_t)e * strideB;
    const int ar = tid >> 2, ak = (tid & 3) * 4; const int grow = tm * 64 + ar; const int arow = rowmap ? rowmap[grow] : grow;
    const int bk = tid >> 4, bn = (tid & 15) * 4; const int gn = tn * 64 + bn;
    float acc[4][4] = {}, acc2[4][4] = {};
    for (int k0 = 0; k0 < K; k0 += 16) {
        float4 av = make_float4(0.f, 0.f, 0.f, 0.f); if (arow >= 0) av = *(const float4*)(A + (size_t)arow * lda + k0 + ak);
        float4 bv = make_float4(0.f, 0.f, 0.f, 0.f), bv2 = bv;
        if (gn < N) { bv = *(const float4*)(B + (size_t)(k0 + bk) * ldb + gn); if (MODE == 2) bv2 = *(const float4*)(B2 + (size_t)(k0 + bk) * ldb + gn); }
        __syncthreads();
        As[ak + 0][ar] = av.x; As[ak + 1][ar] = av.y; As[ak + 2][ar] = av.z; As[ak + 3][ar] = av.w;
        *(float4*)&Bs[bk][bn] = bv; if (MODE == 2) *(float4*)&Bs2[bk][bn] = bv2;
        __syncthreads();
#pragma unroll
        for (int k = 0; k < 16; ++k) {
            const float4 a = *(const float4*)&As[k][ty * 4]; const float4 b = *(const float4*)&Bs[k][tx * 4];
            const float aa[4] = {a.x, a.y, a.z, a.w}, bb[4] = {b.x, b.y, b.z, b.w};
#pragma unroll
            for (int i = 0; i < 4; ++i)
#pragma unroll
                for (int j = 0; j < 4; ++j) acc[i][j] += aa[i] * bb[j];
            if (MODE == 2) { const float4 b2 = *(const float4*)&Bs2[k][tx * 4]; const float bb2[4] = {b2.x, b2.y, b2.z, b2.w};
#pragma unroll
                for (int i = 0; i < 4; ++i)
#pragma unroll
                    for (int j = 0; j < 4; ++j) acc2[i][j] += aa[i] * bb2[j]; }
        }
    }
    const int c0 = tn * 64 + tx * 4; if (c0 >= N) return;
#pragma unroll
    for (int i = 0; i < 4; ++i) { float* cp = C + (size_t)(tm * 64 + ty * 4 + i) * ldc + c0; float4 o;
        if (MODE == 0) o = make_float4(acc[i][0], acc[i][1], acc[i][2], acc[i][3]);
        if (MODE == 1) { o = *(float4*)cp; o.x += acc[i][0]; o.y += acc[i][1]; o.z += acc[i][2]; o.w += acc[i][3]; }
        if (MODE == 2) { float r[4];
#pragma unroll
            for (int j = 0; j < 4; ++j) { const float gq = acc[i][j]; r[j] = gq * sigmoidf_(gq) * acc2[i][j]; } o = make_float4(r[0], r[1], r[2], r[3]); }
        *(float4*)cp = o; }
}

__global__ __launch_bounds__(256) void mlstm_rec(const float* __restrict__ z, const float* __restrict__ b_if, float* __restrict__ ht) {
    const int wave = (blockIdx.x * 256 + threadIdx.x) >> 6, lane = threadIdx.x & 63;
    const int bh = wave >> 5, es = wave & 31, b = bh >> 2, h = bh & 3, e0 = es * 4;
    float C[2][4] = {}, n[2] = {0.f, 0.f};
    const float bi = b_if[h], bf = b_if[4 + h]; const float ksc = 0.08838834764831845f;
    for (int t0 = 0; t0 < SEQ; t0 += 8) {
        float kk[8][2], qq[8][2], vv[8][4], ii[8], ff[8];
#pragma unroll
        for (int j = 0; j < 8; ++j) { const float* row = z + (size_t)(b * SEQ + t0 + j) * DIN;
            kk[j][0] = row[ZK + h * DH + lane] * ksc; kk[j][1] = row[ZK + h * DH + lane + 64] * ksc; qq[j][0] = row[ZQ + h * DH + lane]; qq[j][1] = row[ZQ + h * DH + lane + 64];
#pragma unroll
            for (int e = 0; e < 4; ++e) vv[j][e] = row[ZV + h * DH + e0 + e];
            ii[j] = __expf(row[ZI + h] + bi); ff[j] = sigmoidf_(row[ZF + h] + bf); }
#pragma unroll
        for (int j = 0; j < 8; ++j) { float s[5] = {0.f, 0.f, 0.f, 0.f, 0.f};
#pragma unroll
            for (int d = 0; d < 2; ++d) { n[d] = ff[j] * n[d] + ii[j] * kk[j][d]; s[4] += n[d] * qq[j][d];
#pragma unroll
                for (int e = 0; e < 4; ++e) { C[d][e] = ff[j] * C[d][e] + ii[j] * kk[j][d] * vv[j][e]; s[e] += C[d][e] * qq[j][d]; } }
#pragma unroll
            for (int e = 0; e < 5; ++e) s[e] = wave_sum(s[e]);
            const float den = fmaxf(fabsf(s[4]), 1.f);
            if (lane == 0) { float* o = ht + (size_t)(b * SEQ + t0 + j) * MLW + h * DH + e0; o[0] = s[0] / den; o[1] = s[1] / den; o[2] = s[2] / den; o[3] = s[3] / den; } }
    }
}
__global__ __launch_bounds__(256) void ml_out(const float* __restrict__ z, const float* __restrict__ ht, const float* __restrict__ g, float* __restrict__ y) {
    const int w = (blockIdx.x * 256 + threadIdx.x) >> 6, lane = threadIdx.x & 63, t = w >> 2, h = w & 3;
    const float a = ht[(size_t)t * MLW + h * DH + lane], b = ht[(size_t)t * MLW + h * DH + lane + 64];
    const float r = rsqrtf(wave_sum(a * a + b * b) * (1.f / DH) + EPS);
    const float oa = z[(size_t)t * DIN + ZO + h * DH + lane], ob = z[(size_t)t * DIN + ZO + h * DH + lane + 64];
    y[(size_t)t * D + h * DH + lane] = sigmoidf_(oa) * a * r * g[h * DH + lane]; y[(size_t)t * D + h * DH + lane + 64] = sigmoidf_(ob) * b * r * g[h * DH + lane + 64];
}
__global__ __launch_bounds__(512) void rg_gates(const float* __restrict__ z, const float* __restrict__ cw, const float* __restrict__ cb, const float* __restrict__ wa, const float* __restrict__ ba,
                                                const float* __restrict__ wx, const float* __restrict__ bx, const float* __restrict__ lam, float* __restrict__ av, float* __restrict__ uv) {
    __shared__ float xs[RGW]; const int t = blockIdx.x, c = threadIdx.x, tl = t % SEQ;
    float xc = cb[c];
#pragma unroll
    for (int j = 0; j < 4; ++j) { const int tt = tl - 3 + j; if (tt >= 0) xc += cw[j * RGW + c] * z[(size_t)(t - 3 + j) * DIN + ZRX + c]; }
    xs[c] = xc; __syncthreads();
    const int g = c >> 6, jj = c & 63; float ra = ba[c], rx = bx[c];
    for (int i = 0; i < RGD; ++i) { const float xv = xs[g * RGD + i]; ra += xv * wa[(g * RGD + i) * RGD + jj]; rx += xv * wx[(g * RGD + i) * RGD + jj]; }
    const float r = sigmoidf_(ra), ig = sigmoidf_(rx);
    const float sp = log1pf(__expf(-lam[c])); const float la = -8.f * r * sp;
    av[(size_t)t * RGW + c] = __expf(la); uv[(size_t)t * RGW + c] = sqrtf(-expm1f(2.f * la)) * (ig * xc);
}
__global__ __launch_bounds__(256) void rg_scan(const float* __restrict__ av, float* __restrict__ uv) {
    const int id = blockIdx.x * 256 + threadIdx.x, b = id / RGW, c = id % RGW; float h = 0.f;
    for (int t0 = 0; t0 < SEQ; t0 += 8) { float a[8], u[8];
#pragma unroll
        for (int j = 0; j < 8; ++j) { a[j] = av[(size_t)(b * SEQ + t0 + j) * RGW + c]; u[j] = uv[(size_t)(b * SEQ + t0 + j) * RGW + c]; }
#pragma unroll
        for (int j = 0; j < 8; ++j) { h = a[j] * h + u[j]; uv[(size_t)(b * SEQ + t0 + j) * RGW + c] = h; } }
}
__global__ __launch_bounds__(256) void rg_out(const float* __restrict__ z, const float* __restrict__ hr, const float* __restrict__ g, float* __restrict__ y) {
    const int t = (blockIdx.x * 256 + threadIdx.x) >> 6, lane = threadIdx.x & 63; float v[8]; float s = 0.f;
#pragma unroll
    for (int j = 0; j < 8; ++j) { const int c = lane + 64 * j; v[j] = hr[(size_t)t * RGW + c] * gelu_tanh(z[(size_t)t * DIN + ZRG + c]); s += v[j] * v[j]; }
    const float r = rsqrtf(wave_sum(s) * (1.f / RGW) + EPS);
#pragma unroll
    for (int j = 0; j < 8; ++j) { const int c = lane + 64 * j; y[(size_t)t * D + MLW + c] = v[j] * r * g[c]; }
}
__global__ __launch_bounds__(256) void route(const float* __restrict__ u, const float* __restrict__ wr, int* __restrict__ eidx, float* __restrict__ ew) {
    const int t = (blockIdx.x * 256 + threadIdx.x) >> 6, lane = threadIdx.x & 63; float lg[NE] = {};
    for (int k = lane; k < D; k += 64) { const float xv = u[(size_t)t * D + k];
#pragma unroll
        for (int e = 0; e < NE; ++e) lg[e] += xv * wr[k * NE + e]; }
#pragma unroll
    for (int e = 0; e < NE; ++e) lg[e] = wave_sum(lg[e]);
    int i0 = 0; float v0 = lg[0];
#pragma unroll
    for (int e = 1; e < NE; ++e) if (lg[e] > v0) { v0 = lg[e]; i0 = e; }
    int i1 = -1; float v1 = -3.4e38f;
#pragma unroll
    for (int e = 0; e < NE; ++e) if (e != i0 && lg[e] > v1) { v1 = lg[e]; i1 = e; }
    if (lane == 0) { eidx[2 * t] = i0; eidx[2 * t + 1] = i1; const float w0 = 1.f / (1.f + __expf(v1 - v0)); ew[2 * t] = w0; ew[2 * t + 1] = 1.f - w0; }
}
__global__ __launch_bounds__(256) void count(const int* __restrict__ eidx, int* __restrict__ blkcnt) {
    __shared__ int c[NE]; if (threadIdx.x < NE) c[threadIdx.x] = 0; __syncthreads();
    const int t = blockIdx.x * 256 + threadIdx.x; atomicAdd(&c[eidx[2 * t]], 1); atomicAdd(&c[eidx[2 * t + 1]], 1); __syncthreads();
    if (threadIdx.x < NE) blkcnt[blockIdx.x * NE + threadIdx.x] = c[threadIdx.x];
}
__global__ __launch_bounds__(256) void offsets(const int* __restrict__ blkcnt, int* __restrict__ blkbase, int* __restrict__ meta, int* __restrict__ texp64, int* __restrict__ texp256, int* __restrict__ rowtok) {
    __shared__ int off[NE + 1], cnt[NE];
    const int nblk = T / 256;
    if (threadIdx.x < NE) { int s = 0; for (int b = 0; b < nblk; ++b) { blkbase[b * NE + threadIdx.x] = s; s += blkcnt[b * NE + threadIdx.x]; } cnt[threadIdx.x] = s; }
    __syncthreads();
    if (threadIdx.x == 0) { int o = 0; for (int e = 0; e < NE; ++e) { off[e] = o; o += (cnt[e] + 255) / 256 * 256; } off[NE] = o; }
    __syncthreads();
    if (threadIdx.x < NE) { meta[threadIdx.x] = off[threadIdx.x]; meta[8 + threadIdx.x] = cnt[threadIdx.x]; }
    if (threadIdx.x == 0) { meta[16] = off[NE]; meta[17] = off[NE] / 64; meta[18] = off[NE] / 256; }
    for (int i = threadIdx.x; i < nblk * NE; i += 256) blkbase[i] += off[i % NE];
    __syncthreads();
    for (int tl = threadIdx.x; tl < MAXROWS / 64; tl += 256) { const int r = tl * 64; int e = 0; for (int q = 0; q < NE; ++q) if (r >= off[q]) e = q; texp64[tl] = e; if ((tl & 3) == 0) texp256[tl >> 2] = e; }
    for (int e = 0; e < NE; ++e) for (int r = off[e] + cnt[e] + threadIdx.x; r < off[e + 1]; r += 256) rowtok[r] = -1;
}
__global__ __launch_bounds__(256) void assign(const int* __restrict__ eidx, const int* __restrict__ blkbase, int* __restrict__ pos, int* __restrict__ rowtok) {
    __shared__ int wcnt[4][NE]; const int t = blockIdx.x * 256 + threadIdx.x, lane = threadIdx.x & 63, w = threadIdx.x >> 6;
    const int e0 = eidx[2 * t], e1 = eidx[2 * t + 1]; int rank0 = 0, rank1 = 0;
#pragma unroll
    for (int e = 0; e < NE; ++e) { const unsigned long long m0 = __ballot(e0 == e), m1 = __ballot(e1 == e); const unsigned long long lt = (1ull << lane) - 1ull;
        const int c0 = __popcll(m0), r0 = __popcll(m0 & lt), r1 = c0 + __popcll(m1 & lt);
        if (e0 == e) rank0 = r0; if (e1 == e) rank1 = r1; if (lane == 0) wcnt[w][e] = c0 + __popcll(m1); }
    __syncthreads();
    int b0 = blkbase[blockIdx.x * NE + e0], b1 = blkbase[blockIdx.x * NE + e1];
    for (int q = 0; q < w; ++q) { b0 += wcnt[q][e0]; b1 += wcnt[q][e1]; }
    const int p0 = b0 + rank0, p1 = b1 + rank1; pos[2 * t] = p0; pos[2 * t + 1] = p1; rowtok[p0] = t; rowtok[p1] = t;
}
__global__ __launch_bounds__(256) void combine(const float* __restrict__ Y, const int* __restrict__ pos, const float* __restrict__ ew, float* __restrict__ h) {
    const int t = blockIdx.x; const int p0 = pos[2 * t], p1 = pos[2 * t + 1]; const float w0 = ew[2 * t], w1 = ew[2 * t + 1];
    const float4 a = ((const float4*)(Y + (size_t)p0 * D))[threadIdx.x], b = ((const float4*)(Y + (size_t)p1 * D))[threadIdx.x]; float4 o = ((float4*)(h + (size_t)t * D))[threadIdx.x];
    o.x += w0 * a.x + w1 * b.x; o.y += w0 * a.y + w1 * b.y; o.z += w0 * a.z + w1 * b.z; o.w += w0 * a.w + w1 * b.w; ((float4*)(h + (size_t)t * D))[threadIdx.x] = o;
}
}

extern "C" void kernel_launch(void* const* d_in, const int* in_sizes, int n_in, void* d_out, int out_size, void* d_ws, size_t ws_size, hipStream_t stream) {
    const float* x = (const float*)d_in[0]; const float* norm_mix_g = (const float*)d_in[1]; const float* w_in = (const float*)d_in[2]; const float* ml_b_if = (const float*)d_in[3];
    const float* ml_norm_g = (const float*)d_in[4]; const float* conv_w = (const float*)d_in[5]; const float* conv_b = (const float*)d_in[6]; const float* rg_w_a = (const float*)d_in[7];
    const float* rg_b_a = (const float*)d_in[8]; const float* rg_w_x = (const float*)d_in[9]; const float* rg_b_x = (const float*)d_in[10]; const float* rg_lam = (const float*)d_in[11];
    const float* rg_norm_g = (const float*)d_in[12]; const float* w_out = (const float*)d_in[13]; const float* norm_ffn_g = (const float*)d_in[14]; const float* ffn_wg = (const float*)d_in[15];
    const float* ffn_wu = (const float*)d_in[16]; const float* ffn_wd = (const float*)d_in[17]; const float* moe_wr = (const float*)d_in[18]; const float* moe_wg = (const float*)d_in[19];
    const float* moe_wu = (const float*)d_in[20]; const float* moe_wd = (const float*)d_in[21]; const float* norm_final_g = (const float*)d_in[22];
    unsigned char* ws = (unsigned char*)d_ws; constexpr size_t MiB = 1u << 20;
    float* h = (float*)(ws + 0 * MiB); float* xn = (float*)(ws + 64 * MiB); float* y = (float*)(ws + 128 * MiB);
    float* z = (float*)(ws + 192 * MiB); float* ht = (float*)(ws + 388 * MiB); float* ra = (float*)(ws + 420 * MiB); float* ru = (float*)(ws + 452 * MiB);
    float* hid = (float*)(ws + 192 * MiB); float* Y = (float*)(ws + 672 * MiB);
    int* eidx = (int*)(ws + 810 * MiB); float* ew = (float*)(ws + 811 * MiB); int* pos = (int*)(ws + 812 * MiB); int* rowtok = (int*)(ws + 813 * MiB);
    int* blkcnt = (int*)(ws + 814 * MiB); int* blkbase = blkcnt + 1024; int* meta = blkbase + 1024; int* texp64 = meta + 64; int* texp256 = texp64 + 1024;
    hipMemcpyAsync(h, x, (size_t)T * D * 4, hipMemcpyDeviceToDevice, stream);
    for (int l = 0; l < DEPTH; ++l) {
        nv::rmsnorm<<<T / 4, 256, 0, stream>>>(h, norm_mix_g + l * D, xn, T);
        nv::gemm<0><<<dim3((DIN + 63) / 64, T / 64), 256, 0, stream>>>(xn, D, nullptr, w_in + (size_t)l * D * DIN, nullptr, DIN, 0, nullptr, nullptr, z, DIN, DIN, D);
        nv::mlstm_rec<<<128, 256, 0, stream>>>(z, ml_b_if + l * 8, ht);
        nv::ml_out<<<T * 4 / 4, 256, 0, stream>>>(z, ht, ml_norm_g + l * MLW, y);
        nv::rg_gates<<<T, 512, 0, stream>>>(z, conv_w + l * 4 * RGW, conv_b + l * RGW, rg_w_a + (size_t)l * RGB * RGD * RGD, rg_b_a + l * RGW, rg_w_x + (size_t)l * RGB * RGD * RGD, rg_b_x + l * RGW, rg_lam + l * RGW, ra, ru);
        nv::rg_scan<<<BATCH * RGW / 256, 256, 0, stream>>>(ra, ru);
        nv::rg_out<<<T / 4, 256, 0, stream>>>(z, ru, rg_norm_g + l * RGW, y);
        nv::gemm<1><<<dim3(D / 64, T / 64), 256, 0, stream>>>(y, D, nullptr, w_out + (size_t)l * D * D, nullptr, D, 0, nullptr, nullptr, h, D, D, D);
        nv::rmsnorm<<<T / 4, 256, 0, stream>>>(h, norm_ffn_g + l * D, xn, T);
        const int j = l / 2;
        if (l % 2 == 0) {
            nv::gemm<2><<<dim3(FFD / 64, T / 64), 256, 0, stream>>>(xn, D, nullptr, ffn_wg + (size_t)j * D * FFD, ffn_wu + (size_t)j * D * FFD, FFD, 0, nullptr, nullptr, hid, FFD, FFD, D);
            nv::gemm<1><<<dim3(D / 64, T / 64), 256, 0, stream>>>(hid, FFD, nullptr, ffn_wd + (size_t)j * FFD * D, nullptr, D, 0, nullptr, nullptr, h, D, D, FFD);
        } else {
            nv::route<<<T / 4, 256, 0, stream>>>(xn, moe_wr + (size_t)j * D * NE, eidx, ew);
            nv::count<<<T / 256, 256, 0, stream>>>(eidx, blkcnt);
            nv::offsets<<<1, 256, 0, stream>>>(blkcnt, blkbase, meta, texp64, texp256, rowtok);
            nv::assign<<<T / 256, 256, 0, stream>>>(eidx, blkbase, pos, rowtok);
            nv::gemm<2><<<dim3(FFE / 64, MAXROWS / 64), 256, 0, stream>>>(xn, D, rowtok, moe_wg + (size_t)j * NE * D * FFE, moe_wu + (size_t)j * NE * D * FFE, FFE, (size_t)D * FFE, texp64, meta + 17, hid, FFE, FFE, D);
            nv::gemm<0><<<dim3(D / 64, MAXROWS / 64), 256, 0, stream>>>(hid, FFE, nullptr, moe_wd + (size_t)j * NE * FFE * D, nullptr, D, (size_t)FFE * D, texp64, meta + 17, Y, D, D, FFE);
            nv::combine<<<T, 256, 0, stream>>>(Y, pos, ew, h);
        }
    }
    nv::rmsnorm<<<T / 4, 256, 0, stream>>>(h, norm_final_g, (float*)d_out, T);
}
```

```cpp
#include <hip/hip_runtime.h>
#include <cstdio>
#include <cstdint>

constexpr int D = 1024, BATCH = 4, SEQ = 4096, T = BATCH * SEQ, DEPTH = 4;
constexpr int MLW = 512, MLH = 4, DH = 128, RGW = 512, RGB = 8, RGD = 64;
constexpr int DIN = 3080, FFD = 2816, NE = 8, FFE = 3584;
constexpr int NZ = 3072;
constexpr int ZQ = 0, ZK = 512, ZV = 1024, ZO = 1536, ZRX = 2048, ZRG = 2560;
constexpr float EPS = 1e-6f;
constexpr int MAXROWS = 2 * T + NE * 256;
constexpr int MAXT256 = MAXROWS / 256;
constexpr int NWAVES = 8, NTHR = 512;

#define LAS __attribute__((address_space(3)))
#define GAS __attribute__((address_space(1)))
typedef unsigned short bf16;
typedef float f32x4 __attribute__((ext_vector_type(4)));
typedef float f32x2 __attribute__((ext_vector_type(2)));
typedef unsigned u32x4 __attribute__((ext_vector_type(4)));
typedef unsigned u32x2 __attribute__((ext_vector_type(2)));
typedef short bf16x8 __attribute__((ext_vector_type(8)));

__device__ __forceinline__ float wave_sum(float v) {
#pragma unroll
    for (int o = 1; o < 64; o <<= 1) v += __shfl_xor(v, o);
    return v;
}
__device__ __forceinline__ float sigmoidf_(float x) { return 1.f / (1.f + __expf(-x)); }
__device__ __forceinline__ float gelu_tanh(float x) { const float u = 0.7978845608028654f * (x + 0.044715f * x * x * x); return 0.5f * x * (1.f + tanhf(u)); }
__device__ __forceinline__ unsigned cvt_pk_bf16(float lo, float hi) { unsigned r; asm volatile("v_cvt_pk_bf16_f32 %0, %1, %2" : "=v"(r) : "v"(lo), "v"(hi)); return r; }
__device__ __forceinline__ float bf2f(unsigned short b) { return __uint_as_float(((unsigned)b) << 16); }
__device__ __forceinline__ float bflo(unsigned w) { return __uint_as_float(w << 16); }
__device__ __forceinline__ float bfhi(unsigned w) { return __uint_as_float(w & 0xffff0000u); }
__device__ __forceinline__ bf16 f2bf(float f) { return (bf16)(cvt_pk_bf16(f, 0.f) & 0xffffu); }

namespace pg8 {
#define PG8_LAS __attribute__((address_space(3)))
typedef unsigned short bf16_t;
constexpr int BM = 256, BK = 64, HALF = 128, HTB = HALF * BK * 2  , STAGE_BYTES = 8 * HTB, NXCD = 8, WGM = 8;
__host__ __device__ __forceinline__ int lds_byte(int r, int c) { const int st = (r >> 4) * 2 + (c >> 5), rr = r & 15, cc = c & 31, ob = rr * 64 + cc * 2; return st * 1024 + (ob ^ (((ob >> 9) & 1) << 5)); }
__host__ __device__ __forceinline__ void stage_rc(int b, int& R, int& C) { const int st = b / 1024, sb = b % 1024, swz = sb ^ (((sb >> 9) & 1) << 5); R = (st >> 1) * 16 + swz / 64; C = (st & 1) * 32 + (swz % 64) / 2; }
__host__ __device__ __forceinline__ int perm32(int rho) { const int n = rho >> 4, i = rho & 15; return 8 * (i >> 2) + 4 * n + (i & 3); }

struct Unit { int pm, pn, pb; };
struct Gemm { const bf16_t* A; const bf16_t* Bt; int M, N, K; };

struct StaticOrder {
    int nM, nN, nwg, G, c;
    __host__ __device__ void init(int M, int N, int G_, int c_) { nM = M / BM; nN = N / BM; nwg = nM * nN; G = G_; c = c_; }
    __host__ __device__ bool next(int i, Unit& u) const {
        const long L = (long)i * G + c; if (L >= nwg) return false;
        int wgid = (int)L; { const int q = nwg / NXCD, r = nwg % NXCD, xcd = wgid % NXCD, off = wgid / NXCD; wgid = (xcd < r ? xcd * (q + 1) : r * (q + 1) + (xcd - r) * q) + off; }
        const int nig = WGM * nN, gid = wgid / nig, fm = gid * WGM, gsz = (nM - fm) < WGM ? (nM - fm) : WGM;
        u.pm = fm + ((wgid % nig) % gsz); u.pn = (wgid % nig) / gsz; u.pb = u.pn; return true;
    }
    __device__ __forceinline__ void a_ready(const Unit&) const {}
    __device__ __forceinline__ void done(const Unit&) const {}
};
struct MoeOrder {
    int nM, nN, nwg, G, c; const int* texp;
    __device__ void init(int nM_, int N, int G_, int c_, const int* texp_) { nM = nM_; nN = N / BM; nwg = nM * nN; G = G_; c = c_; texp = texp_; }
    __device__ bool next(int i, Unit& u) const {
        const long L = (long)i * G + c; if (L >= nwg) return false;
        int wgid = (int)L; { const int q = nwg / NXCD, r = nwg % NXCD, xcd = wgid % NXCD, off = wgid / NXCD; wgid = (xcd < r ? xcd * (q + 1) : r * (q + 1) + (xcd - r) * q) + off; }
        const int nig = WGM * nN, gid = wgid / nig, fm = gid * WGM, gsz = (nM - fm) < WGM ? (nM - fm) : WGM;
        u.pm = fm + ((wgid % nig) % gsz); u.pn = (wgid % nig) / gsz; u.pb = __builtin_amdgcn_readfirstlane(texp[u.pm]) * nN + u.pn; return true;
    }
    __device__ __forceinline__ void a_ready(const Unit&) const {}
    __device__ __forceinline__ void done(const Unit&) const {}
};

struct EpiBf16 {
    static constexpr bool PERM = true, AFTER_DRAIN = false;
    bf16_t* O; int ldc;
    __device__ __forceinline__ void operator()(const f32x4 (&acc)[2][2][4][2], const Unit& u, int wr, int wc, int fr, int fq) const {
        const int row0 = u.pm * BM + wr * 64 + fr, col0 = u.pn * BM + wc * 32 + 8 * fq;
#pragma unroll
        for (int ai = 0; ai < 2; ++ai)
#pragma unroll
            for (int m = 0; m < 4; ++m) { bf16_t* rowp = O + (size_t)(row0 + ai * HALF + m * 16) * ldc + col0;
#pragma unroll
                for (int bj = 0; bj < 2; ++bj) { const f32x4 v0 = acc[ai][bj][m][0], v1 = acc[ai][bj][m][1];
                    u32x4 w; w.x = cvt_pk_bf16(v0[0], v0[1]); w.y = cvt_pk_bf16(v0[2], v0[3]); w.z = cvt_pk_bf16(v1[0], v1[1]); w.w = cvt_pk_bf16(v1[2], v1[3]);
                    *(u32x4*)(rowp + bj * HALF) = w; } }
    }
};
struct EpiResF32 {
    static constexpr bool PERM = false, AFTER_DRAIN = false;
    float* C; int ldc;
    __device__ __forceinline__ void operator()(const f32x4 (&acc)[2][2][4][2], const Unit& u, int wr, int wc, int fr, int fq) const {
        const int row0 = u.pm * BM + wr * 64 + fr, col0 = u.pn * BM + wc * 32 + 4 * fq;
#pragma unroll
        for (int ai = 0; ai < 2; ++ai)
#pragma unroll
            for (int m = 0; m < 4; ++m) { float* rowp = C + (size_t)(row0 + ai * HALF + m * 16) * ldc + col0;
                f32x4 o[2][2];
#pragma unroll
                for (int bj = 0; bj < 2; ++bj)
#pragma unroll
                    for (int n = 0; n < 2; ++n) o[bj][n] = *(const f32x4*)(rowp + bj * HALF + n * 16);
#pragma unroll
                for (int bj = 0; bj < 2; ++bj)
#pragma unroll
                    for (int n = 0; n < 2; ++n) *(f32x4*)(rowp + bj * HALF + n * 16) = o[bj][n] + acc[ai][bj][m][n]; }
    }
};
struct EpiSwiglu {
    static constexpr bool PERM = true, AFTER_DRAIN = false;
    bf16_t* O; int ldc;
    __device__ __forceinline__ void operator()(const f32x4 (&acc)[2][2][4][2], const Unit& u, int wr, int wc, int fr, int fq) const {
        const int row0 = u.pm * BM + wr * 64 + fr, col0 = u.pn * HALF + wc * 32 + 8 * fq;
#pragma unroll
        for (int ai = 0; ai < 2; ++ai)
#pragma unroll
            for (int m = 0; m < 4; ++m) { bf16_t* rowp = O + (size_t)(row0 + ai * HALF + m * 16) * ldc + col0; float r[8];
#pragma unroll
                for (int n = 0; n < 2; ++n)
#pragma unroll
                    for (int j = 0; j < 4; ++j) { const float g = acc[ai][0][m][n][j], up = acc[ai][1][m][n][j]; r[4 * n + j] = g * __builtin_amdgcn_rcpf(1.f + __expf(-g)) * up; }
                u32x4 w; w.x = cvt_pk_bf16(r[0], r[1]); w.y = cvt_pk_bf16(r[2], r[3]); w.z = cvt_pk_bf16(r[4], r[5]); w.w = cvt_pk_bf16(r[6], r[7]);
                *(u32x4*)rowp = w; }
    }
};

template <class Epi, class Sched, bool ALIGN_EPI = false, bool SP2 = false>
__device__ __forceinline__ void gemm_phase(PG8_LAS unsigned char* lds, const Gemm g, const Sched& S, const Epi& E) {
    int tid_o = threadIdx.x; asm volatile("" : "+v"(tid_o));
    const int tid = tid_o, wid = __builtin_amdgcn_readfirstlane(tid >> 6), lane = tid & 63, wr = wid >> 2, wc = wid & 3, fr = lane & 15, fq = lane >> 4;
    const int K = g.K, nt = K / BK;
    unsigned voffA[2], voffB[2];
#pragma unroll
    for (int i = 0; i < 2; ++i) { int R, C; stage_rc(tid * 16 + i * 8192, R, C); const int Rb = Epi::PERM ? ((R & ~31) + perm32(R & 31)) : R;
        voffA[i] = (unsigned)(R * K + C) * 2u; voffB[i] = (unsigned)(Rb * K + C) * 2u; }
    const size_t kstep = (size_t)(BK * 2);
    const size_t hstep = (size_t)HALF * K * 2;
    const size_t tstep = 2 * hstep;
    const unsigned ldsw = (unsigned)wid * 1024u;
    const int aoff = lds_byte(wr * 64 + fr, fq * 8), boff = lds_byte(wc * 32 + fr, fq * 8);
#define PG8_SA(b, h) (((b) * 2 + (h)) * HTB)
#define PG8_SB(b, h) ((4 + (b) * 2 + (h)) * HTB)
#define PG8_STAGE(bufoff, gbase, voff) do { _Pragma("unroll") for (int _i = 0; _i < 2; ++_i) \
        __builtin_amdgcn_global_load_lds((const unsigned*)((const char*)(gbase) + (voff)[_i]), (PG8_LAS unsigned*)(lds + (bufoff) + ldsw + _i * 8192), 16, 0, 0); } while (0)
#define PG8_LDA(dst, b, h) do { _Pragma("unroll") for (int m = 0; m < 4; ++m) _Pragma("unroll") for (int k = 0; k < 2; ++k) dst[m][k] = *(const PG8_LAS bf16x8*)(lds + PG8_SA(b, h) + aoff + m * 2048 + k * 1024); } while (0)
#define PG8_LDB(dst, b, h) do { _Pragma("unroll") for (int n = 0; n < 2; ++n) _Pragma("unroll") for (int k = 0; k < 2; ++k) dst[n][k] = *(const PG8_LAS bf16x8*)(lds + PG8_SB(b, h) + boff + n * 2048 + k * 1024); } while (0)
#define PG8_MMA(ai, bj, At, Bt) do { __builtin_amdgcn_s_setprio(1); _Pragma("unroll") for (int m = 0; m < 4; ++m) _Pragma("unroll") for (int n = 0; n < 2; ++n) _Pragma("unroll") for (int k = 0; k < 2; ++k) \
        acc[ai][bj][m][n] = __builtin_amdgcn_mfma_f32_16x16x32_bf16(Bt[n][k], At[m][k], acc[ai][bj][m][n], 0, 0, 0); __builtin_amdgcn_s_setprio(0); } while (0)
#define PG8_WAIT_V(n) asm volatile("s_waitcnt vmcnt(" #n ")" ::: "memory")
#define PG8_WAIT_L(n) asm volatile("s_waitcnt lgkmcnt(" #n ")" ::: "memory")
#define PG8_BAR __builtin_amdgcn_s_barrier()
#define PG8_SCHED __builtin_amdgcn_sched_barrier(0)
    Unit cur, nxt; int ui = 0;
    if (!S.next(0, cur)) return;
    f32x4 acc[2][2][4][2];
#pragma unroll
    for (int a = 0; a < 2; ++a)
#pragma unroll
        for (int b = 0; b < 2; ++b)
#pragma unroll
            for (int m = 0; m < 4; ++m)
#pragma unroll
                for (int n = 0; n < 2; ++n) acc[a][b][m][n] = (f32x4){0.f, 0.f, 0.f, 0.f};
    bf16x8 At[4][2], B0[2][2], B1[2][2];
    const char* cA = (const char*)g.A + (size_t)cur.pm * tstep; const char* cB = (const char*)g.Bt + (size_t)cur.pb * tstep;
    S.a_ready(cur);
    if constexpr (SP2) {
        PG8_STAGE(PG8_SB(0, 0), cB, voffB); PG8_STAGE(PG8_SB(0, 1), cB + hstep, voffB); PG8_STAGE(PG8_SA(0, 0), cA, voffA); PG8_STAGE(PG8_SA(0, 1), cA + hstep, voffA);
        if (wr == 1) PG8_BAR;
        PG8_WAIT_V(2); PG8_BAR;
        PG8_STAGE(PG8_SB(1, 0), cB + kstep, voffB); PG8_STAGE(PG8_SA(1, 0), cA + kstep, voffA); PG8_STAGE(PG8_SB(1, 1), cB + hstep + kstep, voffB);
        PG8_WAIT_V(6); PG8_BAR;
    } else {
        PG8_STAGE(PG8_SB(0, 0), cB, voffB); PG8_STAGE(PG8_SA(0, 0), cA, voffA); PG8_STAGE(PG8_SB(0, 1), cB + hstep, voffB); PG8_STAGE(PG8_SA(0, 1), cA + hstep, voffA);
        if (wr == 1) PG8_BAR;
        PG8_WAIT_V(4); PG8_BAR;
        PG8_STAGE(PG8_SB(1, 0), cB + kstep, voffB); PG8_STAGE(PG8_SA(1, 0), cA + kstep, voffA); PG8_STAGE(PG8_SB(1, 1), cB + hstep + kstep, voffB);
        PG8_WAIT_V(6); PG8_BAR;
    }
    for (;;) {
        const bool has_next = S.next(ui + 1, nxt);
        const char* nA = has_next ? (const char*)g.A + (size_t)nxt.pm * tstep : cA; const char* nB = has_next ? (const char*)g.Bt + (size_t)nxt.pb * tstep : cB;
        for (int t = 0; t < nt; t += 2) {
            const bool last = (t == nt - 2);
            const char* a1 = cA + (size_t)(t + 1) * kstep;
            const char* a2 = last ? nA : cA + (size_t)(t + 2) * kstep; const char* b2 = last ? nB : cB + (size_t)(t + 2) * kstep;
            const char* a3 = a2 + kstep; const char* b3 = b2 + kstep;
            if (last && has_next) S.a_ready(nxt);
            if constexpr (SP2) {
            PG8_LDB(B0, 0, 0); PG8_LDB(B1, 0, 1); PG8_SCHED; PG8_LDA(At, 0, 0); PG8_STAGE(PG8_SA(1, 1), a1 + hstep, voffA);
            PG8_WAIT_V(8); PG8_WAIT_L(0); PG8_BAR; PG8_MMA(0, 0, At, B0); PG8_MMA(0, 1, At, B1); PG8_BAR; PG8_SCHED;
            PG8_LDA(At, 0, 1); PG8_STAGE(PG8_SB(0, 0), b2, voffB); PG8_STAGE(PG8_SB(0, 1), b2 + hstep, voffB); PG8_STAGE(PG8_SA(0, 0), a2, voffA);
            PG8_WAIT_V(8); PG8_WAIT_L(0); PG8_BAR; PG8_MMA(1, 0, At, B0); PG8_MMA(1, 1, At, B1); PG8_BAR; PG8_SCHED;
            PG8_LDB(B0, 1, 0); PG8_LDB(B1, 1, 1); PG8_SCHED; PG8_LDA(At, 1, 0); PG8_STAGE(PG8_SA(0, 1), a2 + hstep, voffA);
            PG8_WAIT_V(8); PG8_WAIT_L(0); PG8_BAR; PG8_MMA(0, 0, At, B0); PG8_MMA(0, 1, At, B1); PG8_BAR; PG8_SCHED;
            PG8_LDA(At, 1, 1); PG8_STAGE(PG8_SB(1, 0), b3, voffB); PG8_STAGE(PG8_SB(1, 1), b3 + hstep, voffB); PG8_STAGE(PG8_SA(1, 0), a3, voffA);
            PG8_WAIT_V(8); PG8_WAIT_L(0); PG8_BAR; PG8_MMA(1, 0, At, B0); PG8_MMA(1, 1, At, B1); PG8_BAR; PG8_SCHED;
            } else {
            PG8_LDB(B0, 0, 0); PG8_SCHED; PG8_LDA(At, 0, 0); PG8_STAGE(PG8_SA(1, 1), a1 + hstep, voffA);
            PG8_WAIT_L(8); PG8_BAR; PG8_WAIT_L(0); PG8_MMA(0, 0, At, B0); PG8_BAR; PG8_SCHED;
            PG8_LDB(B1, 0, 1); PG8_STAGE(PG8_SB(0, 0), b2, voffB);
            PG8_BAR; PG8_WAIT_L(0); PG8_MMA(0, 1, At, B1); PG8_BAR;
            PG8_LDA(At, 0, 1); PG8_STAGE(PG8_SA(0, 0), a2, voffA);
            PG8_BAR; PG8_WAIT_L(0); PG8_MMA(1, 0, At, B0); PG8_BAR; PG8_SCHED;
            PG8_STAGE(PG8_SB(0, 1), b2 + hstep, voffB);
            PG8_WAIT_V(6); PG8_BAR; PG8_MMA(1, 1, At, B1); PG8_BAR;
            PG8_LDB(B0, 1, 0); PG8_SCHED; PG8_LDA(At, 1, 0); PG8_STAGE(PG8_SA(0, 1), a2 + hstep, voffA);
            PG8_WAIT_L(8); PG8_BAR; PG8_WAIT_L(0); PG8_MMA(0, 0, At, B0); PG8_BAR; PG8_SCHED;
            PG8_LDB(B1, 1, 1); PG8_STAGE(PG8_SB(1, 0), b3, voffB);
            PG8_BAR; PG8_WAIT_L(0); PG8_MMA(0, 1, At, B1); PG8_BAR;
            PG8_LDA(At, 1, 1); PG8_STAGE(PG8_SA(1, 0), a3, voffA);
            PG8_BAR; PG8_WAIT_L(0); PG8_MMA(1, 0, At, B0); PG8_BAR; PG8_SCHED;
            PG8_STAGE(PG8_SB(1, 1), b3 + hstep, voffB);
            PG8_WAIT_V(6); PG8_BAR; PG8_MMA(1, 1, At, B1); PG8_BAR;
            }
        }
        if constexpr (ALIGN_EPI) { if (wr == 0) PG8_BAR; }
        if constexpr (!Epi::AFTER_DRAIN) { E(acc, cur, wr, wc, fr, fq); S.done(cur); }
        if (!has_next) break;
#pragma unroll
        for (int a = 0; a < 2; ++a)
#pragma unroll
            for (int b = 0; b < 2; ++b)
#pragma unroll
                for (int m = 0; m < 4; ++m)
#pragma unroll
                    for (int n = 0; n < 2; ++n) acc[a][b][m][n] = (f32x4){0.f, 0.f, 0.f, 0.f};
        cur = nxt; cA = nA; cB = nB; ++ui;
        if constexpr (ALIGN_EPI) { if (wr == 1) PG8_BAR; }
    }
    PG8_WAIT_V(0);
    if constexpr (!ALIGN_EPI) { if (wr == 0) PG8_BAR; }
    PG8_BAR;
    if constexpr (Epi::AFTER_DRAIN) { E.fused(acc, cur, wr, wc, fr, fq, lds, wid, lane); S.done(cur); }
#undef PG8_SA
#undef PG8_SB
#undef PG8_STAGE
#undef PG8_LDA
#undef PG8_LDB
#undef PG8_MMA
#undef PG8_WAIT_V
#undef PG8_WAIT_L
#undef PG8_BAR
#undef PG8_SCHED
}
}

constexpr size_t MiB = 1u << 20;
constexpr size_t WS_CTL = 0;
constexpr int CW_BAR = 4096;
constexpr size_t WS_IFP = 1 * MiB;
constexpr size_t WS_EIDX = WS_IFP + 512 * 1024;
constexpr size_t WS_EW = WS_EIDX + 128 * 1024;
constexpr size_t WS_POS = WS_EW + 128 * 1024;
constexpr size_t WS_BLKCNT = WS_POS + 128 * 1024;
constexpr size_t WS_META = WS_BLKCNT + 16 * 1024;
constexpr size_t WS_SMALL = 2 * MiB;
constexpr size_t WS_WRG = 4 * MiB;
constexpr size_t WS_WIN = 8 * MiB;
constexpr size_t WS_WOUT = 32 * MiB;
constexpr size_t WS_WGU = 40 * MiB;
constexpr size_t WS_WD = 62 * MiB;
constexpr size_t WS_MWGU = 74 * MiB;
constexpr size_t WS_MWD = 298 * MiB;
constexpr size_t WS_H = 410 * MiB;
constexpr size_t WS_XN = 474 * MiB;
constexpr size_t WS_R = 506 * MiB;
constexpr size_t WS_Z = WS_R;
constexpr size_t WS_Y = WS_R + 96 * MiB;
constexpr size_t WS_CTL_LOC = WS_R + 128 * MiB;
constexpr size_t WS_CTP = WS_R + 160 * MiB;
constexpr size_t WS_RA = WS_R + 176 * MiB;
constexpr size_t WS_RU = WS_R + 208 * MiB;
constexpr size_t WS_HID = WS_R;
constexpr size_t WS_XG = WS_R;
constexpr size_t WS_MHID = WS_R + 68 * MiB;
constexpr size_t WS_END = 812 * MiB;

constexpr int LDS_BYTES = 147456;
constexpr int MISC_OFF = 131072 + 4096;

struct Ctx { const float* in[23]; float* out; unsigned char* ws; int s_lo, s_hi; };

#define XB_TMO      128
#define XB_XCNT(j)  (256  + 64 * (j))
#define XB_XSUB(j)  (1280 + 64 * (j))
#define XB_XGEN(j)  (2304 + 64 * (j))
#define XB_TOP      3328
#define XB_TOPGEN   3392
#define XCD_BAR_WORDS 3456
#define XB_SPIN_CAP (1u << 18)

__device__ __forceinline__ unsigned xb_ld(unsigned* p)              { return __hip_atomic_load(p, __ATOMIC_RELAXED, __HIP_MEMORY_SCOPE_AGENT); }
__device__ __forceinline__ unsigned xb_add(unsigned* p, unsigned v) { return __hip_atomic_fetch_add(p, v, __ATOMIC_RELAXED, __HIP_MEMORY_SCOPE_AGENT); }
__device__ __forceinline__ unsigned xb_xcc_id() { return (unsigned)__builtin_amdgcn_s_getreg((3 << 11) | 20) & 0xFu; }
#define XB_SPIN(cond, bar) do { unsigned _sp = 0; while (cond) { __builtin_amdgcn_s_sleep(1); \
    if ((++_sp & 255u) == 0u) { if (xb_ld(&(bar)[XB_TMO])) break; if (_sp > XB_SPIN_CAP) { atomicAdd(&(bar)[XB_TMO], 1u); break; } } } } while (0)

struct XcdBarrier {
    unsigned* bar; unsigned x;
    volatile LAS unsigned* st;
};

__device__ __forceinline__ XcdBarrier xcd_barrier_post(unsigned* bar, volatile LAS unsigned* st) {
    XcdBarrier b; b.bar = bar; b.x = xb_xcc_id(); b.st = st;
    if (threadIdx.x == 0) (void)xb_add(&bar[XB_XCNT(b.x)], 1u);
    return b;
}
__device__ __forceinline__ void xcd_barrier_complete(unsigned* bar, unsigned x, unsigned& nloc, unsigned& nx) {
    const unsigned G = gridDim.x * gridDim.y * gridDim.z;
    unsigned sum, cnt, mine, sp = 0u;
    for (;;) {
        sum = 0u; cnt = 0u; mine = 0u;
#pragma unroll
        for (unsigned j = 0; j < 16; ++j) { const unsigned c = xb_ld(&bar[XB_XCNT(j)]); sum += c; cnt += (c > 0u) ? 1u : 0u; mine = (j == x) ? c : mine; }
        if (sum == G) break;
        __builtin_amdgcn_s_sleep(1);
        if ((++sp & 255u) == 0u) { if (xb_ld(&bar[XB_TMO])) break; if (sp > XB_SPIN_CAP) { atomicAdd(&bar[XB_TMO], 1u); break; } }
    }
    nloc = mine > 0u ? mine : 1u; nx = cnt > 0u ? cnt : 1u;
}

__device__ __forceinline__ void xcd_barrier(const XcdBarrier& b) {
    asm volatile("s_waitcnt vmcnt(0)" ::: "memory");
    __syncthreads();
    if (threadIdx.x == 0) {
        unsigned* bar = b.bar;
        __builtin_amdgcn_s_waitcnt(0);
        unsigned nloc = b.st[0], nx = b.st[1];
        if (nloc == 0u) { xcd_barrier_complete(bar, b.x, nloc, nx); b.st[0] = nloc; b.st[1] = nx; }
        const unsigned old = xb_add(&bar[XB_XSUB(b.x)], 1u);
        const unsigned gen = old / nloc;
        if (old + 1u == (gen + 1u) * nloc) {
            __builtin_amdgcn_fence(__ATOMIC_RELEASE, "agent");
            asm volatile("s_waitcnt vmcnt(0)" ::: "memory");
            const unsigned og = xb_add(&bar[XB_TOP], 1u);
            const unsigned tg = og / nx;
            if (og + 1u == (tg + 1u) * nx) xb_add(&bar[XB_TOPGEN], 1u);
            else XB_SPIN(xb_ld(&bar[XB_TOPGEN]) == tg, bar);
            __builtin_amdgcn_fence(__ATOMIC_ACQUIRE, "agent");
            xb_add(&bar[XB_XGEN(b.x)], 1u);
            asm volatile("s_waitcnt vmcnt(0)" ::: "memory");
        } else {
            XB_SPIN(xb_ld(&bar[XB_XGEN(b.x)]) == gen, bar);
            __builtin_amdgcn_fence(__ATOMIC_ACQUIRE, "agent");
            asm volatile("s_waitcnt vmcnt(0)" ::: "memory");
        }
    }
    __syncthreads();
}

__device__ __forceinline__ int opaque_bid() { int b = blockIdx.x; asm volatile("" : "+s"(b)); return b; }
#define IN_X 0
#define IN_NORM_MIX_G 1
#define IN_W_IN 2
#define IN_ML_B_IF 3
#define IN_ML_NORM_G 4
#define IN_CONV_W 5
#define IN_CONV_B 6
#define IN_RG_W_A 7
#define IN_RG_B_A 8
#define IN_RG_W_X 9
#define IN_RG_B_X 10
#define IN_RG_LAM 11
#define IN_RG_NORM_G 12
#define IN_W_OUT 13
#define IN_NORM_FFN_G 14
#define IN_FFN_WG 15
#define IN_FFN_WU 16
#define IN_FFN_WD 17
#define IN_MOE_WR 18
#define IN_MOE_WG 19
#define IN_MOE_WU 20
#define IN_MOE_WD 21
#define IN_NORM_FINAL_G 22

__device__ __forceinline__ void cvt_tile(const float* __restrict__ src, int ld, bf16* __restrict__ dst, int K, LAS float* scr, int lane) {
#pragma unroll 4
    for (int i = 0; i < 16; ++i) { const int kk = 4 * i + (lane >> 4); const f32x4 v = *(const f32x4*)(src + (size_t)kk * ld + (lane & 15) * 4);
        LAS float* s = scr + kk * 65 + (lane & 15) * 4; s[0] = v[0]; s[1] = v[1]; s[2] = v[2]; s[3] = v[3]; }
    asm volatile("s_waitcnt lgkmcnt(0)" ::: "memory");
    const int c = lane & 7;
#pragma unroll
    for (int j = 0; j < 8; ++j) { const int n = (lane >> 3) + 8 * j; const LAS float* s = scr + (8 * c) * 65 + n;
        u32x4 o; o.x = cvt_pk_bf16(s[0], s[65]); o.y = cvt_pk_bf16(s[130], s[195]); o.z = cvt_pk_bf16(s[260], s[325]); o.w = cvt_pk_bf16(s[390], s[455]);
        *(u32x4*)(dst + (size_t)n * K + 8 * c) = o; }
    asm volatile("s_waitcnt lgkmcnt(0)" ::: "memory");
}
constexpr int CV_IN = 4 * 768, CV_OUT = 4 * 256, CV_GU = 2 * 1408, CV_D = 2 * 704, CV_MGU = 16 * 1792, CV_MD = 16 * 896, CV_RG = 64;
constexpr int CV_TOTAL = CV_IN + CV_OUT + CV_GU + CV_D + CV_MGU + CV_MD + CV_RG;
__device__ __forceinline__ void cvt_phase(const Ctx& c, LAS unsigned char* lds) {
    int tid_o = threadIdx.x; asm volatile("" : "+v"(tid_o));
    const int tid = tid_o, lane = tid & 63, wave = __builtin_amdgcn_readfirstlane(tid >> 6);
    LAS float* scr = (LAS float*)(lds + wave * 16640);
    const int gw = opaque_bid() * NWAVES + wave, NGW = gridDim.x * NWAVES;
    for (int it0 = gw; it0 < CV_TOTAL; it0 += NGW) {
        int it = it0; const float* src; int ld, K; bf16* dst;
        if (it < CV_IN) { const int l = it / 768, r = it % 768, nt = r % 48, kt = r / 48, n0 = 64 * nt, k0 = 64 * kt, sc = n0 < 2048 ? n0 : n0 + 8;
            src = c.in[IN_W_IN] + (size_t)l * D * DIN + (size_t)k0 * DIN + sc; ld = DIN; K = D; dst = (bf16*)(c.ws + WS_WIN) + (size_t)l * NZ * D + (size_t)n0 * D + k0; }
        else if ((it -= CV_IN) < CV_OUT) { const int l = it / 256, r = it % 256, nt = r % 16, kt = r / 16, n0 = 64 * nt, k0 = 64 * kt;
            src = c.in[IN_W_OUT] + (size_t)l * D * D + (size_t)k0 * D + n0; ld = D; K = D; dst = (bf16*)(c.ws + WS_WOUT) + (size_t)l * D * D + (size_t)n0 * D + k0; }
        else if ((it -= CV_OUT) < CV_GU) { const int j = it / 1408, r = it % 1408, nt = r % 88, kt = r / 88, n0 = 64 * nt, k0 = 64 * kt, jj = n0 >> 8, cc = n0 & 255;
            src = (cc < 128 ? c.in[IN_FFN_WG] : c.in[IN_FFN_WU]) + (size_t)j * D * FFD + (size_t)k0 * FFD + jj * 128 + (cc & 127); ld = FFD; K = D;
            dst = (bf16*)(c.ws + WS_WGU) + (size_t)j * 2 * FFD * D + (size_t)n0 * D + k0; }
        else if ((it -= CV_GU) < CV_D) { const int j = it / 704, r = it % 704, nt = r % 16, kt = r / 16, n0 = 64 * nt, k0 = 64 * kt;
            src = c.in[IN_FFN_WD] + (size_t)j * FFD * D + (size_t)k0 * D + n0; ld = D; K = FFD; dst = (bf16*)(c.ws + WS_WD) + (size_t)j * D * FFD + (size_t)n0 * FFD + k0; }
        else if ((it -= CV_D) < CV_MGU) { const int je = it / 1792, r = it % 1792, nt = r % 112, kt = r / 112, n0 = 64 * nt, k0 = 64 * kt, jj = n0 >> 8, cc = n0 & 255;
            src = (cc < 128 ? c.in[IN_MOE_WG] : c.in[IN_MOE_WU]) + (size_t)je * D * FFE + (size_t)k0 * FFE + jj * 128 + (cc & 127); ld = FFE; K = D;
            dst = (bf16*)(c.ws + WS_MWGU) + (size_t)je * 2 * FFE * D + (size_t)n0 * D + k0; }
        else if ((it -= CV_MGU) < CV_MD) { const int je = it / 896, r = it % 896, nt = r % 16, kt = r / 16, n0 = 64 * nt, k0 = 64 * kt;
            src = c.in[IN_MOE_WD] + (size_t)je * FFE * D + (size_t)k0 * D + n0; ld = D; K = FFE; dst = (bf16*)(c.ws + WS_MWD) + (size_t)je * D * FFE + (size_t)n0 * FFE + k0; }
        else { it -= CV_MD; const int l = it >> 4, which = (it >> 3) & 1, g = it & 7;
            src = c.in[which ? IN_RG_W_X : IN_RG_W_A] + (size_t)(l * RGB + g) * RGD * RGD; ld = RGD; K = RGD; dst = (bf16*)(c.ws + WS_WRG) + (size_t)((l * 2 + which) * RGB + g) * RGD * RGD; }
        cvt_tile(src, ld, dst, K, scr, lane);
    }
}

constexpr int W8S = 1028;
template <int MODE>
__device__ __forceinline__ void norm_phase(const Ctx& c, int l, bool combine, LAS unsigned char* lds) {
    int tid_o = threadIdx.x; asm volatile("" : "+v"(tid_o));
    const int tid = tid_o, lane = tid & 63, wave = __builtin_amdgcn_readfirstlane(tid >> 6);
    LAS float* w8 = (LAS float*)lds; LAS int* cnt = (LAS int*)(lds + 8 * W8S * 4);
    float* h = (float*)(c.ws + WS_H); bf16* xn = (bf16*)(c.ws + WS_XN);
    const float* gain = MODE == 1 ? c.in[IN_NORM_MIX_G] + l * D : (MODE == 3 ? c.in[IN_NORM_FINAL_G] : c.in[IN_NORM_FFN_G] + l * D);
    if (MODE == 1 || MODE == 2) {
        const float* wsrc = MODE == 1 ? c.in[IN_W_IN] + (size_t)l * D * DIN + 2048 : c.in[IN_MOE_WR] + (size_t)(l >> 1) * D * NE; const int ldw = MODE == 1 ? DIN : NE;
        for (int i = tid; i < 8 * D; i += NTHR) { const int k = i >> 3, j = i & 7; w8[j * W8S + k] = wsrc[(size_t)k * ldw + j]; }
    }
    f32x4 gg[4];
#pragma unroll
    for (int j = 0; j < 4; ++j) gg[j] = *(const f32x4*)(gain + 4 * (lane + 64 * j));
    const int* pos = (const int*)(c.ws + WS_POS); const float* ew = (const float*)(c.ws + WS_EW); const bf16* Y = (const bf16*)(c.ws + WS_XG);
    for (int tb = opaque_bid(); tb < T / 64; tb += gridDim.x) {
        if (MODE == 2) { if (tid < 8) cnt[tid] = 0; }
        __syncthreads();
        for (int i = 0; i < 8; ++i) {
            const int t = tb * 64 + wave * 8 + i;
            float* hrow = h + (size_t)t * D; f32x4 v[4];
#pragma unroll
            for (int j = 0; j < 4; ++j) v[j] = *(const f32x4*)(hrow + 4 * (lane + 64 * j));
            if (combine) {
                const int p0 = pos[2 * t], p1 = pos[2 * t + 1]; const float w0 = ew[2 * t], w1 = ew[2 * t + 1];
#pragma unroll
                for (int j = 0; j < 4; ++j) { const u32x2 a = *(const u32x2*)(Y + (size_t)p0 * D + 4 * (lane + 64 * j)), b = *(const u32x2*)(Y + (size_t)p1 * D + 4 * (lane + 64 * j));
                    v[j][0] += w0 * bflo(a.x) + w1 * bflo(b.x); v[j][1] += w0 * bfhi(a.x) + w1 * bfhi(b.x); v[j][2] += w0 * bflo(a.y) + w1 * bflo(b.y); v[j][3] += w0 * bfhi(a.y) + w1 * bfhi(b.y); }
                if (MODE != 3) {
#pragma unroll
                    for (int j = 0; j < 4; ++j) *(f32x4*)(hrow + 4 * (lane + 64 * j)) = v[j]; }
            }
            float s = 0.f;
#pragma unroll
            for (int j = 0; j < 4; ++j) s += (v[j][0] * v[j][0] + v[j][1] * v[j][1]) + (v[j][2] * v[j][2] + v[j][3] * v[j][3]);
            const float r = rsqrtf(wave_sum(s) * (1.f / D) + EPS);
#pragma unroll
            for (int j = 0; j < 4; ++j) v[j] = v[j] * r * gg[j];
            if (MODE == 3) {
#pragma unroll
                for (int j = 0; j < 4; ++j) *(f32x4*)(c.out + (size_t)t * D + 4 * (lane + 64 * j)) = v[j];
            } else {
#pragma unroll
                for (int j = 0; j < 4; ++j) { u32x2 o; o.x = cvt_pk_bf16(v[j][0], v[j][1]); o.y = cvt_pk_bf16(v[j][2], v[j][3]); *(u32x2*)(xn + (size_t)t * D + 4 * (lane + 64 * j)) = o; }
            }
            if (MODE == 1 || MODE == 2) {
                float d8[8];
#pragma unroll
                for (int g = 0; g < 8; ++g) { float a = 0.f;
#pragma unroll
                    for (int j = 0; j < 4; ++j) { const f32x4 w = *(const LAS f32x4*)(w8 + g * W8S + 4 * (lane + 64 * j)); a += (v[j][0] * w[0] + v[j][1] * w[1]) + (v[j][2] * w[2] + v[j][3] * w[3]); }
                    d8[g] = wave_sum(a); }
                if (MODE == 1) {
                    float sel = d8[0];
#pragma unroll
                    for (int g = 1; g < 8; ++g) sel = (lane == g) ? d8[g] : sel;
                    if (lane < 8) ((float*)(c.ws + WS_IFP))[(size_t)t * 8 + lane] = sel + c.in[IN_ML_B_IF][l * 8 + lane];
                } else {
                    int i0 = 0; float v0 = d8[0];
#pragma unroll
                    for (int e = 1; e < NE; ++e) if (d8[e] > v0) { v0 = d8[e]; i0 = e; }
                    int i1 = -1; float v1 = -3.4e38f;
#pragma unroll
                    for (int e = 0; e < NE; ++e) if (e != i0 && d8[e] > v1) { v1 = d8[e]; i1 = e; }
                    if (lane == 0) { int* eidx = (int*)(c.ws + WS_EIDX); float* eww = (float*)(c.ws + WS_EW); eidx[2 * t] = i0; eidx[2 * t + 1] = i1;
                        const float w0 = 1.f / (1.f + __expf(v1 - v0)); eww[2 * t] = w0; eww[2 * t + 1] = 1.f - w0; __hip_atomic_fetch_add(&cnt[i0], 1, __ATOMIC_RELAXED, __HIP_MEMORY_SCOPE_WORKGROUP); __hip_atomic_fetch_add(&cnt[i1], 1, __ATOMIC_RELAXED, __HIP_MEMORY_SCOPE_WORKGROUP); }
                }
            }
        }
        if (MODE == 2) { __syncthreads(); if (tid < 8) ((int*)(c.ws + WS_BLKCNT))[tb * 8 + tid] = cnt[tid]; }
    }
}

__device__ __forceinline__ void moe_gather_phase(const Ctx& c, LAS unsigned char* lds) {
    int tid_o = threadIdx.x; asm volatile("" : "+v"(tid_o));
    const int tid = tid_o, lane = tid & 63, wave = __builtin_amdgcn_readfirstlane(tid >> 6);
    LAS int* tot = (LAS int*)lds; LAS int* bef = tot + 8; LAS int* off = tot + 16; LAS int* lpos = tot + 32;
    const int* blkcnt = (const int*)(c.ws + WS_BLKCNT); const int* eidx = (const int*)(c.ws + WS_EIDX); int* pos = (int*)(c.ws + WS_POS); int* meta = (int*)(c.ws + WS_META);
    const bf16* xn = (const bf16*)(c.ws + WS_XN); bf16* Xg = (bf16*)(c.ws + WS_XG);
    for (int tb = opaque_bid(); tb < T / 64; tb += gridDim.x) {
        __syncthreads();
        if (tid < 16) tot[tid] = 0;
        __syncthreads();
        { const int e = tid & 7, part = tid >> 3; int st = 0, sb = 0;
#pragma unroll
          for (int q = 0; q < 4; ++q) { const int b = part * 4 + q; const int v = blkcnt[b * 8 + e]; st += v; sb += (b < tb) ? v : 0; }
          __hip_atomic_fetch_add(&tot[e], st, __ATOMIC_RELAXED, __HIP_MEMORY_SCOPE_WORKGROUP); __hip_atomic_fetch_add(&bef[e], sb, __ATOMIC_RELAXED, __HIP_MEMORY_SCOPE_WORKGROUP); }
        __syncthreads();
        if (tid == 0) { int o = 0; for (int e = 0; e < NE; ++e) { off[e] = o; o += (tot[e] + 255) & ~255; } off[NE] = o; }
        __syncthreads();
        if (wave == 0) {
            const int t = tb * 64 + lane; const int e0 = eidx[2 * t], e1 = eidx[2 * t + 1]; int r0 = 0, r1 = 0; const unsigned long long lt = (1ull << lane) - 1ull;
#pragma unroll
            for (int e = 0; e < NE; ++e) { const unsigned long long m0 = __ballot(e0 == e), m1 = __ballot(e1 == e);
                if (e0 == e) r0 = __popcll(m0 & lt); if (e1 == e) r1 = __popcll(m0) + __popcll(m1 & lt); }
            const int p0 = off[e0] + bef[e0] + r0, p1 = off[e1] + bef[e1] + r1;
            pos[2 * t] = p0; pos[2 * t + 1] = p1; lpos[2 * lane] = p0; lpos[2 * lane + 1] = p1;
        }
        __syncthreads();
        for (int q = wave; q < 128; q += NWAVES) { const int t = tb * 64 + (q >> 1); const int p = lpos[q];
            const u32x4* s = (const u32x4*)(xn + (size_t)t * D); u32x4* d = (u32x4*)(Xg + (size_t)p * D); const u32x4 a = s[lane], b = s[lane + 64]; d[lane] = a; d[lane + 64] = b; }
        if (tb < NE) { const int r0 = off[tb] + tot[tb], r1 = off[tb + 1]; const u32x4 zz = {0u, 0u, 0u, 0u};
            for (int r = r0 + wave; r < r1; r += NWAVES) { u32x4* d = (u32x4*)(Xg + (size_t)r * D); d[lane] = zz; d[lane + 64] = zz; } }
        if (tb == 0) { if (tid < 9) meta[tid] = off[tid]; if (tid == 0) meta[16] = off[NE] >> 8;
            for (int tl = tid; tl < MAXT256; tl += NTHR) { const int r = tl * 256; int e = 0;
#pragma unroll
                for (int q = 0; q < NE; ++q) if (r >= off[q]) e = q;
                meta[32 + tl] = e; } }
    }
}

__global__ void __launch_bounds__(NTHR, 2) mega(Ctx c) {
    extern __shared__ __attribute__((aligned(16))) unsigned char lds_raw[];
    LAS unsigned char* lds = (LAS unsigned char*)lds_raw;
    const int tid = threadIdx.x;
    if (tid < 64) ((LAS unsigned*)(lds + MISC_OFF))[tid] = 0u;
    __syncthreads();
    XcdBarrier bar; bar.bar = (unsigned*)(c.ws + WS_CTL) + CW_BAR; bar.x = 0; bar.st = (volatile LAS unsigned*)(lds + MISC_OFF + 32);
    if (c.s_hi - c.s_lo > 1) bar = xcd_barrier_post((unsigned*)(c.ws + WS_CTL) + CW_BAR, (volatile LAS unsigned*)(lds + MISC_OFF + 32));
#define STEP_ON(s) (c.s_lo <= (s) && (s) < c.s_hi)
#define SEAM(s) do { if ((s) + 1 < c.s_hi) xcd_barrier(bar); } while (0)
    if (STEP_ON(0)) { cvt_phase(c, lds); SEAM(0); }
    for (int l = 0; l < DEPTH; ++l) {
        const int s0 = 1 + 10 * l; const bool moe = (l & 1) != 0; const int jl = l >> 1;
        if (s0 + 9 < c.s_lo || s0 >= c.s_hi) continue;
        if (STEP_ON(s0 + 0)) { norm_phase<1>(c, l, l == 2, lds); SEAM(s0 + 0); }
        if (STEP_ON(s0 + 1)) {
            pg8::Gemm g{(const bf16*)(c.ws + WS_XN), (const bf16*)(c.ws + WS_WIN) + (size_t)l * NZ * D, T, NZ, D}; pg8::StaticOrder S; S.init(T, NZ, gridDim.x, opaque_bid());
            pg8::EpiBf16 E{(bf16*)(c.ws + WS_Z), NZ};
            pg8::gemm_phase<pg8::EpiBf16, pg8::StaticOrder, true, true>(lds, g, S, E); SEAM(s0 + 1); }
        if (STEP_ON(s0 + 2)) { SEAM(s0 + 2); }
        if (STEP_ON(s0 + 3)) { SEAM(s0 + 3); }
        if (STEP_ON(s0 + 4)) { SEAM(s0 + 4); }
        if (STEP_ON(s0 + 5)) {
            pg8::Gemm g{(const bf16*)(c.ws + WS_Y), (const bf16*)(c.ws + WS_WOUT) + (size_t)l * D * D, T, D, D}; pg8::StaticOrder S; S.init(T, D, gridDim.x, opaque_bid());
            pg8::EpiResF32 E{(float*)(c.ws + WS_H), D};
            pg8::gemm_phase<pg8::EpiResF32, pg8::StaticOrder, true, true>(lds, g, S, E); SEAM(s0 + 5); }
        if (!moe) {
            if (STEP_ON(s0 + 6)) { norm_phase<0>(c, l, false, lds); SEAM(s0 + 6); }
            if (STEP_ON(s0 + 7)) {
                pg8::Gemm g{(const bf16*)(c.ws + WS_XN), (const bf16*)(c.ws + WS_WGU) + (size_t)jl * 2 * FFD * D, T, 2 * FFD, D}; pg8::StaticOrder S; S.init(T, 2 * FFD, gridDim.x, opaque_bid());
                pg8::EpiSwiglu E{(bf16*)(c.ws + WS_HID), FFD};
                pg8::gemm_phase<pg8::EpiSwiglu, pg8::StaticOrder, true, true>(lds, g, S, E); SEAM(s0 + 7); }
            if (STEP_ON(s0 + 8)) {
                pg8::Gemm g{(const bf16*)(c.ws + WS_HID), (const bf16*)(c.ws + WS_WD) + (size_t)jl * D * FFD, T, D, FFD}; pg8::StaticOrder S; S.init(T, D, gridDim.x, opaque_bid());
                pg8::EpiResF32 E{(float*)(c.ws + WS_H), D};
                pg8::gemm_phase<pg8::EpiResF32, pg8::StaticOrder, true, true>(lds, g, S, E); SEAM(s0 + 8); }
        } else {
            if (STEP_ON(s0 + 6)) { norm_phase<2>(c, l, false, lds); SEAM(s0 + 6); }
            if (STEP_ON(s0 + 7)) { moe_gather_phase(c, lds); SEAM(s0 + 7); }
            if (STEP_ON(s0 + 8)) {
                const int* meta = (const int*)(c.ws + WS_META); const int nM = __builtin_amdgcn_readfirstlane(meta[16]);
                pg8::Gemm g{(const bf16*)(c.ws + WS_XG), (const bf16*)(c.ws + WS_MWGU) + (size_t)jl * NE * 2 * FFE * D, nM * 256, 2 * FFE, D}; pg8::MoeOrder S; S.init(nM, 2 * FFE, gridDim.x, opaque_bid(), meta + 32);
                pg8::EpiSwiglu E{(bf16*)(c.ws + WS_MHID), FFE};
                pg8::gemm_phase<pg8::EpiSwiglu, pg8::MoeOrder, true, true>(lds, g, S, E); SEAM(s0 + 8); }
            if (STEP_ON(s0 + 9)) {
                const int* meta = (const int*)(c.ws + WS_META); const int nM = __builtin_amdgcn_readfirstlane(meta[16]);
                pg8::Gemm g{(const bf16*)(c.ws + WS_MHID), (const bf16*)(c.ws + WS_MWD) + (size_t)jl * NE * D * FFE, nM * 256, D, FFE}; pg8::MoeOrder S; S.init(nM, D, gridDim.x, opaque_bid(), meta + 32);
                pg8::EpiBf16 E{(bf16*)(c.ws + WS_XG), D};
                pg8::gemm_phase<pg8::EpiBf16, pg8::MoeOrder, true, true>(lds, g, S, E); SEAM(s0 + 9); }
        }
    }
    if (STEP_ON(41)) norm_phase<3>(c, 0, true, lds);
}

namespace nv {
__global__ __launch_bounds__(256) void mlstm_rec(const bf16* __restrict__ z, const float* __restrict__ ifp, float* __restrict__ ht) {
    const int wave = (blockIdx.x * 256 + threadIdx.x) >> 6, lane = threadIdx.x & 63;
    const int bh = wave >> 5, es = wave & 31, b = bh >> 2, h = bh & 3, e0 = es * 4;
    float C[2][4] = {}, n[2] = {0.f, 0.f};
    const float ksc = 0.08838834764831845f;
    for (int t0 = 0; t0 < SEQ; t0 += 8) {
        float kk[8][2], qq[8][2], vv[8][4], ii[8], ff[8];
#pragma unroll
        for (int j = 0; j < 8; ++j) { const size_t t = (size_t)(b * SEQ + t0 + j); const bf16* row = z + t * NZ;
            kk[j][0] = bf2f(row[ZK + h * DH + lane]) * ksc; kk[j][1] = bf2f(row[ZK + h * DH + lane + 64]) * ksc; qq[j][0] = bf2f(row[ZQ + h * DH + lane]); qq[j][1] = bf2f(row[ZQ + h * DH + lane + 64]);
#pragma unroll
            for (int e = 0; e < 4; ++e) vv[j][e] = bf2f(row[ZV + h * DH + e0 + e]);
            ii[j] = __expf(ifp[t * 8 + h]); ff[j] = sigmoidf_(ifp[t * 8 + 4 + h]); }
#pragma unroll
        for (int j = 0; j < 8; ++j) { float s[5] = {0.f, 0.f, 0.f, 0.f, 0.f};
#pragma unroll
            for (int d = 0; d < 2; ++d) { n[d] = ff[j] * n[d] + ii[j] * kk[j][d]; s[4] += n[d] * qq[j][d];
#pragma unroll
                for (int e = 0; e < 4; ++e) { C[d][e] = ff[j] * C[d][e] + ii[j] * kk[j][d] * vv[j][e]; s[e] += C[d][e] * qq[j][d]; } }
#pragma unroll
            for (int e = 0; e < 5; ++e) s[e] = wave_sum(s[e]);
            const float den = fmaxf(fabsf(s[4]), 1.f);
            if (lane == 0) { float* o = ht + (size_t)(b * SEQ + t0 + j) * MLW + h * DH + e0; o[0] = s[0] / den; o[1] = s[1] / den; o[2] = s[2] / den; o[3] = s[3] / den; } }
    }
}
__global__ __launch_bounds__(256) void ml_out(const bf16* __restrict__ z, const float* __restrict__ ht, const float* __restrict__ g, bf16* __restrict__ y) {
    const int w = (blockIdx.x * 256 + threadIdx.x) >> 6, lane = threadIdx.x & 63, t = w >> 2, h = w & 3;
    const float a = ht[(size_t)t * MLW + h * DH + lane], b = ht[(size_t)t * MLW + h * DH + lane + 64];
    const float r = rsqrtf(wave_sum(a * a + b * b) * (1.f / DH) + EPS);
    const float oa = bf2f(z[(size_t)t * NZ + ZO + h * DH + lane]), ob = bf2f(z[(size_t)t * NZ + ZO + h * DH + lane + 64]);
    y[(size_t)t * D + h * DH + lane] = f2bf(sigmoidf_(oa) * a * r * g[h * DH + lane]); y[(size_t)t * D + h * DH + lane + 64] = f2bf(sigmoidf_(ob) * b * r * g[h * DH + lane + 64]);
}
__global__ __launch_bounds__(512) void rg_gates(const bf16* __restrict__ z, const float* __restrict__ cw, const float* __restrict__ cb, const float* __restrict__ wa, const float* __restrict__ ba,
                                                const float* __restrict__ wx, const float* __restrict__ bx, const float* __restrict__ lam, float* __restrict__ av, float* __restrict__ uv) {
    __shared__ float xs[RGW]; const int t = blockIdx.x, c = threadIdx.x, tl = t % SEQ;
    float xc = cb[c];
#pragma unroll
    for (int j = 0; j < 4; ++j) { const int tt = tl - 3 + j; if (tt >= 0) xc += cw[j * RGW + c] * bf2f(z[(size_t)(t - 3 + j) * NZ + ZRX + c]); }
    xs[c] = xc; __syncthreads();
    const int g = c >> 6, jj = c & 63; float ra = ba[c], rx = bx[c];
    for (int i = 0; i < RGD; ++i) { const float xv = xs[g * RGD + i]; ra += xv * wa[(g * RGD + i) * RGD + jj]; rx += xv * wx[(g * RGD + i) * RGD + jj]; }
    const float r = sigmoidf_(ra), ig = sigmoidf_(rx);
    const float sp = log1pf(__expf(-lam[c])); const float la = -8.f * r * sp;
    av[(size_t)t * RGW + c] = __expf(la); uv[(size_t)t * RGW + c] = sqrtf(-expm1f(2.f * la)) * (ig * xc);
}
__global__ __launch_bounds__(256) void rg_scan(const float* __restrict__ av, float* __restrict__ uv) {
    const int id = blockIdx.x * 256 + threadIdx.x, b = id / RGW, c = id % RGW; float h = 0.f;
    for (int t0 = 0; t0 < SEQ; t0 += 8) { float a[8], u[8];
#pragma unroll
        for (int j = 0; j < 8; ++j) { a[j] = av[(size_t)(b * SEQ + t0 + j) * RGW + c]; u[j] = uv[(size_t)(b * SEQ + t0 + j) * RGW + c]; }
#pragma unroll
        for (int j = 0; j < 8; ++j) { h = a[j] * h + u[j]; uv[(size_t)(b * SEQ + t0 + j) * RGW + c] = h; } }
}
__global__ __launch_bounds__(256) void rg_out(const bf16* __restrict__ z, const float* __restrict__ hr, const float* __restrict__ g, bf16* __restrict__ y) {
    const int t = (blockIdx.x * 256 + threadIdx.x) >> 6, lane = threadIdx.x & 63; float v[8]; float s = 0.f;
#pragma unroll
    for (int j = 0; j < 8; ++j) { const int c = lane + 64 * j; v[j] = hr[(size_t)t * RGW + c] * gelu_tanh(bf2f(z[(size_t)t * NZ + ZRG + c])); s += v[j] * v[j]; }
    const float r = rsqrtf(wave_sum(s) * (1.f / RGW) + EPS);
#pragma unroll
    for (int j = 0; j < 8; ++j) { const int c = lane + 64 * j; y[(size_t)t * D + MLW + c] = f2bf(v[j] * r * g[c]); }
}
}

extern "C" void kernel_launch(void* const* d_in, const int* in_sizes, int n_in, void* d_out, int out_size, void* d_ws, size_t ws_size, hipStream_t stream) {
    static int ok = 0;
    if (ok == 0) {
        if (n_in != 23 || ws_size < WS_END || out_size != T * D) { fprintf(stderr, "kernel_launch: unexpected shapes (n_in %d, ws %zu, out %d)\n", n_in, ws_size, out_size); ok = -1; return; }
        if (hipFuncSetAttribute((const void*)mega, hipFuncAttributeMaxDynamicSharedMemorySize, LDS_BYTES) != hipSuccess) { fprintf(stderr, "kernel_launch: hipFuncSetAttribute failed\n"); ok = -1; return; }
        ok = 1;
    }
    if (ok < 0) return;
    unsigned char* ws = (unsigned char*)d_ws;
    (void)hipMemsetAsync(ws + WS_CTL, 0, 1 * MiB, stream);
    (void)hipMemcpyAsync(ws + WS_H, d_in[0], (size_t)T * D * 4, hipMemcpyDeviceToDevice, stream);
    Ctx base{}; for (int i = 0; i < 23; ++i) base.in[i] = (const float*)d_in[i]; base.out = (float*)d_out; base.ws = ws;
    auto run = [&](int lo, int hi) { Ctx a = base; a.s_lo = lo; a.s_hi = hi; hipLaunchKernelGGL(mega, dim3(256), dim3(NTHR), LDS_BYTES, stream, a); };
    const bf16* z = (const bf16*)(ws + WS_Z); bf16* y = (bf16*)(ws + WS_Y); const float* ifp = (const float*)(ws + WS_IFP);
    float* ht = (float*)(ws + WS_CTL_LOC); float* ra = (float*)(ws + WS_RA); float* ru = (float*)(ws + WS_RU);
    run(0, 1);
    for (int l = 0; l < DEPTH; ++l) {
        const int s0 = 1 + 10 * l;
        run(s0, s0 + 1); run(s0 + 1, s0 + 2);
        nv::mlstm_rec<<<128, 256, 0, stream>>>(z, ifp, ht);
        nv::ml_out<<<T, 256, 0, stream>>>(z, ht, (const float*)d_in[IN_ML_NORM_G] + l * MLW, y);
        nv::rg_gates<<<T, 512, 0, stream>>>(z, (const float*)d_in[IN_CONV_W] + l * 4 * RGW, (const float*)d_in[IN_CONV_B] + l * RGW, (const float*)d_in[IN_RG_W_A] + (size_t)l * RGB * RGD * RGD,
                                            (const float*)d_in[IN_RG_B_A] + l * RGW, (const float*)d_in[IN_RG_W_X] + (size_t)l * RGB * RGD * RGD, (const float*)d_in[IN_RG_B_X] + l * RGW, (const float*)d_in[IN_RG_LAM] + l * RGW, ra, ru);
        nv::rg_scan<<<BATCH * RGW / 256, 256, 0, stream>>>(ra, ru);
        nv::rg_out<<<T / 4, 256, 0, stream>>>(z, ru, (const float*)d_in[IN_RG_NORM_G] + l * RGW, y);
        run(s0 + 5, s0 + 6); run(s0 + 6, s0 + 7); run(s0 + 7, s0 + 8); run(s0 + 8, s0 + 9);
        if (l & 1) run(s0 + 9, s0 + 10);
    }
    run(41, 42);
}
```

```cpp
#include <hip/hip_runtime.h>
#include <cstdio>
#include <cstdint>

constexpr int D = 1024, BATCH = 4, SEQ = 4096, T = BATCH * SEQ, DEPTH = 4;
constexpr int MLW = 512, MLH = 4, DH = 128, RGW = 512, RGB = 8, RGD = 64;
constexpr int DIN = 3080, FFD = 2816, NE = 8, FFE = 3584;
constexpr int NZ = 3072;
constexpr int ZQ = 0, ZK = 512, ZV = 1024, ZO = 1536, ZRX = 2048, ZRG = 2560;
constexpr float EPS = 1e-6f;
constexpr int MAXROWS = 2 * T + NE * 256;
constexpr int MAXT256 = MAXROWS / 256;
constexpr int NWAVES = 8, NTHR = 512;

#define LAS __attribute__((address_space(3)))
#define GAS __attribute__((address_space(1)))
typedef unsigned short bf16;
typedef float f32x4 __attribute__((ext_vector_type(4)));
typedef float f32x2 __attribute__((ext_vector_type(2)));
typedef unsigned u32x4 __attribute__((ext_vector_type(4)));
typedef unsigned u32x2 __attribute__((ext_vector_type(2)));
typedef short bf16x8 __attribute__((ext_vector_type(8)));

__device__ __forceinline__ float wave_sum(float v) {
#pragma unroll
    for (int o = 1; o < 64; o <<= 1) v += __shfl_xor(v, o);
    return v;
}
__device__ __forceinline__ float sigmoidf_(float x) { return 1.f / (1.f + __expf(-x)); }
__device__ __forceinline__ float gelu_tanh(float x) { const float u = 0.7978845608028654f * (x + 0.044715f * x * x * x); return 0.5f * x * (1.f + tanhf(u)); }
__device__ __forceinline__ unsigned cvt_pk_bf16(float lo, float hi) { unsigned r; asm volatile("v_cvt_pk_bf16_f32 %0, %1, %2" : "=v"(r) : "v"(lo), "v"(hi)); return r; }
__device__ __forceinline__ float bf2f(unsigned short b) { return __uint_as_float(((unsigned)b) << 16); }
__device__ __forceinline__ float bflo(unsigned w) { return __uint_as_float(w << 16); }
__device__ __forceinline__ float bfhi(unsigned w) { return __uint_as_float(w & 0xffff0000u); }
__device__ __forceinline__ bf16 f2bf(float f) { return (bf16)(cvt_pk_bf16(f, 0.f) & 0xffffu); }

namespace pg8 {
#define PG8_LAS __attribute__((address_space(3)))
typedef unsigned short bf16_t;
constexpr int BM = 256, BK = 64, HALF = 128, HTB = HALF * BK * 2  , STAGE_BYTES = 8 * HTB, NXCD = 8, WGM = 8;
__host__ __device__ __forceinline__ int lds_byte(int r, int c) { const int st = (r >> 4) * 2 + (c >> 5), rr = r & 15, cc = c & 31, ob = rr * 64 + cc * 2; return st * 1024 + (ob ^ (((ob >> 9) & 1) << 5)); }
__host__ __device__ __forceinline__ void stage_rc(int b, int& R, int& C) { const int st = b / 1024, sb = b % 1024, swz = sb ^ (((sb >> 9) & 1) << 5); R = (st >> 1) * 16 + swz / 64; C = (st & 1) * 32 + (swz % 64) / 2; }
__host__ __device__ __forceinline__ int perm32(int rho) { const int n = rho >> 4, i = rho & 15; return 8 * (i >> 2) + 4 * n + (i & 3); }

struct Unit { int pm, pn, pb; };
struct Gemm { const bf16_t* A; const bf16_t* Bt; int M, N, K; };

struct StaticOrder {
    int nM, nN, nwg, G, c;
    __host__ __device__ void init(int M, int N, int G_, int c_) { nM = M / BM; nN = N / BM; nwg = nM * nN; G = G_; c = c_; }
    __host__ __device__ bool next(int i, Unit& u) const {
        const long L = (long)i * G + c; if (L >= nwg) return false;
        int wgid = (int)L; { const int q = nwg / NXCD, r = nwg % NXCD, xcd = wgid % NXCD, off = wgid / NXCD; wgid = (xcd < r ? xcd * (q + 1) : r * (q + 1) + (xcd - r) * q) + off; }
        const int nig = WGM * nN, gid = wgid / nig, fm = gid * WGM, gsz = (nM - fm) < WGM ? (nM - fm) : WGM;
        u.pm = fm + ((wgid % nig) % gsz); u.pn = (wgid % nig) / gsz; u.pb = u.pn; return true;
    }
    __device__ __forceinline__ void a_ready(const Unit&) const {}
    __device__ __forceinline__ void done(const Unit&) const {}
};
struct MoeOrder {
    int nM, nN, nwg, G, c; const int* texp;
    __device__ void init(int nM_, int N, int G_, int c_, const int* texp_) { nM = nM_; nN = N / BM; nwg = nM * nN; G = G_; c = c_; texp = texp_; }
    __device__ bool next(int i, Unit& u) const {
        const long L = (long)i * G + c; if (L >= nwg) return false;
        int wgid = (int)L; { const int q = nwg / NXCD, r = nwg % NXCD, xcd = wgid % NXCD, off = wgid / NXCD; wgid = (xcd < r ? xcd * (q + 1) : r * (q + 1) + (xcd - r) * q) + off; }
        const int nig = WGM * nN, gid = wgid / nig, fm = gid * WGM, gsz = (nM - fm) < WGM ? (nM - fm) : WGM;
        u.pm = fm + ((wgid % nig) % gsz); u.pn = (wgid % nig) / gsz; u.pb = __builtin_amdgcn_readfirstlane(texp[u.pm]) * nN + u.pn; return true;
    }
    __device__ __forceinline__ void a_ready(const Unit&) const {}
    __device__ __forceinline__ void done(const Unit&) const {}
};

struct EpiBf16 {
    static constexpr bool PERM = true, AFTER_DRAIN = false;
    bf16_t* O; int ldc;
    __device__ __forceinline__ void operator()(const f32x4 (&acc)[2][2][4][2], const Unit& u, int wr, int wc, int fr, int fq) const {
        const int row0 = u.pm * BM + wr * 64 + fr, col0 = u.pn * BM + wc * 32 + 8 * fq;
#pragma unroll
        for (int ai = 0; ai < 2; ++ai)
#pragma unroll
            for (int m = 0; m < 4; ++m) { bf16_t* rowp = O + (size_t)(row0 + ai * HALF + m * 16) * ldc + col0;
#pragma unroll
                for (int bj = 0; bj < 2; ++bj) { const f32x4 v0 = acc[ai][bj][m][0], v1 = acc[ai][bj][m][1];
                    u32x4 w; w.x = cvt_pk_bf16(v0[0], v0[1]); w.y = cvt_pk_bf16(v0[2], v0[3]); w.z = cvt_pk_bf16(v1[0], v1[1]); w.w = cvt_pk_bf16(v1[2], v1[3]);
                    *(u32x4*)(rowp + bj * HALF) = w; } }
    }
};
struct EpiResF32 {
    static constexpr bool PERM = false, AFTER_DRAIN = false;
    const float* Base; float* C; int ldc;
    __device__ __forceinline__ void operator()(const f32x4 (&acc)[2][2][4][2], const Unit& u, int wr, int wc, int fr, int fq) const {
        const int row0 = u.pm * BM + wr * 64 + fr, col0 = u.pn * BM + wc * 32 + 4 * fq;
#pragma unroll
        for (int ai = 0; ai < 2; ++ai)
#pragma unroll
            for (int m = 0; m < 4; ++m) { const size_t ro = (size_t)(row0 + ai * HALF + m * 16) * ldc + col0; float* rowp = C + ro; const float* basep = Base + ro;
                f32x4 o[2][2];
#pragma unroll
                for (int bj = 0; bj < 2; ++bj)
#pragma unroll
                    for (int n = 0; n < 2; ++n) o[bj][n] = *(const f32x4*)(basep + bj * HALF + n * 16);
#pragma unroll
                for (int bj = 0; bj < 2; ++bj)
#pragma unroll
                    for (int n = 0; n < 2; ++n) *(f32x4*)(rowp + bj * HALF + n * 16) = o[bj][n] + acc[ai][bj][m][n]; }
    }
};
struct EpiSwiglu {
    static constexpr bool PERM = true, AFTER_DRAIN = false;
    bf16_t* O; int ldc;
    __device__ __forceinline__ void operator()(const f32x4 (&acc)[2][2][4][2], const Unit& u, int wr, int wc, int fr, int fq) const {
        const int row0 = u.pm * BM + wr * 64 + fr, col0 = u.pn * HALF + wc * 32 + 8 * fq;
#pragma unroll
        for (int ai = 0; ai < 2; ++ai)
#pragma unroll
            for (int m = 0; m < 4; ++m) { bf16_t* rowp = O + (size_t)(row0 + ai * HALF + m * 16) * ldc + col0; float r[8];
#pragma unroll
                for (int n = 0; n < 2; ++n)
#pragma unroll
                    for (int j = 0; j < 4; ++j) { const float g = acc[ai][0][m][n][j], up = acc[ai][1][m][n][j]; r[4 * n + j] = g * __builtin_amdgcn_rcpf(1.f + __expf(-g)) * up; }
                u32x4 w; w.x = cvt_pk_bf16(r[0], r[1]); w.y = cvt_pk_bf16(r[2], r[3]); w.z = cvt_pk_bf16(r[4], r[5]); w.w = cvt_pk_bf16(r[6], r[7]);
                *(u32x4*)rowp = w; }
    }
};

template <class Epi, class Sched, bool ALIGN_EPI = false, bool SP2 = false>
__device__ __forceinline__ void gemm_phase(PG8_LAS unsigned char* lds, const Gemm g, const Sched& S, const Epi& E) {
    int tid_o = threadIdx.x; asm volatile("" : "+v"(tid_o));
    const int tid = tid_o, wid = __builtin_amdgcn_readfirstlane(tid >> 6), lane = tid & 63, wr = wid >> 2, wc = wid & 3, fr = lane & 15, fq = lane >> 4;
    const int K = g.K, nt = K / BK;
    unsigned voffA[2], voffB[2];
#pragma unroll
    for (int i = 0; i < 2; ++i) { int R, C; stage_rc(tid * 16 + i * 8192, R, C); const int Rb = Epi::PERM ? ((R & ~31) + perm32(R & 31)) : R;
        voffA[i] = (unsigned)(R * K + C) * 2u; voffB[i] = (unsigned)(Rb * K + C) * 2u; }
    const size_t kstep = (size_t)(BK * 2);
    const size_t hstep = (size_t)HALF * K * 2;
    const size_t tstep = 2 * hstep;
    const unsigned ldsw = (unsigned)wid * 1024u;
    const int aoff = lds_byte(wr * 64 + fr, fq * 8), boff = lds_byte(wc * 32 + fr, fq * 8);
#define PG8_SA(b, h) (((b) * 2 + (h)) * HTB)
#define PG8_SB(b, h) ((4 + (b) * 2 + (h)) * HTB)
#define PG8_STAGE(bufoff, gbase, voff) do { _Pragma("unroll") for (int _i = 0; _i < 2; ++_i) \
        __builtin_amdgcn_global_load_lds((const unsigned*)((const char*)(gbase) + (voff)[_i]), (PG8_LAS unsigned*)(lds + (bufoff) + ldsw + _i * 8192), 16, 0, 0); } while (0)
#define PG8_LDA(dst, b, h) do { _Pragma("unroll") for (int m = 0; m < 4; ++m) _Pragma("unroll") for (int k = 0; k < 2; ++k) dst[m][k] = *(const PG8_LAS bf16x8*)(lds + PG8_SA(b, h) + aoff + m * 2048 + k * 1024); } while (0)
#define PG8_LDB(dst, b, h) do { _Pragma("unroll") for (int n = 0; n < 2; ++n) _Pragma("unroll") for (int k = 0; k < 2; ++k) dst[n][k] = *(const PG8_LAS bf16x8*)(lds + PG8_SB(b, h) + boff + n * 2048 + k * 1024); } while (0)
#define PG8_MMA(ai, bj, At, Bt) do { __builtin_amdgcn_s_setprio(1); _Pragma("unroll") for (int m = 0; m < 4; ++m) _Pragma("unroll") for (int n = 0; n < 2; ++n) _Pragma("unroll") for (int k = 0; k < 2; ++k) \
        acc[ai][bj][m][n] = __builtin_amdgcn_mfma_f32_16x16x32_bf16(Bt[n][k], At[m][k], acc[ai][bj][m][n], 0, 0, 0); __builtin_amdgcn_s_setprio(0); } while (0)
#define PG8_WAIT_V(n) asm volatile("s_waitcnt vmcnt(" #n ")" ::: "memory")
#define PG8_WAIT_L(n) asm volatile("s_waitcnt lgkmcnt(" #n ")" ::: "memory")
#define PG8_BAR __builtin_amdgcn_s_barrier()
#define PG8_SCHED __builtin_amdgcn_sched_barrier(0)
    Unit cur, nxt; int ui = 0;
    if (!S.next(0, cur)) return;
    f32x4 acc[2][2][4][2];
#pragma unroll
    for (int a = 0; a < 2; ++a)
#pragma unroll
        for (int b = 0; b < 2; ++b)
#pragma unroll
            for (int m = 0; m < 4; ++m)
#pragma unroll
                for (int n = 0; n < 2; ++n) acc[a][b][m][n] = (f32x4){0.f, 0.f, 0.f, 0.f};
    bf16x8 At[4][2], B0[2][2], B1[2][2];
    const char* cA = (const char*)g.A + (size_t)cur.pm * tstep; const char* cB = (const char*)g.Bt + (size_t)cur.pb * tstep;
    S.a_ready(cur);
    if constexpr (SP2) {
        PG8_STAGE(PG8_SB(0, 0), cB, voffB); PG8_STAGE(PG8_SB(0, 1), cB + hstep, voffB); PG8_STAGE(PG8_SA(0, 0), cA, voffA); PG8_STAGE(PG8_SA(0, 1), cA + hstep, voffA);
        if (wr == 1) PG8_BAR;
        PG8_WAIT_V(2); PG8_BAR;
        PG8_STAGE(PG8_SB(1, 0), cB + kstep, voffB); PG8_STAGE(PG8_SA(1, 0), cA + kstep, voffA); PG8_STAGE(PG8_SB(1, 1), cB + hstep + kstep, voffB);
        PG8_WAIT_V(6); PG8_BAR;
    } else {
        PG8_STAGE(PG8_SB(0, 0), cB, voffB); PG8_STAGE(PG8_SA(0, 0), cA, voffA); PG8_STAGE(PG8_SB(0, 1), cB + hstep, voffB); PG8_STAGE(PG8_SA(0, 1), cA + hstep, voffA);
        if (wr == 1) PG8_BAR;
        PG8_WAIT_V(4); PG8_BAR;
        PG8_STAGE(PG8_SB(1, 0), cB + kstep, voffB); PG8_STAGE(PG8_SA(1, 0), cA + kstep, voffA); PG8_STAGE(PG8_SB(1, 1), cB + hstep + kstep, voffB);
        PG8_WAIT_V(6); PG8_BAR;
    }
    for (;;) {
        const bool has_next = S.next(ui + 1, nxt);
        const char* nA = has_next ? (const char*)g.A + (size_t)nxt.pm * tstep : cA; const char* nB = has_next ? (const char*)g.Bt + (size_t)nxt.pb * tstep : cB;
        for (int t = 0; t < nt; t += 2) {
            const bool last = (t == nt - 2);
            const char* a1 = cA + (size_t)(t + 1) * kstep;
            const char* a2 = last ? nA : cA + (size_t)(t + 2) * kstep; const char* b2 = last ? nB : cB + (size_t)(t + 2) * kstep;
            const char* a3 = a2 + kstep; const char* b3 = b2 + kstep;
            if (last && has_next) S.a_ready(nxt);
            if constexpr (SP2) {
            PG8_LDB(B0, 0, 0); PG8_LDB(B1, 0, 1); PG8_SCHED; PG8_LDA(At, 0, 0); PG8_STAGE(PG8_SA(1, 1), a1 + hstep, voffA);
            PG8_WAIT_V(8); PG8_WAIT_L(0); PG8_BAR; PG8_MMA(0, 0, At, B0); PG8_MMA(0, 1, At, B1); PG8_BAR; PG8_SCHED;
            PG8_LDA(At, 0, 1); PG8_STAGE(PG8_SB(0, 0), b2, voffB); PG8_STAGE(PG8_SB(0, 1), b2 + hstep, voffB); PG8_STAGE(PG8_SA(0, 0), a2, voffA);
            PG8_WAIT_V(8); PG8_WAIT_L(0); PG8_BAR; PG8_MMA(1, 0, At, B0); PG8_MMA(1, 1, At, B1); PG8_BAR; PG8_SCHED;
            PG8_LDB(B0, 1, 0); PG8_LDB(B1, 1, 1); PG8_SCHED; PG8_LDA(At, 1, 0); PG8_STAGE(PG8_SA(0, 1), a2 + hstep, voffA);
            PG8_WAIT_V(8); PG8_WAIT_L(0); PG8_BAR; PG8_MMA(0, 0, At, B0); PG8_MMA(0, 1, At, B1); PG8_BAR; PG8_SCHED;
            PG8_LDA(At, 1, 1); PG8_STAGE(PG8_SB(1, 0), b3, voffB); PG8_STAGE(PG8_SB(1, 1), b3 + hstep, voffB); PG8_STAGE(PG8_SA(1, 0), a3, voffA);
            PG8_WAIT_V(8); PG8_WAIT_L(0); PG8_BAR; PG8_MMA(1, 0, At, B0); PG8_MMA(1, 1, At, B1); PG8_BAR; PG8_SCHED;
            } else {
            PG8_LDB(B0, 0, 0); PG8_SCHED; PG8_LDA(At, 0, 0); PG8_STAGE(PG8_SA(1, 1), a1 + hstep, voffA);
            PG8_WAIT_L(8); PG8_BAR; PG8_WAIT_L(0); PG8_MMA(0, 0, At, B0); PG8_BAR; PG8_SCHED;
            PG8_LDB(B1, 0, 1); PG8_STAGE(PG8_SB(0, 0), b2, voffB);
            PG8_BAR; PG8_WAIT_L(0); PG8_MMA(0, 1, At, B1); PG8_BAR;
            PG8_LDA(At, 0, 1); PG8_STAGE(PG8_SA(0, 0), a2, voffA);
            PG8_BAR; PG8_WAIT_L(0); PG8_MMA(1, 0, At, B0); PG8_BAR; PG8_SCHED;
            PG8_STAGE(PG8_SB(0, 1), b2 + hstep, voffB);
            PG8_WAIT_V(6); PG8_BAR; PG8_MMA(1, 1, At, B1); PG8_BAR;
            PG8_LDB(B0, 1, 0); PG8_SCHED; PG8_LDA(At, 1, 0); PG8_STAGE(PG8_SA(0, 1), a2 + hstep, voffA);
            PG8_WAIT_L(8); PG8_BAR; PG8_WAIT_L(0); PG8_MMA(0, 0, At, B0); PG8_BAR; PG8_SCHED;
            PG8_LDB(B1, 1, 1); PG8_STAGE(PG8_SB(1, 0), b3, voffB);
            PG8_BAR; PG8_WAIT_L(0); PG8_MMA(0, 1, At, B1); PG8_BAR;
            PG8_LDA(At, 1, 1); PG8_STAGE(PG8_SA(1, 0), a3, voffA);
            PG8_BAR; PG8_WAIT_L(0); PG8_MMA(1, 0, At, B0); PG8_BAR; PG8_SCHED;
            PG8_STAGE(PG8_SB(1, 1), b3 + hstep, voffB);
            PG8_WAIT_V(6); PG8_BAR; PG8_MMA(1, 1, At, B1); PG8_BAR;
            }
        }
        if constexpr (ALIGN_EPI) { if (wr == 0) PG8_BAR; }
        if constexpr (!Epi::AFTER_DRAIN) { E(acc, cur, wr, wc, fr, fq); S.done(cur); }
        if (!has_next) break;
#pragma unroll
        for (int a = 0; a < 2; ++a)
#pragma unroll
            for (int b = 0; b < 2; ++b)
#pragma unroll
                for (int m = 0; m < 4; ++m)
#pragma unroll
                    for (int n = 0; n < 2; ++n) acc[a][b][m][n] = (f32x4){0.f, 0.f, 0.f, 0.f};
        cur = nxt; cA = nA; cB = nB; ++ui;
        if constexpr (ALIGN_EPI) { if (wr == 1) PG8_BAR; }
    }
    PG8_WAIT_V(0);
    if constexpr (!ALIGN_EPI) { if (wr == 0) PG8_BAR; }
    PG8_BAR;
    if constexpr (Epi::AFTER_DRAIN) { E.fused(acc, cur, wr, wc, fr, fq, lds, wid, lane); S.done(cur); }
#undef PG8_SA
#undef PG8_SB
#undef PG8_STAGE
#undef PG8_LDA
#undef PG8_LDB
#undef PG8_MMA
#undef PG8_WAIT_V
#undef PG8_WAIT_L
#undef PG8_BAR
#undef PG8_SCHED
}
}

constexpr size_t MiB = 1u << 20;
constexpr size_t WS_CTL = 0;
constexpr int CW_BAR = 4096;
constexpr size_t WS_IFP = 1 * MiB;
constexpr size_t WS_EIDX = WS_IFP + 512 * 1024;
constexpr size_t WS_EW = WS_EIDX + 128 * 1024;
constexpr size_t WS_POS = WS_EW + 128 * 1024;
constexpr size_t WS_BLKCNT = WS_POS + 128 * 1024;
constexpr size_t WS_META = WS_BLKCNT + 16 * 1024;
constexpr size_t WS_SMALL = 2 * MiB;
constexpr size_t WS_WRG = 4 * MiB;
constexpr size_t WS_WIN = 8 * MiB;
constexpr size_t WS_WOUT = 32 * MiB;
constexpr size_t WS_WGU = 40 * MiB;
constexpr size_t WS_WD = 62 * MiB;
constexpr size_t WS_MWGU = 74 * MiB;
constexpr size_t WS_MWD = 298 * MiB;
constexpr size_t WS_H = 410 * MiB;
constexpr size_t WS_XN = 474 * MiB;
constexpr size_t WS_R = 506 * MiB;
constexpr size_t WS_Z = WS_R;
constexpr size_t WS_Y = WS_R + 96 * MiB;
constexpr size_t WS_CTL_LOC = WS_R + 128 * MiB;
constexpr size_t WS_CTP = WS_R + 160 * MiB;
constexpr size_t WS_RA = WS_R + 176 * MiB;
constexpr size_t WS_RU = WS_R + 208 * MiB;
constexpr size_t WS_HID = WS_R;
constexpr size_t WS_XG = WS_R;
constexpr size_t WS_MHID = WS_R + 68 * MiB;
constexpr size_t WS_END = 812 * MiB;

constexpr int LDS_BYTES = 163840;
constexpr int MISC_OFF = LDS_BYTES - 256;

struct Ctx { const float* in[23]; float* out; unsigned char* ws; int s_lo, s_hi; };

#define XB_TMO      128
#define XB_XCNT(j)  (256  + 64 * (j))
#define XB_XSUB(j)  (1280 + 64 * (j))
#define XB_XGEN(j)  (2304 + 64 * (j))
#define XB_TOP      3328
#define XB_TOPGEN   3392
#define XCD_BAR_WORDS 3456
#define XB_SPIN_CAP (1u << 18)

__device__ __forceinline__ unsigned xb_ld(unsigned* p)              { return __hip_atomic_load(p, __ATOMIC_RELAXED, __HIP_MEMORY_SCOPE_AGENT); }
__device__ __forceinline__ unsigned xb_add(unsigned* p, unsigned v) { return __hip_atomic_fetch_add(p, v, __ATOMIC_RELAXED, __HIP_MEMORY_SCOPE_AGENT); }
__device__ __forceinline__ unsigned xb_xcc_id() { return (unsigned)__builtin_amdgcn_s_getreg((3 << 11) | 20) & 0xFu; }
#define XB_SPIN(cond, bar) do { unsigned _sp = 0; while (cond) { __builtin_amdgcn_s_sleep(1); \
    if ((++_sp & 255u) == 0u) { if (xb_ld(&(bar)[XB_TMO])) break; if (_sp > XB_SPIN_CAP) { atomicAdd(&(bar)[XB_TMO], 1u); break; } } } } while (0)

struct XcdBarrier {
    unsigned* bar; unsigned x;
    volatile LAS unsigned* st;
};

__device__ __forceinline__ XcdBarrier xcd_barrier_post(unsigned* bar, volatile LAS unsigned* st) {
    XcdBarrier b; b.bar = bar; b.x = xb_xcc_id(); b.st = st;
    if (threadIdx.x == 0) (void)xb_add(&bar[XB_XCNT(b.x)], 1u);
    return b;
}
__device__ __forceinline__ void xcd_barrier_complete(unsigned* bar, unsigned x, unsigned& nloc, unsigned& nx) {
    const unsigned G = gridDim.x * gridDim.y * gridDim.z;
    unsigned sum, cnt, mine, sp = 0u;
    for (;;) {
        sum = 0u; cnt = 0u; mine = 0u;
#pragma unroll
        for (unsigned j = 0; j < 16; ++j) { const unsigned c = xb_ld(&bar[XB_XCNT(j)]); sum += c; cnt += (c > 0u) ? 1u : 0u; mine = (j == x) ? c : mine; }
        if (sum == G) break;
        __builtin_amdgcn_s_sleep(1);
        if ((++sp & 255u) == 0u) { if (xb_ld(&bar[XB_TMO])) break; if (sp > XB_SPIN_CAP) { atomicAdd(&bar[XB_TMO], 1u); break; } }
    }
    nloc = mine > 0u ? mine : 1u; nx = cnt > 0u ? cnt : 1u;
}

__device__ __forceinline__ void xcd_barrier(const XcdBarrier& b) {
    asm volatile("s_waitcnt vmcnt(0)" ::: "memory");
    __syncthreads();
    if (threadIdx.x == 0) {
        unsigned* bar = b.bar;
        __builtin_amdgcn_s_waitcnt(0);
        unsigned nloc = b.st[0], nx = b.st[1];
        if (nloc == 0u) { xcd_barrier_complete(bar, b.x, nloc, nx); b.st[0] = nloc; b.st[1] = nx; }
        const unsigned old = xb_add(&bar[XB_XSUB(b.x)], 1u);
        const unsigned gen = old / nloc;
        if (old + 1u == (gen + 1u) * nloc) {
            __builtin_amdgcn_fence(__ATOMIC_RELEASE, "agent");
            asm volatile("s_waitcnt vmcnt(0)" ::: "memory");
            const unsigned og = xb_add(&bar[XB_TOP], 1u);
            const unsigned tg = og / nx;
            if (og + 1u == (tg + 1u) * nx) xb_add(&bar[XB_TOPGEN], 1u);
            else XB_SPIN(xb_ld(&bar[XB_TOPGEN]) == tg, bar);
            __builtin_amdgcn_fence(__ATOMIC_ACQUIRE, "agent");
            xb_add(&bar[XB_XGEN(b.x)], 1u);
            asm volatile("s_waitcnt vmcnt(0)" ::: "memory");
        } else {
            XB_SPIN(xb_ld(&bar[XB_XGEN(b.x)]) == gen, bar);
            __builtin_amdgcn_fence(__ATOMIC_ACQUIRE, "agent");
            asm volatile("s_waitcnt vmcnt(0)" ::: "memory");
        }
    }
    __syncthreads();
}

#ifndef MIX_FAST
#define MIX_FAST 1
#endif
#ifndef NV_ML
#define NV_ML 0
#endif
#ifndef NV_RG
#define NV_RG 0
#endif
__device__ __forceinline__ int opaque_bid() { int b = blockIdx.x; asm volatile("" : "+s"(b)); return b; }
#define IN_X 0
#define IN_NORM_MIX_G 1
#define IN_W_IN 2
#define IN_ML_B_IF 3
#define IN_ML_NORM_G 4
#define IN_CONV_W 5
#define IN_CONV_B 6
#define IN_RG_W_A 7
#define IN_RG_B_A 8
#define IN_RG_W_X 9
#define IN_RG_B_X 10
#define IN_RG_LAM 11
#define IN_RG_NORM_G 12
#define IN_W_OUT 13
#define IN_NORM_FFN_G 14
#define IN_FFN_WG 15
#define IN_FFN_WU 16
#define IN_FFN_WD 17
#define IN_MOE_WR 18
#define IN_MOE_WG 19
#define IN_MOE_WU 20
#define IN_MOE_WD 21
#define IN_NORM_FINAL_G 22

__device__ __forceinline__ void cvt_tile(const float* __restrict__ src, int ld, bf16* __restrict__ dst, int K, LAS float* scr, int lane) {
#pragma unroll 4
    for (int i = 0; i < 16; ++i) { const int kk = 4 * i + (lane >> 4); const f32x4 v = *(const f32x4*)(src + (size_t)kk * ld + (lane & 15) * 4);
        LAS float* s = scr + kk * 65 + (lane & 15) * 4; s[0] = v[0]; s[1] = v[1]; s[2] = v[2]; s[3] = v[3]; }
    asm volatile("s_waitcnt lgkmcnt(0)" ::: "memory");
    const int c = lane & 7;
#pragma unroll
    for (int j = 0; j < 8; ++j) { const int n = (lane >> 3) + 8 * j; const LAS float* s = scr + (8 * c) * 65 + n;
        u32x4 o; o.x = cvt_pk_bf16(s[0], s[65]); o.y = cvt_pk_bf16(s[130], s[195]); o.z = cvt_pk_bf16(s[260], s[325]); o.w = cvt_pk_bf16(s[390], s[455]);
        *(u32x4*)(dst + (size_t)n * K + 8 * c) = o; }
    asm volatile("s_waitcnt lgkmcnt(0)" ::: "memory");
}
constexpr int CV_IN = 4 * 768, CV_OUT = 4 * 256, CV_GU = 2 * 1408, CV_D = 2 * 704, CV_MGU = 16 * 1792, CV_MD = 16 * 896, CV_RG = 64;
constexpr int CV_TOTAL = CV_IN + CV_OUT + CV_GU + CV_D + CV_MGU + CV_MD + CV_RG;
__device__ __forceinline__ void cvt_phase(const Ctx& c, LAS unsigned char* lds) {
    int tid_o = threadIdx.x; asm volatile("" : "+v"(tid_o));
    const int tid = tid_o, lane = tid & 63, wave = __builtin_amdgcn_readfirstlane(tid >> 6);
    LAS float* scr = (LAS float*)(lds + wave * 16640);
    const int gw = opaque_bid() * NWAVES + wave, NGW = gridDim.x * NWAVES;
    for (int it0 = gw; it0 < CV_TOTAL; it0 += NGW) {
        int it = it0; const float* src; int ld, K; bf16* dst;
        if (it < CV_IN) { const int l = it / 768, r = it % 768, nt = r % 48, kt = r / 48, n0 = 64 * nt, k0 = 64 * kt, sc = n0 < 2048 ? n0 : n0 + 8;
            src = c.in[IN_W_IN] + (size_t)l * D * DIN + (size_t)k0 * DIN + sc; ld = DIN; K = D; dst = (bf16*)(c.ws + WS_WIN) + (size_t)l * NZ * D + (size_t)n0 * D + k0; }
        else if ((it -= CV_IN) < CV_OUT) { const int l = it / 256, r = it % 256, nt = r % 16, kt = r / 16, n0 = 64 * nt, k0 = 64 * kt;
            src = c.in[IN_W_OUT] + (size_t)l * D * D + (size_t)k0 * D + n0; ld = D; K = D; dst = (bf16*)(c.ws + WS_WOUT) + (size_t)l * D * D + (size_t)n0 * D + k0; }
        else if ((it -= CV_OUT) < CV_GU) { const int j = it / 1408, r = it % 1408, nt = r % 88, kt = r / 88, n0 = 64 * nt, k0 = 64 * kt, jj = n0 >> 8, cc = n0 & 255;
            src = (cc < 128 ? c.in[IN_FFN_WG] : c.in[IN_FFN_WU]) + (size_t)j * D * FFD + (size_t)k0 * FFD + jj * 128 + (cc & 127); ld = FFD; K = D;
            dst = (bf16*)(c.ws + WS_WGU) + (size_t)j * 2 * FFD * D + (size_t)n0 * D + k0; }
        else if ((it -= CV_GU) < CV_D) { const int j = it / 704, r = it % 704, nt = r % 16, kt = r / 16, n0 = 64 * nt, k0 = 64 * kt;
            src = c.in[IN_FFN_WD] + (size_t)j * FFD * D + (size_t)k0 * D + n0; ld = D; K = FFD; dst = (bf16*)(c.ws + WS_WD) + (size_t)j * D * FFD + (size_t)n0 * FFD + k0; }
        else if ((it -= CV_D) < CV_MGU) { const int je = it / 1792, r = it % 1792, nt = r % 112, kt = r / 112, n0 = 64 * nt, k0 = 64 * kt, jj = n0 >> 8, cc = n0 & 255;
            src = (cc < 128 ? c.in[IN_MOE_WG] : c.in[IN_MOE_WU]) + (size_t)je * D * FFE + (size_t)k0 * FFE + jj * 128 + (cc & 127); ld = FFE; K = D;
            dst = (bf16*)(c.ws + WS_MWGU) + (size_t)je * 2 * FFE * D + (size_t)n0 * D + k0; }
        else if ((it -= CV_MGU) < CV_MD) { const int je = it / 896, r = it % 896, nt = r % 16, kt = r / 16, n0 = 64 * nt, k0 = 64 * kt;
            src = c.in[IN_MOE_WD] + (size_t)je * FFE * D + (size_t)k0 * D + n0; ld = D; K = FFE; dst = (bf16*)(c.ws + WS_MWD) + (size_t)je * D * FFE + (size_t)n0 * FFE + k0; }
        else { it -= CV_MD; const int l = it >> 4, which = (it >> 3) & 1, g = it & 7;
            src = c.in[which ? IN_RG_W_X : IN_RG_W_A] + (size_t)(l * RGB + g) * RGD * RGD; ld = RGD; K = RGD; dst = (bf16*)(c.ws + WS_WRG) + (size_t)((l * 2 + which) * RGB + g) * RGD * RGD; }
        cvt_tile(src, ld, dst, K, scr, lane);
    }
}

constexpr int W8S = 1028;
template <int MODE>
__device__ __forceinline__ void norm_phase(const Ctx& c, int l, bool combine, LAS unsigned char* lds) {
    int tid_o = threadIdx.x; asm volatile("" : "+v"(tid_o));
    const int tid = tid_o, lane = tid & 63, wave = __builtin_amdgcn_readfirstlane(tid >> 6);
    LAS float* w8 = (LAS float*)lds; LAS int* cnt = (LAS int*)(lds + 8 * W8S * 4);
    float* h = (float*)(c.ws + WS_H); bf16* xn = (bf16*)(c.ws + WS_XN); const float* hsrc = (MODE == 1 && l == 0) ? c.in[IN_X] : h;
    const float* gain = MODE == 1 ? c.in[IN_NORM_MIX_G] + l * D : (MODE == 3 ? c.in[IN_NORM_FINAL_G] : c.in[IN_NORM_FFN_G] + l * D);
    if (MODE == 1 || MODE == 2) {
        const float* wsrc = MODE == 1 ? c.in[IN_W_IN] + (size_t)l * D * DIN + 2048 : c.in[IN_MOE_WR] + (size_t)(l >> 1) * D * NE; const int ldw = MODE == 1 ? DIN : NE;
        for (int i = tid; i < 8 * D; i += NTHR) { const int k = i >> 3, j = i & 7; w8[j * W8S + k] = wsrc[(size_t)k * ldw + j]; }
    }
    f32x4 gg[4];
#pragma unroll
    for (int j = 0; j < 4; ++j) gg[j] = *(const f32x4*)(gain + 4 * (lane + 64 * j));
    const int* pos = (const int*)(c.ws + WS_POS); const float* ew = (const float*)(c.ws + WS_EW); const bf16* Y = (const bf16*)(c.ws + WS_XG);
    for (int tb = opaque_bid(); tb < T / 64; tb += gridDim.x) {
        if (MODE == 2) { if (tid < 8) cnt[tid] = 0; }
        __syncthreads();
        for (int i = 0; i < 8; ++i) {
            const int t = tb * 64 + wave * 8 + i;
            float* hrow = h + (size_t)t * D; const float* hin = hsrc + (size_t)t * D; f32x4 v[4];
#pragma unroll
            for (int j = 0; j < 4; ++j) v[j] = *(const f32x4*)(hin + 4 * (lane + 64 * j));
            if (combine) {
                const int p0 = pos[2 * t], p1 = pos[2 * t + 1]; const float w0 = ew[2 * t], w1 = ew[2 * t + 1];
#pragma unroll
                for (int j = 0; j < 4; ++j) { const u32x2 a = *(const u32x2*)(Y + (size_t)p0 * D + 4 * (lane + 64 * j)), b = *(const u32x2*)(Y + (size_t)p1 * D + 4 * (lane + 64 * j));
                    v[j][0] += w0 * bflo(a.x) + w1 * bflo(b.x); v[j][1] += w0 * bfhi(a.x) + w1 * bfhi(b.x); v[j][2] += w0 * bflo(a.y) + w1 * bflo(b.y); v[j][3] += w0 * bfhi(a.y) + w1 * bfhi(b.y); }
                if (MODE != 3) {
#pragma unroll
                    for (int j = 0; j < 4; ++j) *(f32x4*)(hrow + 4 * (lane + 64 * j)) = v[j]; }
            }
            float s = 0.f;
#pragma unroll
            for (int j = 0; j < 4; ++j) s += (v[j][0] * v[j][0] + v[j][1] * v[j][1]) + (v[j][2] * v[j][2] + v[j][3] * v[j][3]);
            const float r = rsqrtf(wave_sum(s) * (1.f / D) + EPS);
#pragma unroll
            for (int j = 0; j < 4; ++j) v[j] = v[j] * r * gg[j];
            if (MODE == 3) {
#pragma unroll
                for (int j = 0; j < 4; ++j) *(f32x4*)(c.out + (size_t)t * D + 4 * (lane + 64 * j)) = v[j];
            } else {
#pragma unroll
                for (int j = 0; j < 4; ++j) { u32x2 o; o.x = cvt_pk_bf16(v[j][0], v[j][1]); o.y = cvt_pk_bf16(v[j][2], v[j][3]); *(u32x2*)(xn + (size_t)t * D + 4 * (lane + 64 * j)) = o; }
            }
            if (MODE == 1 || MODE == 2) {
                float d8[8];
#pragma unroll
                for (int g = 0; g < 8; ++g) { float a = 0.f;
#pragma unroll
                    for (int j = 0; j < 4; ++j) { const f32x4 w = *(const LAS f32x4*)(w8 + g * W8S + 4 * (lane + 64 * j)); a += (v[j][0] * w[0] + v[j][1] * w[1]) + (v[j][2] * w[2] + v[j][3] * w[3]); }
                    d8[g] = wave_sum(a); }
                if (MODE == 1) {
                    float sel = d8[0];
#pragma unroll
                    for (int g = 1; g < 8; ++g) sel = (lane == g) ? d8[g] : sel;
                    if (lane < 8) ((float*)(c.ws + WS_IFP))[(size_t)t * 8 + lane] = sel + c.in[IN_ML_B_IF][l * 8 + lane];
                } else {
                    int i0 = 0; float v0 = d8[0];
#pragma unroll
                    for (int e = 1; e < NE; ++e) if (d8[e] > v0) { v0 = d8[e]; i0 = e; }
                    int i1 = -1; float v1 = -3.4e38f;
#pragma unroll
                    for (int e = 0; e < NE; ++e) if (e != i0 && d8[e] > v1) { v1 = d8[e]; i1 = e; }
                    if (lane == 0) { int* eidx = (int*)(c.ws + WS_EIDX); float* eww = (float*)(c.ws + WS_EW); eidx[2 * t] = i0; eidx[2 * t + 1] = i1;
                        const float w0 = 1.f / (1.f + __expf(v1 - v0)); eww[2 * t] = w0; eww[2 * t + 1] = 1.f - w0; __hip_atomic_fetch_add(&cnt[i0], 1, __ATOMIC_RELAXED, __HIP_MEMORY_SCOPE_WORKGROUP); __hip_atomic_fetch_add(&cnt[i1], 1, __ATOMIC_RELAXED, __HIP_MEMORY_SCOPE_WORKGROUP); }
                }
            }
        }
        if (MODE == 2) { __syncthreads(); if (tid < 8) ((int*)(c.ws + WS_BLKCNT))[tb * 8 + tid] = cnt[tid]; }
    }
}

__device__ __forceinline__ void moe_gather_phase(const Ctx& c, LAS unsigned char* lds) {
    int tid_o = threadIdx.x; asm volatile("" : "+v"(tid_o));
    const int tid = tid_o, lane = tid & 63, wave = __builtin_amdgcn_readfirstlane(tid >> 6);
    LAS int* tot = (LAS int*)lds; LAS int* bef = tot + 8; LAS int* off = tot + 16; LAS int* lpos = tot + 32;
    const int* blkcnt = (const int*)(c.ws + WS_BLKCNT); const int* eidx = (const int*)(c.ws + WS_EIDX); int* pos = (int*)(c.ws + WS_POS); int* meta = (int*)(c.ws + WS_META);
    const bf16* xn = (const bf16*)(c.ws + WS_XN); bf16* Xg = (bf16*)(c.ws + WS_XG);
    for (int tb = opaque_bid(); tb < T / 64; tb += gridDim.x) {
        __syncthreads();
        if (tid < 16) tot[tid] = 0;
        __syncthreads();
        { const int e = tid & 7, part = tid >> 3; int st = 0, sb = 0;
#pragma unroll
          for (int q = 0; q < 4; ++q) { const int b = part * 4 + q; const int v = blkcnt[b * 8 + e]; st += v; sb += (b < tb) ? v : 0; }
          __hip_atomic_fetch_add(&tot[e], st, __ATOMIC_RELAXED, __HIP_MEMORY_SCOPE_WORKGROUP); __hip_atomic_fetch_add(&bef[e], sb, __ATOMIC_RELAXED, __HIP_MEMORY_SCOPE_WORKGROUP); }
        __syncthreads();
        if (tid == 0) { int o = 0; for (int e = 0; e < NE; ++e) { off[e] = o; o += (tot[e] + 255) & ~255; } off[NE] = o; }
        __syncthreads();
        if (wave == 0) {
            const int t = tb * 64 + lane; const int e0 = eidx[2 * t], e1 = eidx[2 * t + 1]; int r0 = 0, r1 = 0; const unsigned long long lt = (1ull << lane) - 1ull;
#pragma unroll
            for (int e = 0; e < NE; ++e) { const unsigned long long m0 = __ballot(e0 == e), m1 = __ballot(e1 == e);
                if (e0 == e) r0 = __popcll(m0 & lt); if (e1 == e) r1 = __popcll(m0) + __popcll(m1 & lt); }
            const int p0 = off[e0] + bef[e0] + r0, p1 = off[e1] + bef[e1] + r1;
            pos[2 * t] = p0; pos[2 * t + 1] = p1; lpos[2 * lane] = p0; lpos[2 * lane + 1] = p1;
        }
        __syncthreads();
        for (int q = wave; q < 128; q += NWAVES) { const int t = tb * 64 + (q >> 1); const int p = lpos[q];
            const u32x4* s = (const u32x4*)(xn + (size_t)t * D); u32x4* d = (u32x4*)(Xg + (size_t)p * D); const u32x4 a = s[lane], b = s[lane + 64]; d[lane] = a; d[lane + 64] = b; }
        if (tb < NE) { const int r0 = off[tb] + tot[tb], r1 = off[tb + 1]; const u32x4 zz = {0u, 0u, 0u, 0u};
            for (int r = r0 + wave; r < r1; r += NWAVES) { u32x4* d = (u32x4*)(Xg + (size_t)r * D); d[lane] = zz; d[lane + 64] = zz; } }
        if (tb == 0) { if (tid < 9) meta[tid] = off[tid]; if (tid == 0) meta[16] = off[NE] >> 8;
            for (int tl = tid; tl < MAXT256; tl += NTHR) { const int r = tl * 256; int e = 0;
#pragma unroll
                for (int q = 0; q < NE; ++q) if (r >= off[q]) e = q;
                meta[32 + tl] = e; } }
    }
}


typedef short s16x4 __attribute__((ext_vector_type(4)));
constexpr size_t SM_CG = WS_SMALL, SM_CM = WS_SMALL + 4096, SM_MP = WS_SMALL + 8192;
constexpr size_t SM_NL = WS_SMALL + 65536, SM_NP = WS_SMALL + 327680;
constexpr size_t SM_RGA = WS_SMALL + 589824, SM_RGH = WS_SMALL + 1114112;
constexpr size_t SM_RGC = 5 * MiB;
constexpr int TROW = 272;
constexpr int TILE_B = 128 * TROW;
constexpr float KSC = 0.08838834764831845f;

__device__ __forceinline__ float wscan_add(float v, int lane) {
#pragma unroll
    for (int o = 1; o < 64; o <<= 1) { const float t = __shfl_up(v, o); v = (lane >= o) ? v + t : v; }
    return v;
}
__device__ __forceinline__ float wscan_max(float v, int lane) {
#pragma unroll
    for (int o = 1; o < 64; o <<= 1) { const float t = __shfl_up(v, o); v = (lane >= o) ? fmaxf(v, t) : v; }
    return v;
}
__device__ __forceinline__ float wave_max(float v) {
#pragma unroll
    for (int o = 1; o < 64; o <<= 1) v = fmaxf(v, __shfl_xor(v, o));
    return v;
}
__device__ __forceinline__ float logsigmoidf_(float x) { return -log1pf(__expf(-x)); }
__device__ __forceinline__ void stage_tile(const bf16* __restrict__ g, int ldg, LAS unsigned char* tile, int tid) {
#pragma unroll
    for (int i = 0; i < 4; ++i) { const int ch = tid + NTHR * i, r = ch >> 4, c16 = ch & 15; const u32x4 v = *(const u32x4*)(g + (size_t)r * ldg + c16 * 8); *(LAS u32x4*)(tile + r * TROW + c16 * 16) = v; }
}
__device__ __forceinline__ bf16x8 frag_row(const LAS unsigned char* tile, int row, int ks, int fq) { return *(const LAS bf16x8*)(tile + row * TROW + (32 * ks + 8 * fq) * 2); }
__device__ __forceinline__ bf16x8 frag_tr(const LAS unsigned char* tile, int n0, int ks, int lane) {
    const int i16 = lane & 15, q = i16 >> 2, p = i16 & 3, fq = lane >> 4;
    const LAS unsigned char* a = tile + (32 * ks + 8 * fq + q) * TROW + n0 * 2 + 8 * p;
    const s16x4 lo = __builtin_amdgcn_ds_read_tr16_b64_v4i16((LAS s16x4*)a), hi = __builtin_amdgcn_ds_read_tr16_b64_v4i16((LAS s16x4*)(a + 4 * TROW));
    return __builtin_shufflevector(lo, hi, 0, 1, 2, 3, 4, 5, 6, 7);
}
#define MFMA16(a, b, c) __builtin_amdgcn_mfma_f32_16x16x32_bf16((a), (b), (c), 0, 0, 0)

__device__ __forceinline__ void mix_c_mlstm(const Ctx& c, int u, LAS unsigned char* lds, int tid, int lane, int wave) {
    const int bh = u >> 5, ck = u & 31, b = bh >> 2, h = bh & 3; const size_t t0 = (size_t)b * SEQ + (size_t)ck * 128;
    LAS unsigned char* TKW = lds; LAS unsigned char* TV = lds + TILE_B; LAS float* fw = (LAS float*)(lds + 2 * TILE_B); LAS float* np = fw + 128;
    const float* ifp = (const float*)(c.ws + WS_IFP); const bf16* z = (const bf16*)(c.ws + WS_Z);
    if (wave == 0) {
        const float x0 = ifp[(t0 + 2 * lane) * 8 + 4 + h], x1 = ifp[(t0 + 2 * lane + 1) * 8 + 4 + h];
        const float lf0 = logsigmoidf_(x0), lf1 = logsigmoidf_(x1), s = lf0 + lf1, inc = wscan_add(s, lane), ex = inc - s, b0 = ex + lf0, b1 = b0 + lf1;
        const float g = __shfl(inc, 63);
        const float li0 = ifp[(t0 + 2 * lane) * 8 + h], li1 = ifp[(t0 + 2 * lane + 1) * 8 + h];
        const float a0 = g - b0 + li0, a1 = g - b1 + li1, m = wave_max(fmaxf(a0, a1));
        fw[2 * lane] = __expf(a0 - m) * KSC; fw[2 * lane + 1] = __expf(a1 - m) * KSC;
        if (lane == 0) { ((float*)(c.ws + SM_CG))[bh * 32 + ck] = g; ((float*)(c.ws + SM_CM))[bh * 32 + ck] = m; }
    }
    __syncthreads();
#pragma unroll
    for (int i = 0; i < 4; ++i) { const int ch = tid + NTHR * i, r = ch >> 4, c16 = ch & 15; const bf16* row = z + (t0 + r) * NZ + h * DH + c16 * 8;
        const u32x4 kv = *(const u32x4*)(row + ZK), vv = *(const u32x4*)(row + ZV); const float sc = fw[r]; u32x4 ko;
        ko.x = cvt_pk_bf16(bflo(kv.x) * sc, bfhi(kv.x) * sc); ko.y = cvt_pk_bf16(bflo(kv.y) * sc, bfhi(kv.y) * sc); ko.z = cvt_pk_bf16(bflo(kv.z) * sc, bfhi(kv.z) * sc); ko.w = cvt_pk_bf16(bflo(kv.w) * sc, bfhi(kv.w) * sc);
        *(LAS u32x4*)(TKW + r * TROW + c16 * 16) = ko; *(LAS u32x4*)(TV + r * TROW + c16 * 16) = vv; }
    __syncthreads();
    { const int d = tid & 127, q = tid >> 7; float s = 0.f;
#pragma unroll 8
      for (int l = 32 * q; l < 32 * q + 32; ++l) s += bf2f(*(const LAS bf16*)(TKW + l * TROW + d * 2));
      np[q * 128 + d] = s; }
    const int wr = wave >> 2, wc = wave & 3, fr = lane & 15, fq = lane >> 4;
    f32x4 acc[4][2];
#pragma unroll
    for (int i = 0; i < 4; ++i)
#pragma unroll
        for (int j = 0; j < 2; ++j) acc[i][j] = (f32x4){0.f, 0.f, 0.f, 0.f};
#pragma unroll
    for (int ks = 0; ks < 4; ++ks) { bf16x8 A[4], B[2];
#pragma unroll
        for (int dt = 0; dt < 4; ++dt) A[dt] = frag_tr(TKW, 64 * wr + 16 * dt, ks, lane);
#pragma unroll
        for (int et = 0; et < 2; ++et) B[et] = frag_tr(TV, 32 * wc + 16 * et, ks, lane);
#pragma unroll
        for (int dt = 0; dt < 4; ++dt)
#pragma unroll
            for (int et = 0; et < 2; ++et) acc[dt][et] = MFMA16(A[dt], B[et], acc[dt][et]); }
    float* CTL = (float*)(c.ws + WS_CTL_LOC) + ((size_t)(bh * 32 + ck) << 14);
#pragma unroll
    for (int dt = 0; dt < 4; ++dt)
#pragma unroll
        for (int et = 0; et < 2; ++et) *(f32x4*)(CTL + (size_t)(32 * wc + 16 * et + fr) * 128 + 64 * wr + 16 * dt + 4 * fq) = acc[dt][et];
    __syncthreads();
    if (tid < 128) ((float*)(c.ws + SM_NL))[(size_t)(bh * 32 + ck) * 128 + tid] = (np[tid] + np[128 + tid]) + (np[256 + tid] + np[384 + tid]);
    __syncthreads();
}

__device__ __forceinline__ void mix_c_rg(const Ctx& c, int l, int u, LAS unsigned char* lds, int lane, int wave) {
    const int b = u >> 6, ck = u & 63, g = wave; const size_t t0 = (size_t)b * SEQ + (size_t)ck * 64;
    LAS unsigned char* XC = lds + wave * 9216;
    const bf16* z = (const bf16*)(c.ws + WS_Z); const int cch = 64 * g + lane;
    { const float* cw = c.in[IN_CONV_W] + l * 4 * RGW; const float w0 = cw[cch], w1 = cw[RGW + cch], w2 = cw[2 * RGW + cch], w3 = cw[3 * RGW + cch], cb = c.in[IN_CONV_B][l * RGW + cch];
      float xm3 = 0.f, xm2 = 0.f, xm1 = 0.f;
      if (ck != 0) { xm3 = bf2f(z[(t0 - 3) * NZ + ZRX + cch]); xm2 = bf2f(z[(t0 - 2) * NZ + ZRX + cch]); xm1 = bf2f(z[(t0 - 1) * NZ + ZRX + cch]); }
#pragma unroll 16
      for (int t = 0; t < 64; ++t) { const float x = bf2f(z[(t0 + t) * NZ + ZRX + cch]); const float xc = cb + w0 * xm3 + w1 * xm2 + w2 * xm1 + w3 * x;
          *(LAS bf16*)(XC + t * 144 + lane * 2) = f2bf(xc); xm3 = xm2; xm2 = xm1; xm1 = x; } }
    const int l15 = lane & 15, fq = lane >> 4;
    bf16x8 Af[4][2];
#pragma unroll
    for (int m = 0; m < 4; ++m)
#pragma unroll
        for (int ks = 0; ks < 2; ++ks) Af[m][ks] = *(const LAS bf16x8*)(XC + (16 * m + l15) * 144 + (32 * ks + 8 * fq) * 2);
    const bf16* WTa = (const bf16*)(c.ws + WS_WRG) + (size_t)((l * 2 + 0) * RGB + g) * RGD * RGD; const bf16* WTx = (const bf16*)(c.ws + WS_WRG) + (size_t)((l * 2 + 1) * RGB + g) * RGD * RGD;
    float* RA = (float*)(c.ws + WS_RA); float* RU = (float*)(c.ws + WS_RU);
#pragma unroll
    for (int n = 0; n < 4; ++n) {
        const int jo = 16 * n + l15, cc = 64 * g + jo;
        f32x4 aa[4], ax[4];
#pragma unroll
        for (int m = 0; m < 4; ++m) { aa[m] = (f32x4){0.f, 0.f, 0.f, 0.f}; ax[m] = (f32x4){0.f, 0.f, 0.f, 0.f}; }
#pragma unroll
        for (int ks = 0; ks < 2; ++ks) { const bf16x8 Ba = *(const bf16x8*)(WTa + jo * RGD + 32 * ks + 8 * fq), Bx = *(const bf16x8*)(WTx + jo * RGD + 32 * ks + 8 * fq);
#pragma unroll
            for (int m = 0; m < 4; ++m) { aa[m] = MFMA16(Af[m][ks], Ba, aa[m]); ax[m] = MFMA16(Af[m][ks], Bx, ax[m]); } }
        const float ba = c.in[IN_RG_B_A][l * RGW + cc], bx = c.in[IN_RG_B_X][l * RGW + cc], sp8 = -8.f * log1pf(__expf(-c.in[IN_RG_LAM][l * RGW + cc]));
        float cA[4][4], hL[4][4], SA[4], SH[4];
#pragma unroll
        for (int m = 0; m < 4; ++m) { float Ar = 1.f, Hr = 0.f;
#pragma unroll
            for (int r = 0; r < 4; ++r) { const int t = 16 * m + 4 * fq + r;
                const float la = sp8 * sigmoidf_(aa[m][r] + ba), a = __expf(la), ig = sigmoidf_(ax[m][r] + bx), xcv = bf2f(*(const LAS bf16*)(XC + t * 144 + jo * 2));
                const float uu = sqrtf(-expm1f(2.f * la)) * (ig * xcv);
                Hr = a * Hr + uu; Ar *= a; cA[m][r] = Ar; hL[m][r] = Hr; }
            SA[m] = Ar; SH[m] = Hr; }
        float CA = 1.f, CH = 0.f;
#pragma unroll
        for (int m = 0; m < 4; ++m) {
            float IA = SA[m], IH = SH[m];
            { const float Ap = __shfl_up(IA, 16), Hp = __shfl_up(IH, 16); if (fq >= 1) { IH = IA * Hp + IH; IA = IA * Ap; } }
            { const float Ap = __shfl_up(IA, 32), Hp = __shfl_up(IH, 32); if (fq >= 2) { IH = IA * Hp + IH; IA = IA * Ap; } }
            float EA = __shfl_up(IA, 16), EH = __shfl_up(IH, 16); if (fq == 0) { EA = 1.f; EH = 0.f; }
            const float TA = __shfl(IA, l15 + 48), TH = __shfl(IH, l15 + 48);
            const float PA = CA * EA, PH = EA * CH + EH;
#pragma unroll
            for (int r = 0; r < 4; ++r) { const size_t t = t0 + 16 * m + 4 * fq + r; RA[t * RGW + cc] = PA * cA[m][r]; RU[t * RGW + cc] = hL[m][r] + cA[m][r] * PH; }
            CH = TA * CH + TH; CA = CA * TA;
        }
        if (fq == 0) { ((float*)(c.ws + SM_RGA))[(size_t)(b * 64 + ck) * RGW + cc] = CA; ((float*)(c.ws + SM_RGH))[(size_t)(b * 64 + ck) * RGW + cc] = CH; }
    }
}

__device__ __forceinline__ void mix_d(const Ctx& c, LAS unsigned char* lds, int tid, int lane, int wave) {
    for (int w = opaque_bid(); w < 256; w += gridDim.x) {
        const int bh = w >> 4, sl = w & 15; LAS float* sg = (LAS float*)lds; LAS float* sm = sg + 32;
        __syncthreads();
        if (tid < 32) { sg[tid] = ((const float*)(c.ws + SM_CG))[bh * 32 + tid]; sm[tid] = ((const float*)(c.ws + SM_CM))[bh * 32 + tid]; }
        __syncthreads();
        const int idx = tid * 2, el = idx >> 7, d = idx & 127; const size_t off = (size_t)(8 * sl + el) * 128 + d;
        const float* CTL = (const float*)(c.ws + WS_CTL_LOC) + ((size_t)(bh * 32) << 14) + off; bf16* CTP = (bf16*)(c.ws + WS_CTP) + ((size_t)(bh * 32) << 14) + off;
        const bool nown = (sl == 0 && tid < 128);
        const float* NL = (const float*)(c.ws + SM_NL) + (size_t)(bh * 32) * 128 + (tid & 127); float* NP = (float*)(c.ws + SM_NP) + (size_t)(bh * 32) * 128 + (tid & 127);
        f32x2 ld[32]; float nl[32];
#pragma unroll
        for (int ck = 0; ck < 32; ++ck) { ld[ck] = *(const f32x2*)(CTL + ((size_t)ck << 14)); nl[ck] = nown ? NL[ck * 128] : 0.f; }
        f32x2 st = {0.f, 0.f}; float nst = 0.f, m = 0.f;
#pragma unroll
        for (int ck = 0; ck < 32; ++ck) {
            *(unsigned*)(CTP + ((size_t)ck << 14)) = cvt_pk_bf16(st.x, st.y);
            if (nown) NP[ck * 128] = nst;
            if (sl == 0 && tid == 0) ((float*)(c.ws + SM_MP))[bh * 32 + ck] = m;
            const float g = sg[ck], ml = sm[ck], mn = fmaxf(g + m, ml), so = __expf(g + m - mn), sc = __expf(ml - mn);
            st = st * so + ld[ck] * sc; nst = nst * so + nl[ck] * sc; m = mn;
        }
    }
    for (int gw = opaque_bid() * NWAVES + wave; gw < BATCH * RGW; gw += gridDim.x * NWAVES) {
        const int b = gw >> 9, ch = gw & 511; const size_t o = (size_t)(b * 64 + lane) * RGW + ch;
        float A = ((const float*)(c.ws + SM_RGA))[o], H = ((const float*)(c.ws + SM_RGH))[o];
#pragma unroll
        for (int s = 1; s < 64; s <<= 1) { const float Ap = __shfl_up(A, s), Hp = __shfl_up(H, s); if (lane >= s) { H = A * Hp + H; A = A * Ap; } }
        float cin = __shfl_up(H, 1); if (lane == 0) cin = 0.f;
        ((float*)(c.ws + SM_RGC))[o] = cin;
    }
}

__device__ __forceinline__ void mix_e_mlstm(const Ctx& c, int l, int u, LAS unsigned char* lds, int tid, int lane, int wave) {
    const int bh = u >> 5, ck = u & 31, b = bh >> 2, h = bh & 3; const size_t t0 = (size_t)b * SEQ + (size_t)ck * 128;
    LAS unsigned char* TQ = lds; LAS unsigned char* TK = lds + TILE_B; LAS unsigned char* TV = lds + 2 * TILE_B; LAS unsigned char* TC = lds + 3 * TILE_B; LAS unsigned char* TS = TK;
    LAS float* fb = (LAS float*)(lds + 4 * TILE_B); LAS float* fcs = fb + 128; LAS float* fpm = fb + 256; LAS float* fisc = fb + 384; LAS float* fqn = fb + 512; LAS float* fnp = fb + 640;
    LAS float* pden = fb + 768; LAS float* pss = fb + 1280;
    const float* ifp = (const float*)(c.ws + WS_IFP); const bf16* z = (const bf16*)(c.ws + WS_Z);
    if (wave == 0) {
        const float x0 = ifp[(t0 + 2 * lane) * 8 + 4 + h], x1 = ifp[(t0 + 2 * lane + 1) * 8 + 4 + h];
        const float lf0 = logsigmoidf_(x0), lf1 = logsigmoidf_(x1), s = lf0 + lf1, inc = wscan_add(s, lane), ex = inc - s, b0 = ex + lf0, b1 = b0 + lf1;
        const float li0 = ifp[(t0 + 2 * lane) * 8 + h], li1 = ifp[(t0 + 2 * lane + 1) * 8 + h];
        const float cs0 = li0 - b0, cs1 = li1 - b1, p1 = fmaxf(cs0, cs1), incm = wscan_max(p1, lane);
        float exm = __shfl_up(incm, 1); if (lane == 0) exm = -3.0e38f;
        const float mp = ((const float*)(c.ws + SM_MP))[bh * 32 + ck];
        const float pm0 = fmaxf(fmaxf(exm, cs0), mp), pm1 = fmaxf(fmaxf(exm, p1), mp);
        fb[2 * lane] = b0; fb[2 * lane + 1] = b1; fcs[2 * lane] = cs0; fcs[2 * lane + 1] = cs1; fpm[2 * lane] = pm0; fpm[2 * lane + 1] = pm1;
        fisc[2 * lane] = __expf(mp - pm0); fisc[2 * lane + 1] = __expf(mp - pm1);
    }
    stage_tile(z + t0 * NZ + ZQ + h * DH, NZ, TQ, tid); stage_tile(z + t0 * NZ + ZK + h * DH, NZ, TK, tid); stage_tile(z + t0 * NZ + ZV + h * DH, NZ, TV, tid);
    stage_tile((const bf16*)(c.ws + WS_CTP) + ((size_t)(bh * 32 + ck) << 14), 128, TC, tid);
    if (tid < 128) fnp[tid] = ((const float*)(c.ws + SM_NP))[(size_t)(bh * 32 + ck) * 128 + tid];
    __syncthreads();
    { const int row = tid >> 2, qt = tid & 3; float s = 0.f;
#pragma unroll
      for (int i = 0; i < 4; ++i) { const u32x4 qv = *(const LAS u32x4*)(TQ + row * TROW + (32 * qt + 8 * i) * 2); const LAS float* nn = fnp + 32 * qt + 8 * i;
          s += bflo(qv.x) * nn[0] + bfhi(qv.x) * nn[1] + bflo(qv.y) * nn[2] + bfhi(qv.y) * nn[3] + bflo(qv.z) * nn[4] + bfhi(qv.z) * nn[5] + bflo(qv.w) * nn[6] + bfhi(qv.w) * nn[7]; }
      s += __shfl_xor(s, 1); s += __shfl_xor(s, 2); if (qt == 0) fqn[row] = s; }
    const int wr = wave >> 2, wc = wave & 3, fr = lane & 15, fq = lane >> 4;
    f32x4 aS[4][2];
#pragma unroll
    for (int i = 0; i < 4; ++i)
#pragma unroll
        for (int j = 0; j < 2; ++j) aS[i][j] = (f32x4){0.f, 0.f, 0.f, 0.f};
#pragma unroll
    for (int ks = 0; ks < 4; ++ks) { bf16x8 A[4], B[2];
#pragma unroll
        for (int m = 0; m < 4; ++m) A[m] = frag_row(TQ, 64 * wr + 16 * m + fr, ks, fq);
#pragma unroll
        for (int n = 0; n < 2; ++n) B[n] = frag_row(TK, 32 * wc + 16 * n + fr, ks, fq);
#pragma unroll
        for (int m = 0; m < 4; ++m)
#pragma unroll
            for (int n = 0; n < 2; ++n) aS[m][n] = MFMA16(B[n], A[m], aS[m][n]); }
    __syncthreads();
#pragma unroll
    for (int m = 0; m < 4; ++m) { const int lr = 64 * wr + 16 * m + fr; const float pm = fpm[lr]; float ds = 0.f;
#pragma unroll
        for (int n = 0; n < 2; ++n) { const int s0 = 32 * wc + 16 * n + 4 * fq; float v[4];
#pragma unroll
            for (int j = 0; j < 4; ++j) { const int s = s0 + j; const float wgt = (s <= lr) ? __expf(fcs[s] - pm) : 0.f; v[j] = aS[m][n][j] * wgt * KSC; ds += v[j]; }
            u32x2 o; o.x = cvt_pk_bf16(v[0], v[1]); o.y = cvt_pk_bf16(v[2], v[3]); *(LAS u32x2*)(TS + lr * TROW + s0 * 2) = o; }
        ds += __shfl_xor(ds, 16); ds += __shfl_xor(ds, 32); if (fq == 0) pden[lr * 4 + wc] = ds; }
    __syncthreads();
    f32x4 a1[4][2], a2[4][2];
#pragma unroll
    for (int i = 0; i < 4; ++i)
#pragma unroll
        for (int j = 0; j < 2; ++j) { a1[i][j] = (f32x4){0.f, 0.f, 0.f, 0.f}; a2[i][j] = (f32x4){0.f, 0.f, 0.f, 0.f}; }
#pragma unroll
    for (int ks = 0; ks < 4; ++ks) { bf16x8 A[4], B[2];
#pragma unroll
        for (int m = 0; m < 4; ++m) A[m] = frag_row(TS, 64 * wr + 16 * m + fr, ks, fq);
#pragma unroll
        for (int n = 0; n < 2; ++n) B[n] = frag_tr(TV, 32 * wc + 16 * n, ks, lane);
#pragma unroll
        for (int m = 0; m < 4; ++m)
#pragma unroll
            for (int n = 0; n < 2; ++n) a1[m][n] = MFMA16(B[n], A[m], a1[m][n]); }
#pragma unroll
    for (int ks = 0; ks < 4; ++ks) { bf16x8 A[4], B[2];
#pragma unroll
        for (int m = 0; m < 4; ++m) A[m] = frag_row(TQ, 64 * wr + 16 * m + fr, ks, fq);
#pragma unroll
        for (int n = 0; n < 2; ++n) B[n] = frag_row(TC, 32 * wc + 16 * n + fr, ks, fq);
#pragma unroll
        for (int m = 0; m < 4; ++m)
#pragma unroll
            for (int n = 0; n < 2; ++n) a2[m][n] = MFMA16(B[n], A[m], a2[m][n]); }
#pragma unroll
    for (int m = 0; m < 4; ++m) { const int lr = 64 * wr + 16 * m + fr; const float isc = fisc[lr];
        const float den = (pden[lr * 4] + pden[lr * 4 + 1]) + (pden[lr * 4 + 2] + pden[lr * 4 + 3]) + isc * fqn[lr];
        const float inv = 1.f / fmaxf(fabsf(den), __expf(-(fb[lr] + fpm[lr]))); float ss = 0.f;
#pragma unroll
        for (int n = 0; n < 2; ++n) { a1[m][n] = (a1[m][n] + a2[m][n] * isc) * inv; ss += (a1[m][n][0] * a1[m][n][0] + a1[m][n][1] * a1[m][n][1]) + (a1[m][n][2] * a1[m][n][2] + a1[m][n][3] * a1[m][n][3]); }
        ss += __shfl_xor(ss, 16); ss += __shfl_xor(ss, 32); if (fq == 0) pss[lr * 4 + wc] = ss; }
    __syncthreads();
    const float* gn = c.in[IN_ML_NORM_G] + l * MLW + h * DH; bf16* Y = (bf16*)(c.ws + WS_Y);
#pragma unroll
    for (int m = 0; m < 4; ++m) { const int lr = 64 * wr + 16 * m + fr; const float rstd = rsqrtf(((pss[lr * 4] + pss[lr * 4 + 1]) + (pss[lr * 4 + 2] + pss[lr * 4 + 3])) * (1.f / DH) + EPS);
#pragma unroll
        for (int n = 0; n < 2; ++n) { const int e0 = 32 * wc + 16 * n + 4 * fq; const u32x2 ov = *(const u32x2*)(z + (t0 + lr) * NZ + ZO + h * DH + e0); const f32x4 gv = *(const f32x4*)(gn + e0);
            const float y0 = sigmoidf_(bflo(ov.x)) * a1[m][n][0] * rstd * gv[0], y1 = sigmoidf_(bfhi(ov.x)) * a1[m][n][1] * rstd * gv[1];
            const float y2 = sigmoidf_(bflo(ov.y)) * a1[m][n][2] * rstd * gv[2], y3 = sigmoidf_(bfhi(ov.y)) * a1[m][n][3] * rstd * gv[3];
            u32x2 o; o.x = cvt_pk_bf16(y0, y1); o.y = cvt_pk_bf16(y2, y3); *(u32x2*)(Y + (t0 + lr) * D + h * DH + e0) = o; } }
    __syncthreads();
}

__device__ __forceinline__ void mix_e_rg(const Ctx& c, int l, int u, int lane, int wave) {
    const int b = u >> 6, ck = u & 63; const size_t t0 = (size_t)b * SEQ + (size_t)ck * 64;
    const float* RA = (const float*)(c.ws + WS_RA); const float* RU = (const float*)(c.ws + WS_RU); const bf16* z = (const bf16*)(c.ws + WS_Z); bf16* Y = (bf16*)(c.ws + WS_Y);
    const float* cinp = (const float*)(c.ws + SM_RGC) + (size_t)(b * 64 + ck) * RGW + 8 * lane; const float* gp = c.in[IN_RG_NORM_G] + l * RGW + 8 * lane;
    const f32x4 ci0 = *(const f32x4*)cinp, ci1 = *(const f32x4*)(cinp + 4), g0 = *(const f32x4*)gp, g1 = *(const f32x4*)(gp + 4);
    for (int i = 0; i < 8; ++i) { const size_t t = t0 + wave * 8 + i;
        const f32x4 h0 = *(const f32x4*)(RU + t * RGW + 8 * lane), h1 = *(const f32x4*)(RU + t * RGW + 8 * lane + 4), c0 = *(const f32x4*)(RA + t * RGW + 8 * lane), c1 = *(const f32x4*)(RA + t * RGW + 8 * lane + 4);
        const u32x4 rg = *(const u32x4*)(z + t * NZ + ZRG + 8 * lane);
        const float gt[8] = {bflo(rg.x), bfhi(rg.x), bflo(rg.y), bfhi(rg.y), bflo(rg.z), bfhi(rg.z), bflo(rg.w), bfhi(rg.w)};
        const f32x4 hh0 = h0 + c0 * ci0, hh1 = h1 + c1 * ci1; float v[8]; float s = 0.f;
#pragma unroll
        for (int j = 0; j < 8; ++j) { const float x = gt[j], uu = 1.5957691216057308f * (x + 0.044715f * x * x * x), ge = x / (1.f + __expf(-uu)); v[j] = (j < 4 ? hh0[j] : hh1[j - 4]) * ge; s += v[j] * v[j]; }
        const float r = rsqrtf(wave_sum(s) * (1.f / RGW) + EPS);
        u32x4 o; o.x = cvt_pk_bf16(v[0] * r * g0[0], v[1] * r * g0[1]); o.y = cvt_pk_bf16(v[2] * r * g0[2], v[3] * r * g0[3]); o.z = cvt_pk_bf16(v[4] * r * g1[0], v[5] * r * g1[1]); o.w = cvt_pk_bf16(v[6] * r * g1[2], v[7] * r * g1[3]);
        *(u32x4*)(Y + t * D + MLW + 8 * lane) = o; }
}
__device__ __forceinline__ void mix_c_phase(const Ctx& c, int l, LAS unsigned char* lds) {
    int tid_o = threadIdx.x; asm volatile("" : "+v"(tid_o)); const int tid = tid_o, lane = tid & 63, wave = __builtin_amdgcn_readfirstlane(tid >> 6);
    for (int u = opaque_bid(); u < 512; u += gridDim.x) mix_c_mlstm(c, u, lds, tid, lane, wave);
    for (int u = opaque_bid(); u < 256; u += gridDim.x) { mix_c_rg(c, l, u, lds, lane, wave); __syncthreads(); }
}
__device__ __forceinline__ void mix_d_phase(const Ctx& c, LAS unsigned char* lds) {
    int tid_o = threadIdx.x; asm volatile("" : "+v"(tid_o)); const int tid = tid_o, lane = tid & 63, wave = __builtin_amdgcn_readfirstlane(tid >> 6);
    mix_d(c, lds, tid, lane, wave);
}
__device__ __forceinline__ void mix_e_phase(const Ctx& c, int l, LAS unsigned char* lds) {
    int tid_o = threadIdx.x; asm volatile("" : "+v"(tid_o)); const int tid = tid_o, lane = tid & 63, wave = __builtin_amdgcn_readfirstlane(tid >> 6);
    for (int u = opaque_bid(); u < 512; u += gridDim.x) mix_e_mlstm(c, l, u, lds, tid, lane, wave);
    for (int u = opaque_bid(); u < 256; u += gridDim.x) mix_e_rg(c, l, u, lane, wave);
}
#ifndef ONE_LAUNCH
#define ONE_LAUNCH 1
#endif
__global__ void __launch_bounds__(NTHR, 2) mega(Ctx c) {
    extern __shared__ __attribute__((aligned(16))) unsigned char lds_raw[];
    LAS unsigned char* lds = (LAS unsigned char*)lds_raw;
    const int tid = threadIdx.x;
    if (tid < 64) ((LAS unsigned*)(lds + MISC_OFF))[tid] = 0u;
    __syncthreads();
    XcdBarrier bar; bar.bar = (unsigned*)(c.ws + WS_CTL) + CW_BAR; bar.x = 0; bar.st = (volatile LAS unsigned*)(lds + MISC_OFF + 32);
    if (c.s_hi - c.s_lo > 1) bar = xcd_barrier_post((unsigned*)(c.ws + WS_CTL) + CW_BAR, (volatile LAS unsigned*)(lds + MISC_OFF + 32));
#define STEP_ON(s) (c.s_lo <= (s) && (s) < c.s_hi)
#define SEAM(s) do { if ((s) + 1 < c.s_hi) xcd_barrier(bar); } while (0)
    if (STEP_ON(0)) { cvt_phase(c, lds); SEAM(0); }
    for (int l = 0; l < DEPTH; ++l) {
        const int s0 = 1 + 10 * l; const bool moe = (l & 1) != 0; const int jl = l >> 1;
        if (s0 + 9 < c.s_lo || s0 >= c.s_hi) continue;
        if (STEP_ON(s0 + 0)) { norm_phase<1>(c, l, l == 2, lds); SEAM(s0 + 0); }
        if (STEP_ON(s0 + 1)) {
            pg8::Gemm g{(const bf16*)(c.ws + WS_XN), (const bf16*)(c.ws + WS_WIN) + (size_t)l * NZ * D, T, NZ, D}; pg8::StaticOrder S; S.init(T, NZ, gridDim.x, opaque_bid());
            pg8::EpiBf16 E{(bf16*)(c.ws + WS_Z), NZ};
            pg8::gemm_phase<pg8::EpiBf16, pg8::StaticOrder, true, true>(lds, g, S, E); SEAM(s0 + 1); }
        if (STEP_ON(s0 + 2)) { mix_c_phase(c, l, lds); SEAM(s0 + 2); }
        if (STEP_ON(s0 + 3)) { mix_d_phase(c, lds); SEAM(s0 + 3); }
        if (STEP_ON(s0 + 4)) { mix_e_phase(c, l, lds); SEAM(s0 + 4); }
        if (STEP_ON(s0 + 5)) {
            pg8::Gemm g{(const bf16*)(c.ws + WS_Y), (const bf16*)(c.ws + WS_WOUT) + (size_t)l * D * D, T, D, D}; pg8::StaticOrder S; S.init(T, D, gridDim.x, opaque_bid());
            pg8::EpiResF32 E{l == 0 ? c.in[IN_X] : (const float*)(c.ws + WS_H), (float*)(c.ws + WS_H), D};
            pg8::gemm_phase<pg8::EpiResF32, pg8::StaticOrder, true, true>(lds, g, S, E); SEAM(s0 + 5); }
        if (!moe) {
            if (STEP_ON(s0 + 6)) { norm_phase<0>(c, l, false, lds); SEAM(s0 + 6); }
            if (STEP_ON(s0 + 7)) {
                pg8::Gemm g{(const bf16*)(c.ws + WS_XN), (const bf16*)(c.ws + WS_WGU) + (size_t)jl * 2 * FFD * D, T, 2 * FFD, D}; pg8::StaticOrder S; S.init(T, 2 * FFD, gridDim.x, opaque_bid());
                pg8::EpiSwiglu E{(bf16*)(c.ws + WS_HID), FFD};
                pg8::gemm_phase<pg8::EpiSwiglu, pg8::StaticOrder, true, true>(lds, g, S, E); SEAM(s0 + 7); }
            if (STEP_ON(s0 + 8)) {
                pg8::Gemm g{(const bf16*)(c.ws + WS_HID), (const bf16*)(c.ws + WS_WD) + (size_t)jl * D * FFD, T, D, FFD}; pg8::StaticOrder S; S.init(T, D, gridDim.x, opaque_bid());
                pg8::EpiResF32 E{(const float*)(c.ws + WS_H), (float*)(c.ws + WS_H), D};
                pg8::gemm_phase<pg8::EpiResF32, pg8::StaticOrder, true, true>(lds, g, S, E); SEAM(s0 + 8); }
        } else {
            if (STEP_ON(s0 + 6)) { norm_phase<2>(c, l, false, lds); SEAM(s0 + 6); }
            if (STEP_ON(s0 + 7)) { moe_gather_phase(c, lds); SEAM(s0 + 7); }
            if (STEP_ON(s0 + 8)) {
                const int* meta = (const int*)(c.ws + WS_META); const int nM = __builtin_amdgcn_readfirstlane(meta[16]);
                pg8::Gemm g{(const bf16*)(c.ws + WS_XG), (const bf16*)(c.ws + WS_MWGU) + (size_t)jl * NE * 2 * FFE * D, nM * 256, 2 * FFE, D}; pg8::MoeOrder S; S.init(nM, 2 * FFE, gridDim.x, opaque_bid(), meta + 32);
                pg8::EpiSwiglu E{(bf16*)(c.ws + WS_MHID), FFE};
                pg8::gemm_phase<pg8::EpiSwiglu, pg8::MoeOrder, true, true>(lds, g, S, E); SEAM(s0 + 8); }
            if (STEP_ON(s0 + 9)) {
                const int* meta = (const int*)(c.ws + WS_META); const int nM = __builtin_amdgcn_readfirstlane(meta[16]);
                pg8::Gemm g{(const bf16*)(c.ws + WS_MHID), (const bf16*)(c.ws + WS_MWD) + (size_t)jl * NE * D * FFE, nM * 256, D, FFE}; pg8::MoeOrder S; S.init(nM, D, gridDim.x, opaque_bid(), meta + 32);
                pg8::EpiBf16 E{(bf16*)(c.ws + WS_XG), D};
                pg8::gemm_phase<pg8::EpiBf16, pg8::MoeOrder, true, true>(lds, g, S, E); SEAM(s0 + 9); }
        }
    }
    if (STEP_ON(41)) norm_phase<3>(c, 0, true, lds);
}

namespace nv {
__global__ __launch_bounds__(256) void mlstm_rec(const bf16* __restrict__ z, const float* __restrict__ ifp, float* __restrict__ ht) {
    const int wave = (blockIdx.x * 256 + threadIdx.x) >> 6, lane = threadIdx.x & 63;
    const int bh = wave >> 5, es = wave & 31, b = bh >> 2, h = bh & 3, e0 = es * 4;
    float C[2][4] = {}, n[2] = {0.f, 0.f};
    const float ksc = 0.08838834764831845f;
    for (int t0 = 0; t0 < SEQ; t0 += 8) {
        float kk[8][2], qq[8][2], vv[8][4], ii[8], ff[8];
#pragma unroll
        for (int j = 0; j < 8; ++j) { const size_t t = (size_t)(b * SEQ + t0 + j); const bf16* row = z + t * NZ;
            kk[j][0] = bf2f(row[ZK + h * DH + lane]) * ksc; kk[j][1] = bf2f(row[ZK + h * DH + lane + 64]) * ksc; qq[j][0] = bf2f(row[ZQ + h * DH + lane]); qq[j][1] = bf2f(row[ZQ + h * DH + lane + 64]);
#pragma unroll
            for (int e = 0; e < 4; ++e) vv[j][e] = bf2f(row[ZV + h * DH + e0 + e]);
            ii[j] = __expf(ifp[t * 8 + h]); ff[j] = sigmoidf_(ifp[t * 8 + 4 + h]); }
#pragma unroll
        for (int j = 0; j < 8; ++j) { float s[5] = {0.f, 0.f, 0.f, 0.f, 0.f};
#pragma unroll
            for (int d = 0; d < 2; ++d) { n[d] = ff[j] * n[d] + ii[j] * kk[j][d]; s[4] += n[d] * qq[j][d];
#pragma unroll
                for (int e = 0; e < 4; ++e) { C[d][e] = ff[j] * C[d][e] + ii[j] * kk[j][d] * vv[j][e]; s[e] += C[d][e] * qq[j][d]; } }
#pragma unroll
            for (int e = 0; e < 5; ++e) s[e] = wave_sum(s[e]);
            const float den = fmaxf(fabsf(s[4]), 1.f);
            if (lane == 0) { float* o = ht + (size_t)(b * SEQ + t0 + j) * MLW + h * DH + e0; o[0] = s[0] / den; o[1] = s[1] / den; o[2] = s[2] / den; o[3] = s[3] / den; } }
    }
}
__global__ __launch_bounds__(256) void ml_out(const bf16* __restrict__ z, const float* __restrict__ ht, const float* __restrict__ g, bf16* __restrict__ y) {
    const int w = (blockIdx.x * 256 + threadIdx.x) >> 6, lane = threadIdx.x & 63, t = w >> 2, h = w & 3;
    const float a = ht[(size_t)t * MLW + h * DH + lane], b = ht[(size_t)t * MLW + h * DH + lane + 64];
    const float r = rsqrtf(wave_sum(a * a + b * b) * (1.f / DH) + EPS);
    const float oa = bf2f(z[(size_t)t * NZ + ZO + h * DH + lane]), ob = bf2f(z[(size_t)t * NZ + ZO + h * DH + lane + 64]);
    y[(size_t)t * D + h * DH + lane] = f2bf(sigmoidf_(oa) * a * r * g[h * DH + lane]); y[(size_t)t * D + h * DH + lane + 64] = f2bf(sigmoidf_(ob) * b * r * g[h * DH + lane + 64]);
}
__global__ __launch_bounds__(512) void rg_gates(const bf16* __restrict__ z, const float* __restrict__ cw, const float* __restrict__ cb, const float* __restrict__ wa, const float* __restrict__ ba,
                                                const float* __restrict__ wx, const float* __restrict__ bx, const float* __restrict__ lam, float* __restrict__ av, float* __restrict__ uv) {
    __shared__ float xs[RGW]; const int t = blockIdx.x, c = threadIdx.x, tl = t % SEQ;
    float xc = cb[c];
#pragma unroll
    for (int j = 0; j < 4; ++j) { const int tt = tl - 3 + j; if (tt >= 0) xc += cw[j * RGW + c] * bf2f(z[(size_t)(t - 3 + j) * NZ + ZRX + c]); }
    xs[c] = xc; __syncthreads();
    const int g = c >> 6, jj = c & 63; float ra = ba[c], rx = bx[c];
    for (int i = 0; i < RGD; ++i) { const float xv = xs[g * RGD + i]; ra += xv * wa[(g * RGD + i) * RGD + jj]; rx += xv * wx[(g * RGD + i) * RGD + jj]; }
    const float r = sigmoidf_(ra), ig = sigmoidf_(rx);
    const float sp = log1pf(__expf(-lam[c])); const float la = -8.f * r * sp;
    av[(size_t)t * RGW + c] = __expf(la); uv[(size_t)t * RGW + c] = sqrtf(-expm1f(2.f * la)) * (ig * xc);
}
__global__ __launch_bounds__(256) void rg_scan(const float* __restrict__ av, float* __restrict__ uv) {
    const int id = blockIdx.x * 256 + threadIdx.x, b = id / RGW, c = id % RGW; float h = 0.f;
    for (int t0 = 0; t0 < SEQ; t0 += 8) { float a[8], u[8];
#pragma unroll
        for (int j = 0; j < 8; ++j) { a[j] = av[(size_t)(b * SEQ + t0 + j) * RGW + c]; u[j] = uv[(size_t)(b * SEQ + t0 + j) * RGW + c]; }
#pragma unroll
        for (int j = 0; j < 8; ++j) { h = a[j] * h + u[j]; uv[(size_t)(b * SEQ + t0 + j) * RGW + c] = h; } }
}
__global__ __launch_bounds__(256) void rg_out(const bf16* __restrict__ z, const float* __restrict__ hr, const float* __restrict__ g, bf16* __restrict__ y) {
    const int t = (blockIdx.x * 256 + threadIdx.x) >> 6, lane = threadIdx.x & 63; float v[8]; float s = 0.f;
#pragma unroll
    for (int j = 0; j < 8; ++j) { const int c = lane + 64 * j; v[j] = hr[(size_t)t * RGW + c] * gelu_tanh(bf2f(z[(size_t)t * NZ + ZRG + c])); s += v[j] * v[j]; }
    const float r = rsqrtf(wave_sum(s) * (1.f / RGW) + EPS);
#pragma unroll
    for (int j = 0; j < 8; ++j) { const int c = lane + 64 * j; y[(size_t)t * D + MLW + c] = f2bf(v[j] * r * g[c]); }
}
}

extern "C" void kernel_launch(void* const* d_in, const int* in_sizes, int n_in, void* d_out, int out_size, void* d_ws, size_t ws_size, hipStream_t stream) {
    static int ok = 0; static int grid_g = 256;
    if (ok == 0) {
        if (n_in != 23 || ws_size < WS_END || out_size != T * D) { fprintf(stderr, "kernel_launch: unexpected shapes (n_in %d, ws %zu, out %d)\n", n_in, ws_size, out_size); ok = -1; return; }
        if (hipFuncSetAttribute((const void*)mega, hipFuncAttributeMaxDynamicSharedMemorySize, LDS_BYTES) != hipSuccess) { fprintf(stderr, "kernel_launch: hipFuncSetAttribute failed\n"); ok = -1; return; }
        int dev = 0, cus = 0, per_cu = 0; (void)hipGetDevice(&dev); (void)hipDeviceGetAttribute(&cus, hipDeviceAttributeMultiprocessorCount, dev);
        if (hipOccupancyMaxActiveBlocksPerMultiprocessor(&per_cu, (const void*)mega, NTHR, LDS_BYTES) != hipSuccess || per_cu < 1) { fprintf(stderr, "kernel_launch: occupancy query says %d blocks per CU\n", per_cu); (void)hipGetLastError(); }
        grid_g = cus > 0 ? cus : 256;
        ok = 1;
    }
    if (ok < 0) return;
    unsigned char* ws = (unsigned char*)d_ws;
    (void)hipMemsetAsync(ws + WS_CTL, 0, 1 * MiB, stream);
    Ctx base{}; for (int i = 0; i < 23; ++i) base.in[i] = (const float*)d_in[i]; base.out = (float*)d_out; base.ws = ws;
    auto run = [&](int lo, int hi) { Ctx a = base; a.s_lo = lo; a.s_hi = hi; hipLaunchKernelGGL(mega, dim3(grid_g), dim3(NTHR), LDS_BYTES, stream, a); };
    const bf16* z = (const bf16*)(ws + WS_Z); bf16* y = (bf16*)(ws + WS_Y); const float* ifp = (const float*)(ws + WS_IFP);
    float* ht = (float*)(ws + WS_CTL_LOC); float* ra = (float*)(ws + WS_RA); float* ru = (float*)(ws + WS_RU);
#if ONE_LAUNCH
    run(0, 42);
#else
    run(0, 1);
    for (int l = 0; l < DEPTH; ++l) {
        const int s0 = 1 + 10 * l;
        run(s0, s0 + 1); run(s0 + 1, s0 + 2);
#if MIX_FAST
        run(s0 + 2, s0 + 3); run(s0 + 3, s0 + 4); run(s0 + 4, s0 + 5);
#endif
#if !MIX_FAST || NV_ML
        nv::mlstm_rec<<<128, 256, 0, stream>>>(z, ifp, ht);
        nv::ml_out<<<T, 256, 0, stream>>>(z, ht, (const float*)d_in[IN_ML_NORM_G] + l * MLW, y);
#endif
#if !MIX_FAST || NV_RG
        nv::rg_gates<<<T, 512, 0, stream>>>(z, (const float*)d_in[IN_CONV_W] + l * 4 * RGW, (const float*)d_in[IN_CONV_B] + l * RGW, (const float*)d_in[IN_RG_W_A] + (size_t)l * RGB * RGD * RGD,
                                            (const float*)d_in[IN_RG_B_A] + l * RGW, (const float*)d_in[IN_RG_W_X] + (size_t)l * RGB * RGD * RGD, (const float*)d_in[IN_RG_B_X] + l * RGW, (const float*)d_in[IN_RG_LAM] + l * RGW, ra, ru);
        nv::rg_scan<<<BATCH * RGW / 256, 256, 0, stream>>>(ra, ru);
        nv::rg_out<<<T / 4, 256, 0, stream>>>(z, ru, (const float*)d_in[IN_RG_NORM_G] + l * RGW, y);
#endif
        run(s0 + 5, s0 + 6); run(s0 + 6, s0 + 7); run(s0 + 7, s0 + 8); run(s0 + 8, s0 + 9);
        if (l & 1) run(s0 + 9, s0 + 10);
    }
    run(41, 42);
#endif
}
```

```cpp
#include <hip/hip_runtime.h>
#include <cstdio>
#include <cstdint>

constexpr int D = 1024, BATCH = 4, SEQ = 4096, T = BATCH * SEQ, DEPTH = 4;
constexpr int MLW = 512, MLH = 4, DH = 128, RGW = 512, RGB = 8, RGD = 64;
constexpr int DIN = 3080, FFD = 2816, NE = 8, FFE = 3584;
constexpr int NZ = 3072;
constexpr int ZQ = 0, ZK = 512, ZV = 1024, ZO = 1536, ZRX = 2048, ZRG = 2560;
constexpr float EPS = 1e-6f;
constexpr int MAXROWS = 2 * T + NE * 256;
constexpr int MAXT256 = MAXROWS / 256;
constexpr int NWAVES = 8, NTHR = 512;

#define LAS __attribute__((address_space(3)))
#define GAS __attribute__((address_space(1)))
typedef unsigned short bf16;
typedef float f32x4 __attribute__((ext_vector_type(4)));
typedef float f32x2 __attribute__((ext_vector_type(2)));
typedef unsigned u32x4 __attribute__((ext_vector_type(4)));
typedef unsigned u32x2 __attribute__((ext_vector_type(2)));
typedef short bf16x8 __attribute__((ext_vector_type(8)));

__device__ __forceinline__ float wave_sum(float v) {
#pragma unroll
    for (int o = 1; o < 64; o <<= 1) v += __shfl_xor(v, o);
    return v;
}
__device__ __forceinline__ float sigmoidf_(float x) { return 1.f / (1.f + __expf(-x)); }
__device__ __forceinline__ float gelu_tanh(float x) { const float u = 0.7978845608028654f * (x + 0.044715f * x * x * x); return 0.5f * x * (1.f + tanhf(u)); }
__device__ __forceinline__ unsigned cvt_pk_bf16(float lo, float hi) { unsigned r; asm volatile("v_cvt_pk_bf16_f32 %0, %1, %2" : "=v"(r) : "v"(lo), "v"(hi)); return r; }
__device__ __forceinline__ float bf2f(unsigned short b) { return __uint_as_float(((unsigned)b) << 16); }
__device__ __forceinline__ float bflo(unsigned w) { return __uint_as_float(w << 16); }
__device__ __forceinline__ float bfhi(unsigned w) { return __uint_as_float(w & 0xffff0000u); }
__device__ __forceinline__ bf16 f2bf(float f) { return (bf16)(cvt_pk_bf16(f, 0.f) & 0xffffu); }

namespace pg8 {
#define PG8_LAS __attribute__((address_space(3)))
typedef unsigned short bf16_t;
constexpr int BM = 256, BK = 64, HALF = 128, HTB = HALF * BK * 2  , STAGE_BYTES = 8 * HTB, NXCD = 8, WGM = 8;
__host__ __device__ __forceinline__ int lds_byte(int r, int c) { const int st = (r >> 4) * 2 + (c >> 5), rr = r & 15, cc = c & 31, ob = rr * 64 + cc * 2; return st * 1024 + (ob ^ (((ob >> 9) & 1) << 5)); }
__host__ __device__ __forceinline__ void stage_rc(int b, int& R, int& C) { const int st = b / 1024, sb = b % 1024, swz = sb ^ (((sb >> 9) & 1) << 5); R = (st >> 1) * 16 + swz / 64; C = (st & 1) * 32 + (swz % 64) / 2; }
__host__ __device__ __forceinline__ int perm32(int rho) { const int n = rho >> 4, i = rho & 15; return 8 * (i >> 2) + 4 * n + (i & 3); }

struct Unit { int pm, pn, pb, kz; };
struct Gemm { const bf16_t* A; const bf16_t* Bt; int M, N, K, ld, stag; };

struct StaticOrder {
    int nM, nN, nwg, G, c;
    __host__ __device__ void init(int M, int N, int G_, int c_) { nM = M / BM; nN = N / BM; nwg = nM * nN; G = G_; c = c_; }
    __host__ __device__ bool next(int i, Unit& u) const {
        const long L = (long)i * G + c; if (L >= nwg) return false;
        int wgid = (int)L; { const int q = nwg / NXCD, r = nwg % NXCD, xcd = wgid % NXCD, off = wgid / NXCD; wgid = (xcd < r ? xcd * (q + 1) : r * (q + 1) + (xcd - r) * q) + off; }
        const int nig = WGM * nN, gid = wgid / nig, fm = gid * WGM, gsz = (nM - fm) < WGM ? (nM - fm) : WGM;
        u.pm = fm + ((wgid % nig) % gsz); u.pn = (wgid % nig) / gsz; u.pb = u.pn; u.kz = 0; return true;
    }
    __device__ __forceinline__ void a_ready(const Unit&) const {}
    __device__ __forceinline__ void done(const Unit&) const {}
};
struct MoeOrder {
    int nM, nN, nNo, KS, nwg, G, c; const int* texp;
    __device__ void init(int nM_, int N, int KS_, int G_, int c_, const int* texp_) { nM = nM_; nNo = N / BM; KS = KS_; nN = nNo * KS; nwg = nM * nN; G = G_; c = c_; texp = texp_; }
    __device__ bool next(int i, Unit& u) const {
        const long L = (long)i * G + c; if (L >= nwg) return false;
        int wgid = (int)L; { const int q = nwg / NXCD, r = nwg % NXCD, xcd = wgid % NXCD, off = wgid / NXCD; wgid = (xcd < r ? xcd * (q + 1) : r * (q + 1) + (xcd - r) * q) + off; }
        const int nig = WGM * nN, gid = wgid / nig, fm = gid * WGM, gsz = (nM - fm) < WGM ? (nM - fm) : WGM;
        u.pm = fm + ((wgid % nig) % gsz); const int q = (wgid % nig) / gsz; u.pn = q / KS; u.kz = q % KS; u.pb = __builtin_amdgcn_readfirstlane(texp[u.pm]) * nNo + u.pn; return true;
    }
    __device__ __forceinline__ void a_ready(const Unit&) const {}
    __device__ __forceinline__ void done(const Unit&) const {}
};

struct EpiBf16 {
    static constexpr bool PERM = true, AFTER_DRAIN = false;
    bf16_t* O; int ldc; size_t zstride;
    __device__ __forceinline__ void operator()(const f32x4 (&acc)[2][2][4][2], const Unit& u, int wr, int wc, int fr, int fq) const {
        const int row0 = u.pm * BM + wr * 64 + fr, col0 = u.pn * BM + wc * 32 + 8 * fq;
#pragma unroll
        for (int ai = 0; ai < 2; ++ai)
#pragma unroll
            for (int m = 0; m < 4; ++m) { bf16_t* rowp = O + (size_t)u.kz * zstride + (size_t)(row0 + ai * HALF + m * 16) * ldc + col0;
#pragma unroll
                for (int bj = 0; bj < 2; ++bj) { const f32x4 v0 = acc[ai][bj][m][0], v1 = acc[ai][bj][m][1];
                    u32x4 w; w.x = cvt_pk_bf16(v0[0], v0[1]); w.y = cvt_pk_bf16(v0[2], v0[3]); w.z = cvt_pk_bf16(v1[0], v1[1]); w.w = cvt_pk_bf16(v1[2], v1[3]);
                    *(u32x4*)(rowp + bj * HALF) = w; } }
    }
};
struct EpiNull {
    static constexpr bool PERM = true, AFTER_DRAIN = false;
    __device__ __forceinline__ void operator()(const f32x4 (&acc)[2][2][4][2], const Unit& u, int wr, int wc, int fr, int fq) const {
#pragma unroll
        for (int ai = 0; ai < 2; ++ai)
#pragma unroll
            for (int bj = 0; bj < 2; ++bj)
#pragma unroll
                for (int m = 0; m < 4; ++m)
#pragma unroll
                    for (int n = 0; n < 2; ++n) asm volatile("" :: "v"(acc[ai][bj][m][n]));
    }
};
struct EpiResF32 {
    static constexpr bool PERM = false, AFTER_DRAIN = false;
    const float* Base; float* C; int ldc;
    __device__ __forceinline__ void operator()(const f32x4 (&acc)[2][2][4][2], const Unit& u, int wr, int wc, int fr, int fq) const {
        const int row0 = u.pm * BM + wr * 64 + fr, col0 = u.pn * BM + wc * 32 + 4 * fq;
#pragma unroll
        for (int ai = 0; ai < 2; ++ai)
#pragma unroll
            for (int m = 0; m < 4; ++m) { const size_t ro = (size_t)(row0 + ai * HALF + m * 16) * ldc + col0; float* rowp = C + ro; const float* basep = Base + ro;
                f32x4 o[2][2];
#pragma unroll
                for (int bj = 0; bj < 2; ++bj)
#pragma unroll
                    for (int n = 0; n < 2; ++n) o[bj][n] = *(const f32x4*)(basep + bj * HALF + n * 16);
#pragma unroll
                for (int bj = 0; bj < 2; ++bj)
#pragma unroll
                    for (int n = 0; n < 2; ++n) *(f32x4*)(rowp + bj * HALF + n * 16) = o[bj][n] + acc[ai][bj][m][n]; }
    }
};
struct EpiSwiglu {
    static constexpr bool PERM = true, AFTER_DRAIN = false;
    bf16_t* O; int ldc;
    __device__ __forceinline__ void operator()(const f32x4 (&acc)[2][2][4][2], const Unit& u, int wr, int wc, int fr, int fq) const {
        const int row0 = u.pm * BM + wr * 64 + fr, col0 = u.pn * HALF + wc * 32 + 8 * fq;
#pragma unroll
        for (int ai = 0; ai < 2; ++ai)
#pragma unroll
            for (int m = 0; m < 4; ++m) { bf16_t* rowp = O + (size_t)(row0 + ai * HALF + m * 16) * ldc + col0; float r[8];
#pragma unroll
                for (int n = 0; n < 2; ++n)
#pragma unroll
                    for (int j = 0; j < 4; ++j) { const float g = acc[ai][0][m][n][j], up = acc[ai][1][m][n][j]; r[4 * n + j] = g * __builtin_amdgcn_rcpf(1.f + __expf(-g)) * up; }
                u32x4 w; w.x = cvt_pk_bf16(r[0], r[1]); w.y = cvt_pk_bf16(r[2], r[3]); w.z = cvt_pk_bf16(r[4], r[5]); w.w = cvt_pk_bf16(r[6], r[7]);
                *(u32x4*)rowp = w; }
    }
};

template <class Epi, class Sched, bool ALIGN_EPI = false, bool SP2 = false>
__device__ __forceinline__ void gemm_phase(PG8_LAS unsigned char* lds, const Gemm g, const Sched& S, const Epi& E) {
    int tid_o = threadIdx.x; asm volatile("" : "+v"(tid_o));
    const int tid = tid_o, wid = __builtin_amdgcn_readfirstlane(tid >> 6), lane = tid & 63, wr = wid >> 2, wc = wid & 3, fr = lane & 15, fq = lane >> 4;
    if (g.stag > 0) { const int sg = (int)((blockIdx.x >> 3) & 3u); for (int i = 0; i < sg * g.stag; ++i) __builtin_amdgcn_s_sleep(63); }
    const int K = g.ld, nt = g.K / BK;
    unsigned voffA[2], voffB[2];
#pragma unroll
    for (int i = 0; i < 2; ++i) { int R, C; stage_rc(tid * 16 + i * 8192, R, C); const int Rb = Epi::PERM ? ((R & ~31) + perm32(R & 31)) : R;
        voffA[i] = (unsigned)(R * K + C) * 2u; voffB[i] = (unsigned)(Rb * K + C) * 2u; }
    const size_t kstep = (size_t)(BK * 2);
    const size_t hstep = (size_t)HALF * K * 2;
    const size_t tstep = 2 * hstep;
    const unsigned ldsw = (unsigned)wid * 1024u;
    const int aoff = lds_byte(wr * 64 + fr, fq * 8), boff = lds_byte(wc * 32 + fr, fq * 8);
#define PG8_SA(b, h) (((b) * 2 + (h)) * HTB)
#define PG8_SB(b, h) ((4 + (b) * 2 + (h)) * HTB)
#define PG8_STAGE(bufoff, gbase, voff) do { _Pragma("unroll") for (int _i = 0; _i < 2; ++_i) \
        __builtin_amdgcn_global_load_lds((const unsigned*)((const char*)(gbase) + (voff)[_i]), (PG8_LAS unsigned*)(lds + (bufoff) + ldsw + _i * 8192), 16, 0, 0); } while (0)
#define PG8_LDA(dst, b, h) do { _Pragma("unroll") for (int m = 0; m < 4; ++m) _Pragma("unroll") for (int k = 0; k < 2; ++k) dst[m][k] = *(const PG8_LAS bf16x8*)(lds + PG8_SA(b, h) + aoff + m * 2048 + k * 1024); } while (0)
#define PG8_LDB(dst, b, h) do { _Pragma("unroll") for (int n = 0; n < 2; ++n) _Pragma("unroll") for (int k = 0; k < 2; ++k) dst[n][k] = *(const PG8_LAS bf16x8*)(lds + PG8_SB(b, h) + boff + n * 2048 + k * 1024); } while (0)
#define PG8_MMA(ai, bj, At, Bt) do { __builtin_amdgcn_s_setprio(1); _Pragma("unroll") for (int m = 0; m < 4; ++m) _Pragma("unroll") for (int n = 0; n < 2; ++n) _Pragma("unroll") for (int k = 0; k < 2; ++k) \
        acc[ai][bj][m][n] = __builtin_amdgcn_mfma_f32_16x16x32_bf16(Bt[n][k], At[m][k], acc[ai][bj][m][n], 0, 0, 0); __builtin_amdgcn_s_setprio(0); } while (0)
#define PG8_WAIT_V(n) asm volatile("s_waitcnt vmcnt(" #n ")" ::: "memory")
#define PG8_WAIT_L(n) asm volatile("s_waitcnt lgkmcnt(" #n ")" ::: "memory")
#define PG8_BAR __builtin_amdgcn_s_barrier()
#define PG8_SCHED __builtin_amdgcn_sched_barrier(0)
    Unit cur, nxt; int ui = 0;
    if (!S.next(0, cur)) return;
    f32x4 acc[2][2][4][2];
#pragma unroll
    for (int a = 0; a < 2; ++a)
#pragma unroll
        for (int b = 0; b < 2; ++b)
#pragma unroll
            for (int m = 0; m < 4; ++m)
#pragma unroll
                for (int n = 0; n < 2; ++n) acc[a][b][m][n] = (f32x4){0.f, 0.f, 0.f, 0.f};
    bf16x8 At[4][2], B0[2][2], B1[2][2];
    const size_t kzb = (size_t)g.K * 2;
    const char* cA = (const char*)g.A + (size_t)cur.pm * tstep + cur.kz * kzb; const char* cB = (const char*)g.Bt + (size_t)cur.pb * tstep + cur.kz * kzb;
    S.a_ready(cur);
    if constexpr (SP2) {
        PG8_STAGE(PG8_SB(0, 0), cB, voffB); PG8_STAGE(PG8_SB(0, 1), cB + hstep, voffB); PG8_STAGE(PG8_SA(0, 0), cA, voffA); PG8_STAGE(PG8_SA(0, 1), cA + hstep, voffA);
        if (wr == 1) PG8_BAR;
        PG8_WAIT_V(2); PG8_BAR;
        PG8_STAGE(PG8_SB(1, 0), cB + kstep, voffB); PG8_STAGE(PG8_SA(1, 0), cA + kstep, voffA); PG8_STAGE(PG8_SB(1, 1), cB + hstep + kstep, voffB);
        PG8_WAIT_V(6); PG8_BAR;
    } else {
        PG8_STAGE(PG8_SB(0, 0), cB, voffB); PG8_STAGE(PG8_SA(0, 0), cA, voffA); PG8_STAGE(PG8_SB(0, 1), cB + hstep, voffB); PG8_STAGE(PG8_SA(0, 1), cA + hstep, voffA);
        if (wr == 1) PG8_BAR;
        PG8_WAIT_V(4); PG8_BAR;
        PG8_STAGE(PG8_SB(1, 0), cB + kstep, voffB); PG8_STAGE(PG8_SA(1, 0), cA + kstep, voffA); PG8_STAGE(PG8_SB(1, 1), cB + hstep + kstep, voffB);
        PG8_WAIT_V(6); PG8_BAR;
    }
    for (;;) {
        const bool has_next = S.next(ui + 1, nxt);
        const char* nA = has_next ? (const char*)g.A + (size_t)nxt.pm * tstep + nxt.kz * kzb : cA; const char* nB = has_next ? (const char*)g.Bt + (size_t)nxt.pb * tstep + nxt.kz * kzb : cB;
        for (int t = 0; t < nt; t += 2) {
            const bool last = (t == nt - 2);
            const char* a1 = cA + (size_t)(t + 1) * kstep;
            const char* a2 = last ? nA : cA + (size_t)(t + 2) * kstep; const char* b2 = last ? nB : cB + (size_t)(t + 2) * kstep;
            const char* a3 = a2 + kstep; const char* b3 = b2 + kstep;
            if (last && has_next) S.a_ready(nxt);
            if constexpr (SP2) {
            PG8_LDB(B0, 0, 0); PG8_LDB(B1, 0, 1); PG8_SCHED; PG8_LDA(At, 0, 0); PG8_STAGE(PG8_SA(1, 1), a1 + hstep, voffA);
            PG8_WAIT_V(8); PG8_WAIT_L(0); PG8_BAR; PG8_MMA(0, 0, At, B0); PG8_MMA(0, 1, At, B1); PG8_BAR; PG8_SCHED;
            PG8_LDA(At, 0, 1); PG8_STAGE(PG8_SB(0, 0), b2, voffB); PG8_STAGE(PG8_SB(0, 1), b2 + hstep, voffB); PG8_STAGE(PG8_SA(0, 0), a2, voffA);
            PG8_WAIT_V(8); PG8_WAIT_L(0); PG8_BAR; PG8_MMA(1, 0, At, B0); PG8_MMA(1, 1, At, B1); PG8_BAR; PG8_SCHED;
            PG8_LDB(B0, 1, 0); PG8_LDB(B1, 1, 1); PG8_SCHED; PG8_LDA(At, 1, 0); PG8_STAGE(PG8_SA(0, 1), a2 + hstep, voffA);
            PG8_WAIT_V(8); PG8_WAIT_L(0); PG8_BAR; PG8_MMA(0, 0, At, B0); PG8_MMA(0, 1, At, B1); PG8_BAR; PG8_SCHED;
            PG8_LDA(At, 1, 1); PG8_STAGE(PG8_SB(1, 0), b3, voffB); PG8_STAGE(PG8_SB(1, 1), b3 + hstep, voffB); PG8_STAGE(PG8_SA(1, 0), a3, voffA);
            PG8_WAIT_V(8); PG8_WAIT_L(0); PG8_BAR; PG8_MMA(1, 0, At, B0); PG8_MMA(1, 1, At, B1); PG8_BAR; PG8_SCHED;
            } else {
            PG8_LDB(B0, 0, 0); PG8_SCHED; PG8_LDA(At, 0, 0); PG8_STAGE(PG8_SA(1, 1), a1 + hstep, voffA);
            PG8_WAIT_L(8); PG8_BAR; PG8_WAIT_L(0); PG8_MMA(0, 0, At, B0); PG8_BAR; PG8_SCHED;
            PG8_LDB(B1, 0, 1); PG8_STAGE(PG8_SB(0, 0), b2, voffB);
            PG8_BAR; PG8_WAIT_L(0); PG8_MMA(0, 1, At, B1); PG8_BAR;
            PG8_LDA(At, 0, 1); PG8_STAGE(PG8_SA(0, 0), a2, voffA);
            PG8_BAR; PG8_WAIT_L(0); PG8_MMA(1, 0, At, B0); PG8_BAR; PG8_SCHED;
            PG8_STAGE(PG8_SB(0, 1), b2 + hstep, voffB);
            PG8_WAIT_V(6); PG8_BAR; PG8_MMA(1, 1, At, B1); PG8_BAR;
            PG8_LDB(B0, 1, 0); PG8_SCHED; PG8_LDA(At, 1, 0); PG8_STAGE(PG8_SA(0, 1), a2 + hstep, voffA);
            PG8_WAIT_L(8); PG8_BAR; PG8_WAIT_L(0); PG8_MMA(0, 0, At, B0); PG8_BAR; PG8_SCHED;
            PG8_LDB(B1, 1, 1); PG8_STAGE(PG8_SB(1, 0), b3, voffB);
            PG8_BAR; PG8_WAIT_L(0); PG8_MMA(0, 1, At, B1); PG8_BAR;
            PG8_LDA(At, 1, 1); PG8_STAGE(PG8_SA(1, 0), a3, voffA);
            PG8_BAR; PG8_WAIT_L(0); PG8_MMA(1, 0, At, B0); PG8_BAR; PG8_SCHED;
            PG8_STAGE(PG8_SB(1, 1), b3 + hstep, voffB);
            PG8_WAIT_V(6); PG8_BAR; PG8_MMA(1, 1, At, B1); PG8_BAR;
            }
        }
        if constexpr (ALIGN_EPI) { if (wr == 0) PG8_BAR; }
        if constexpr (!Epi::AFTER_DRAIN) { E(acc, cur, wr, wc, fr, fq); S.done(cur); }
        if (!has_next) break;
#pragma unroll
        for (int a = 0; a < 2; ++a)
#pragma unroll
            for (int b = 0; b < 2; ++b)
#pragma unroll
                for (int m = 0; m < 4; ++m)
#pragma unroll
                    for (int n = 0; n < 2; ++n) acc[a][b][m][n] = (f32x4){0.f, 0.f, 0.f, 0.f};
        cur = nxt; cA = nA; cB = nB; ++ui;
        if constexpr (ALIGN_EPI) { if (wr == 1) PG8_BAR; }
    }
    PG8_WAIT_V(0);
    if constexpr (!ALIGN_EPI) { if (wr == 0) PG8_BAR; }
    PG8_BAR;
    if constexpr (Epi::AFTER_DRAIN) { E.fused(acc, cur, wr, wc, fr, fq, lds, wid, lane); S.done(cur); }
#undef PG8_SA
#undef PG8_SB
#undef PG8_STAGE
#undef PG8_LDA
#undef PG8_LDB
#undef PG8_MMA
#undef PG8_WAIT_V
#undef PG8_WAIT_L
#undef PG8_BAR
#undef PG8_SCHED
}
}

constexpr size_t MiB = 1u << 20;
constexpr size_t WS_CTL = 0;
constexpr int CW_BAR = 4096;
constexpr size_t WS_IFP = 1 * MiB;
constexpr size_t WS_EIDX = WS_IFP + 512 * 1024;
constexpr size_t WS_EW = WS_EIDX + 128 * 1024;
constexpr size_t WS_POS = WS_EW + 128 * 1024;
constexpr size_t WS_BLKCNT = WS_POS + 128 * 1024;
constexpr size_t WS_META = WS_BLKCNT + 16 * 1024;
constexpr size_t WS_SMALL = 2 * MiB;
constexpr size_t WS_WRG = 4 * MiB;
constexpr size_t WS_WIN = 8 * MiB;
constexpr size_t WS_WOUT = 32 * MiB;
constexpr size_t WS_WGU = 40 * MiB;
constexpr size_t WS_WD = 62 * MiB;
constexpr size_t WS_MWGU = 74 * MiB;
constexpr size_t WS_MWD = 298 * MiB;
constexpr size_t WS_H = 410 * MiB;
constexpr size_t WS_XN = 474 * MiB;
constexpr size_t WS_R = 506 * MiB;
constexpr size_t WS_Z = WS_R;
constexpr size_t WS_Y = WS_R + 96 * MiB;
constexpr size_t WS_CTL_LOC = WS_R + 128 * MiB;
constexpr size_t WS_CTP = WS_R + 160 * MiB;
constexpr size_t WS_RA = WS_R + 176 * MiB;
constexpr size_t WS_RU = WS_R + 208 * MiB;
constexpr size_t WS_HID = WS_R;
constexpr size_t WS_XG = WS_R;
constexpr size_t WS_MHID = WS_R + 68 * MiB;
constexpr size_t WS_Y1 = 812 * MiB;
constexpr size_t WS_SCR = WS_R + 128 * MiB;
constexpr size_t WS_END = 880 * MiB;
constexpr int MOE_KS = 2;

constexpr int LDS_BYTES = 163840;
constexpr int MISC_OFF = LDS_BYTES - 256;

struct Ctx { const float* in[23]; float* out; unsigned char* ws; int s_lo, s_hi; };

#define XB_TMO      128
#define XB_XCNT(j)  (256  + 64 * (j))
#define XB_XSUB(j)  (1280 + 64 * (j))
#define XB_XGEN(j)  (2304 + 64 * (j))
#define XB_TOP      3328
#define XB_TOPGEN   3392
#define XCD_BAR_WORDS 3456
#define XB_SPIN_CAP (1u << 18)

__device__ __forceinline__ unsigned xb_ld(unsigned* p)              { return __hip_atomic_load(p, __ATOMIC_RELAXED, __HIP_MEMORY_SCOPE_AGENT); }
__device__ __forceinline__ unsigned xb_add(unsigned* p, unsigned v) { return __hip_atomic_fetch_add(p, v, __ATOMIC_RELAXED, __HIP_MEMORY_SCOPE_AGENT); }
__device__ __forceinline__ unsigned xb_xcc_id() { return (unsigned)__builtin_amdgcn_s_getreg((3 << 11) | 20) & 0xFu; }
#define XB_SPIN(cond, bar) do { unsigned _sp = 0; while (cond) { __builtin_amdgcn_s_sleep(1); \
    if ((++_sp & 255u) == 0u) { if (xb_ld(&(bar)[XB_TMO])) break; if (_sp > XB_SPIN_CAP) { atomicAdd(&(bar)[XB_TMO], 1u); break; } } } } while (0)

struct XcdBarrier {
    unsigned* bar; unsigned x;
    volatile LAS unsigned* st;
};

__device__ __forceinline__ XcdBarrier xcd_barrier_post(unsigned* bar, volatile LAS unsigned* st) {
    XcdBarrier b; b.bar = bar; b.x = xb_xcc_id(); b.st = st;
    if (threadIdx.x == 0) (void)xb_add(&bar[XB_XCNT(b.x)], 1u);
    return b;
}
__device__ __forceinline__ void xcd_barrier_complete(unsigned* bar, unsigned x, unsigned& nloc, unsigned& nx) {
    const unsigned G = gridDim.x * gridDim.y * gridDim.z;
    unsigned sum, cnt, mine, sp = 0u;
    for (;;) {
        sum = 0u; cnt = 0u; mine = 0u;
#pragma unroll
        for (unsigned j = 0; j < 16; ++j) { const unsigned c = xb_ld(&bar[XB_XCNT(j)]); sum += c; cnt += (c > 0u) ? 1u : 0u; mine = (j == x) ? c : mine; }
        if (sum == G) break;
        __builtin_amdgcn_s_sleep(1);
        if ((++sp & 255u) == 0u) { if (xb_ld(&bar[XB_TMO])) break; if (sp > XB_SPIN_CAP) { atomicAdd(&bar[XB_TMO], 1u); break; } }
    }
    nloc = mine > 0u ? mine : 1u; nx = cnt > 0u ? cnt : 1u;
}

__device__ __forceinline__ void xcd_barrier(const XcdBarrier& b) {
    asm volatile("s_waitcnt vmcnt(0)" ::: "memory");
    __syncthreads();
    if (threadIdx.x == 0) {
        unsigned* bar = b.bar;
        __builtin_amdgcn_s_waitcnt(0);
        unsigned nloc = b.st[0], nx = b.st[1];
        if (nloc == 0u) { xcd_barrier_complete(bar, b.x, nloc, nx); b.st[0] = nloc; b.st[1] = nx; }
        const unsigned old = xb_add(&bar[XB_XSUB(b.x)], 1u);
        const unsigned gen = old / nloc;
        if (old + 1u == (gen + 1u) * nloc) {
            __builtin_amdgcn_fence(__ATOMIC_RELEASE, "agent");
            asm volatile("s_waitcnt vmcnt(0)" ::: "memory");
            const unsigned og = xb_add(&bar[XB_TOP], 1u);
            const unsigned tg = og / nx;
            if (og + 1u == (tg + 1u) * nx) xb_add(&bar[XB_TOPGEN], 1u);
            else XB_SPIN(xb_ld(&bar[XB_TOPGEN]) == tg, bar);
            __builtin_amdgcn_fence(__ATOMIC_ACQUIRE, "agent");
            xb_add(&bar[XB_XGEN(b.x)], 1u);
            asm volatile("s_waitcnt vmcnt(0)" ::: "memory");
        } else {
            XB_SPIN(xb_ld(&bar[XB_XGEN(b.x)]) == gen, bar);
            __builtin_amdgcn_fence(__ATOMIC_ACQUIRE, "agent");
            asm volatile("s_waitcnt vmcnt(0)" ::: "memory");
        }
    }
    __syncthreads();
}

#ifndef MIX_FAST
#define MIX_FAST 1
#endif
#ifndef NV_ML
#define NV_ML 0
#endif
#ifndef NV_RG
#define NV_RG 0
#endif
__device__ __forceinline__ int opaque_bid() { int b = blockIdx.x; asm volatile("" : "+s"(b)); return b; }
#define IN_X 0
#define IN_NORM_MIX_G 1
#define IN_W_IN 2
#define IN_ML_B_IF 3
#define IN_ML_NORM_G 4
#define IN_CONV_W 5
#define IN_CONV_B 6
#define IN_RG_W_A 7
#define IN_RG_B_A 8
#define IN_RG_W_X 9
#define IN_RG_B_X 10
#define IN_RG_LAM 11
#define IN_RG_NORM_G 12
#define IN_W_OUT 13
#define IN_NORM_FFN_G 14
#define IN_FFN_WG 15
#define IN_FFN_WU 16
#define IN_FFN_WD 17
#define IN_MOE_WR 18
#define IN_MOE_WG 19
#define IN_MOE_WU 20
#define IN_MOE_WD 21
#define IN_NORM_FINAL_G 22

__device__ __forceinline__ void cvt_tile(const float* __restrict__ src, int ld, bf16* __restrict__ dst, int K, LAS float* scr, int lane) {
#pragma unroll 4
    for (int i = 0; i < 16; ++i) { const int kk = 4 * i + (lane >> 4); const f32x4 v = *(const f32x4*)(src + (size_t)kk * ld + (lane & 15) * 4);
        LAS float* s = scr + kk * 65 + (lane & 15) * 4; s[0] = v[0]; s[1] = v[1]; s[2] = v[2]; s[3] = v[3]; }
    asm volatile("s_waitcnt lgkmcnt(0)" ::: "memory");
    const int c = lane & 7;
#pragma unroll
    for (int j = 0; j < 8; ++j) { const int n = (lane >> 3) + 8 * j; const LAS float* s = scr + (8 * c) * 65 + n;
        u32x4 o; o.x = cvt_pk_bf16(s[0], s[65]); o.y = cvt_pk_bf16(s[130], s[195]); o.z = cvt_pk_bf16(s[260], s[325]); o.w = cvt_pk_bf16(s[390], s[455]);
        *(u32x4*)(dst + (size_t)n * K + 8 * c) = o; }
    asm volatile("s_waitcnt lgkmcnt(0)" ::: "memory");
}
constexpr int CV_IN = 4 * 768, CV_OUT = 4 * 256, CV_GU = 2 * 1408, CV_D = 2 * 704, CV_MGU = 16 * 1792, CV_MD = 16 * 896, CV_RG = 64;
constexpr int CV_TOTAL = CV_IN + CV_OUT + CV_GU + CV_D + CV_MGU + CV_MD + CV_RG;
__device__ __forceinline__ void cvt_phase(const Ctx& c, LAS unsigned char* lds) {
    int tid_o = threadIdx.x; asm volatile("" : "+v"(tid_o));
    const int tid = tid_o, lane = tid & 63, wave = __builtin_amdgcn_readfirstlane(tid >> 6);
    LAS float* scr = (LAS float*)(lds + wave * 16640);
    const int gw = opaque_bid() * NWAVES + wave, NGW = gridDim.x * NWAVES;
    for (int it0 = gw; it0 < CV_TOTAL; it0 += NGW) {
        int it = it0; const float* src; int ld, K; bf16* dst;
        if (it < CV_IN) { const int l = it / 768, r = it % 768, nt = r % 48, kt = r / 48, n0 = 64 * nt, k0 = 64 * kt, sc = n0 < 2048 ? n0 : n0 + 8;
            src = c.in[IN_W_IN] + (size_t)l * D * DIN + (size_t)k0 * DIN + sc; ld = DIN; K = D; dst = (bf16*)(c.ws + WS_WIN) + (size_t)l * NZ * D + (size_t)n0 * D + k0; }
        else if ((it -= CV_IN) < CV_OUT) { const int l = it / 256, r = it % 256, nt = r % 16, kt = r / 16, n0 = 64 * nt, k0 = 64 * kt;
            src = c.in[IN_W_OUT] + (size_t)l * D * D + (size_t)k0 * D + n0; ld = D; K = D; dst = (bf16*)(c.ws + WS_WOUT) + (size_t)l * D * D + (size_t)n0 * D + k0; }
        else if ((it -= CV_OUT) < CV_GU) { const int j = it / 1408, r = it % 1408, nt = r % 88, kt = r / 88, n0 = 64 * nt, k0 = 64 * kt, jj = n0 >> 8, cc = n0 & 255;
            src = (cc < 128 ? c.in[IN_FFN_WG] : c.in[IN_FFN_WU]) + (size_t)j * D * FFD + (size_t)k0 * FFD + jj * 128 + (cc & 127); ld = FFD; K = D;
            dst = (bf16*)(c.ws + WS_WGU) + (size_t)j * 2 * FFD * D + (size_t)n0 * D + k0; }
        else if ((it -= CV_GU) < CV_D) { const int j = it / 704, r = it % 704, nt = r % 16, kt = r / 16, n0 = 64 * nt, k0 = 64 * kt;
            src = c.in[IN_FFN_WD] + (size_t)j * FFD * D + (size_t)k0 * D + n0; ld = D; K = FFD; dst = (bf16*)(c.ws + WS_WD) + (size_t)j * D * FFD + (size_t)n0 * FFD + k0; }
        else if ((it -= CV_D) < CV_MGU) { const int je = it / 1792, r = it % 1792, nt = r % 112, kt = r / 112, n0 = 64 * nt, k0 = 64 * kt, jj = n0 >> 8, cc = n0 & 255;
            src = (cc < 128 ? c.in[IN_MOE_WG] : c.in[IN_MOE_WU]) + (size_t)je * D * FFE + (size_t)k0 * FFE + jj * 128 + (cc & 127); ld = FFE; K = D;
            dst = (bf16*)(c.ws + WS_MWGU) + (size_t)je * 2 * FFE * D + (size_t)n0 * D + k0; }
        else if ((it -= CV_MGU) < CV_MD) { const int je = it / 896, r = it % 896, nt = r % 16, kt = r / 16, n0 = 64 * nt, k0 = 64 * kt;
            src = c.in[IN_MOE_WD] + (size_t)je * FFE * D + (size_t)k0 * D + n0; ld = D; K = FFE; dst = (bf16*)(c.ws + WS_MWD) + (size_t)je * D * FFE + (size_t)n0 * FFE + k0; }
        else { it -= CV_MD; const int l = it >> 4, which = (it >> 3) & 1, g = it & 7;
            src = c.in[which ? IN_RG_W_X : IN_RG_W_A] + (size_t)(l * RGB + g) * RGD * RGD; ld = RGD; K = RGD; dst = (bf16*)(c.ws + WS_WRG) + (size_t)((l * 2 + which) * RGB + g) * RGD * RGD; }
        cvt_tile(src, ld, dst, K, scr, lane);
    }
}

constexpr int W8S = 1028;
template <int MODE>
__device__ __forceinline__ void norm_phase(const Ctx& c, int l, bool combine, LAS unsigned char* lds) {
    int tid_o = threadIdx.x; asm volatile("" : "+v"(tid_o));
    const int tid = tid_o, lane = tid & 63, wave = __builtin_amdgcn_readfirstlane(tid >> 6);
    LAS float* w8 = (LAS float*)lds; LAS int* cnt = (LAS int*)(lds + 8 * W8S * 4);
    float* h = (float*)(c.ws + WS_H); bf16* xn = (bf16*)(c.ws + WS_XN); const float* hsrc = (MODE == 1 && l == 0) ? c.in[IN_X] : h;
    const float* gain = MODE == 1 ? c.in[IN_NORM_MIX_G] + l * D : (MODE == 3 ? c.in[IN_NORM_FINAL_G] : c.in[IN_NORM_FFN_G] + l * D);
    if (MODE == 1 || MODE == 2) {
        const float* wsrc = MODE == 1 ? c.in[IN_W_IN] + (size_t)l * D * DIN + 2048 : c.in[IN_MOE_WR] + (size_t)(l >> 1) * D * NE; const int ldw = MODE == 1 ? DIN : NE;
        for (int i = tid; i < 8 * D; i += NTHR) { const int k = i >> 3, j = i & 7; w8[j * W8S + k] = wsrc[(size_t)k * ldw + j]; }
    }
    f32x4 gg[4];
#pragma unroll
    for (int j = 0; j < 4; ++j) gg[j] = *(const f32x4*)(gain + 4 * (lane + 64 * j));
    const int* pos = (const int*)(c.ws + WS_POS); const float* ew = (const float*)(c.ws + WS_EW); const bf16* Y = (const bf16*)(c.ws + WS_XG); const bf16* Y1 = (const bf16*)(c.ws + WS_Y1);
    for (int tb = opaque_bid(); tb < T / 64; tb += gridDim.x) {
        if (MODE == 2) { if (tid < 8) cnt[tid] = 0; }
        __syncthreads();
        for (int i = 0; i < 8; ++i) {
            const int t = tb * 64 + wave * 8 + i;
            float* hrow = h + (size_t)t * D; const float* hin = hsrc + (size_t)t * D; f32x4 v[4];
#pragma unroll
            for (int j = 0; j < 4; ++j) v[j] = *(const f32x4*)(hin + 4 * (lane + 64 * j));
            if (combine) {
                const int p0 = pos[2 * t], p1 = pos[2 * t + 1]; const float w0 = ew[2 * t], w1 = ew[2 * t + 1];
#pragma unroll
                for (int j = 0; j < 4; ++j) { const size_t o0 = (size_t)p0 * D + 4 * (lane + 64 * j), o1 = (size_t)p1 * D + 4 * (lane + 64 * j);
                    const u32x2 a = *(const u32x2*)(Y + o0), b = *(const u32x2*)(Y + o1), a2 = *(const u32x2*)(Y1 + o0), b2 = *(const u32x2*)(Y1 + o1);
                    v[j][0] += w0 * (bflo(a.x) + bflo(a2.x)) + w1 * (bflo(b.x) + bflo(b2.x)); v[j][1] += w0 * (bfhi(a.x) + bfhi(a2.x)) + w1 * (bfhi(b.x) + bfhi(b2.x));
                    v[j][2] += w0 * (bflo(a.y) + bflo(a2.y)) + w1 * (bflo(b.y) + bflo(b2.y)); v[j][3] += w0 * (bfhi(a.y) + bfhi(a2.y)) + w1 * (bfhi(b.y) + bfhi(b2.y)); }
                if (MODE != 3) {
#pragma unroll
                    for (int j = 0; j < 4; ++j) *(f32x4*)(hrow + 4 * (lane + 64 * j)) = v[j]; }
            }
            float s = 0.f;
#pragma unroll
            for (int j = 0; j < 4; ++j) s += (v[j][0] * v[j][0] + v[j][1] * v[j][1]) + (v[j][2] * v[j][2] + v[j][3] * v[j][3]);
            const float r = rsqrtf(wave_sum(s) * (1.f / D) + EPS);
#pragma unroll
            for (int j = 0; j < 4; ++j) v[j] = v[j] * r * gg[j];
            if (MODE == 3) {
#pragma unroll
                for (int j = 0; j < 4; ++j) *(f32x4*)(c.out + (size_t)t * D + 4 * (lane + 64 * j)) = v[j];
            } else {
#pragma unroll
                for (int j = 0; j < 4; ++j) { u32x2 o; o.x = cvt_pk_bf16(v[j][0], v[j][1]); o.y = cvt_pk_bf16(v[j][2], v[j][3]); *(u32x2*)(xn + (size_t)t * D + 4 * (lane + 64 * j)) = o; }
            }
            if (MODE == 1 || MODE == 2) {
                float d8[8];
#pragma unroll
                for (int g = 0; g < 8; ++g) { float a = 0.f;
#pragma unroll
                    for (int j = 0; j < 4; ++j) { const f32x4 w = *(const LAS f32x4*)(w8 + g * W8S + 4 * (lane + 64 * j)); a += (v[j][0] * w[0] + v[j][1] * w[1]) + (v[j][2] * w[2] + v[j][3] * w[3]); }
                    d8[g] = wave_sum(a); }
                if (MODE == 1) {
                    float sel = d8[0];
#pragma unroll
                    for (int g = 1; g < 8; ++g) sel = (lane == g) ? d8[g] : sel;
                    if (lane < 8) ((float*)(c.ws + WS_IFP))[(size_t)t * 8 + lane] = sel + c.in[IN_ML_B_IF][l * 8 + lane];
                } else {
                    int i0 = 0; float v0 = d8[0];
#pragma unroll
                    for (int e = 1; e < NE; ++e) if (d8[e] > v0) { v0 = d8[e]; i0 = e; }
                    int i1 = -1; float v1 = -3.4e38f;
#pragma unroll
                    for (int e = 0; e < NE; ++e) if (e != i0 && d8[e] > v1) { v1 = d8[e]; i1 = e; }
                    if (lane == 0) { int* eidx = (int*)(c.ws + WS_EIDX); float* eww = (float*)(c.ws + WS_EW); eidx[2 * t] = i0; eidx[2 * t + 1] = i1;
                        const float w0 = 1.f / (1.f + __expf(v1 - v0)); eww[2 * t] = w0; eww[2 * t + 1] = 1.f - w0; __hip_atomic_fetch_add(&cnt[i0], 1, __ATOMIC_RELAXED, __HIP_MEMORY_SCOPE_WORKGROUP); __hip_atomic_fetch_add(&cnt[i1], 1, __ATOMIC_RELAXED, __HIP_MEMORY_SCOPE_WORKGROUP); }
                }
            }
        }
        if (MODE == 2) { __syncthreads(); if (tid < 8) ((int*)(c.ws + WS_BLKCNT))[tb * 8 + tid] = cnt[tid]; }
    }
}

__device__ __forceinline__ void moe_gather_phase(const Ctx& c, LAS unsigned char* lds) {
    int tid_o = threadIdx.x; asm volatile("" : "+v"(tid_o));
    const int tid = tid_o, lane = tid & 63, wave = __builtin_amdgcn_readfirstlane(tid >> 6);
    LAS int* tot = (LAS int*)lds; LAS int* bef = tot + 8; LAS int* off = tot + 16; LAS int* lpos = tot + 32;
    const int* blkcnt = (const int*)(c.ws + WS_BLKCNT); const int* eidx = (const int*)(c.ws + WS_EIDX); int* pos = (int*)(c.ws + WS_POS); int* meta = (int*)(c.ws + WS_META);
    const bf16* xn = (const bf16*)(c.ws + WS_XN); bf16* Xg = (bf16*)(c.ws + WS_XG);
    for (int tb = opaque_bid(); tb < T / 64; tb += gridDim.x) {
        __syncthreads();
        if (tid < 16) tot[tid] = 0;
        __syncthreads();
        { const int e = tid & 7, part = tid >> 3; int st = 0, sb = 0;
#pragma unroll
          for (int q = 0; q < 4; ++q) { const int b = part * 4 + q; const int v = blkcnt[b * 8 + e]; st += v; sb += (b < tb) ? v : 0; }
          __hip_atomic_fetch_add(&tot[e], st, __ATOMIC_RELAXED, __HIP_MEMORY_SCOPE_WORKGROUP); __hip_atomic_fetch_add(&bef[e], sb, __ATOMIC_RELAXED, __HIP_MEMORY_SCOPE_WORKGROUP); }
        __syncthreads();
        if (tid == 0) { int o = 0; for (int e = 0; e < NE; ++e) { off[e] = o; o += (tot[e] + 255) & ~255; } off[NE] = o; }
        __syncthreads();
        if (wave == 0) {
            const int t = tb * 64 + lane; const int e0 = eidx[2 * t], e1 = eidx[2 * t + 1]; int r0 = 0, r1 = 0; const unsigned long long lt = (1ull << lane) - 1ull;
#pragma unroll
            for (int e = 0; e < NE; ++e) { const unsigned long long m0 = __ballot(e0 == e), m1 = __ballot(e1 == e);
                if (e0 == e) r0 = __popcll(m0 & lt); if (e1 == e) r1 = __popcll(m0) + __popcll(m1 & lt); }
            const int p0 = off[e0] + bef[e0] + r0, p1 = off[e1] + bef[e1] + r1;
            pos[2 * t] = p0; pos[2 * t + 1] = p1; lpos[2 * lane] = p0; lpos[2 * lane + 1] = p1;
        }
        __syncthreads();
        for (int q = wave; q < 128; q += NWAVES) { const int t = tb * 64 + (q >> 1); const int p = lpos[q];
            const u32x4* s = (const u32x4*)(xn + (size_t)t * D); u32x4* d = (u32x4*)(Xg + (size_t)p * D); const u32x4 a = s[lane], b = s[lane + 64]; d[lane] = a; d[lane + 64] = b; }
        if (tb < NE) { const int r0 = off[tb] + tot[tb], r1 = off[tb + 1]; const u32x4 zz = {0u, 0u, 0u, 0u};
            for (int r = r0 + wave; r < r1; r += NWAVES) { u32x4* d = (u32x4*)(Xg + (size_t)r * D); d[lane] = zz; d[lane + 64] = zz; } }
        if (tb == 0) { if (tid < 9) meta[tid] = off[tid]; if (tid == 0) meta[16] = off[NE] >> 8;
            for (int tl = tid; tl < MAXT256; tl += NTHR) { const int r = tl * 256; int e = 0;
#pragma unroll
                for (int q = 0; q < NE; ++q) if (r >= off[q]) e = q;
                meta[32 + tl] = e; } }
    }
}


typedef short s16x4 __attribute__((ext_vector_type(4)));
constexpr size_t SM_CG = WS_SMALL, SM_CM = WS_SMALL + 4096, SM_MP = WS_SMALL + 8192;
constexpr size_t SM_NL = WS_SMALL + 65536, SM_NP = WS_SMALL + 327680;
constexpr size_t SM_RGA = WS_SMALL + 589824, SM_RGH = WS_SMALL + 1114112;
constexpr size_t SM_RGC = 5 * MiB;
constexpr int TROW = 272;
constexpr int TILE_B = 128 * TROW;
constexpr float KSC = 0.08838834764831845f;

__device__ __forceinline__ float wscan_add(float v, int lane) {
#pragma unroll
    for (int o = 1; o < 64; o <<= 1) { const float t = __shfl_up(v, o); v = (lane >= o) ? v + t : v; }
    return v;
}
__device__ __forceinline__ float wscan_max(float v, int lane) {
#pragma unroll
    for (int o = 1; o < 64; o <<= 1) { const float t = __shfl_up(v, o); v = (lane >= o) ? fmaxf(v, t) : v; }
    return v;
}
__device__ __forceinline__ float wave_max(float v) {
#pragma unroll
    for (int o = 1; o < 64; o <<= 1) v = fmaxf(v, __shfl_xor(v, o));
    return v;
}
__device__ __forceinline__ float logsigmoidf_(float x) { return -log1pf(__expf(-x)); }
__device__ __forceinline__ void stage_tile(const bf16* __restrict__ g, int ldg, LAS unsigned char* tile, int tid) {
#pragma unroll
    for (int i = 0; i < 4; ++i) { const int ch = tid + NTHR * i, r = ch >> 4, c16 = ch & 15; const u32x4 v = *(const u32x4*)(g + (size_t)r * ldg + c16 * 8); *(LAS u32x4*)(tile + r * TROW + c16 * 16) = v; }
}
__device__ __forceinline__ bf16x8 frag_row(const LAS unsigned char* tile, int row, int ks, int fq) { return *(const LAS bf16x8*)(tile + row * TROW + (32 * ks + 8 * fq) * 2); }
__device__ __forceinline__ bf16x8 frag_tr(const LAS unsigned char* tile, int n0, int ks, int lane) {
    const int i16 = lane & 15, q = i16 >> 2, p = i16 & 3, fq = lane >> 4;
    const LAS unsigned char* a = tile + (32 * ks + 8 * fq + q) * TROW + n0 * 2 + 8 * p;
    const s16x4 lo = __builtin_amdgcn_ds_read_tr16_b64_v4i16((LAS s16x4*)a), hi = __builtin_amdgcn_ds_read_tr16_b64_v4i16((LAS s16x4*)(a + 4 * TROW));
    return __builtin_shufflevector(lo, hi, 0, 1, 2, 3, 4, 5, 6, 7);
}
#define MFMA16(a, b, c) __builtin_amdgcn_mfma_f32_16x16x32_bf16((a), (b), (c), 0, 0, 0)

constexpr int CGRP_B = 73728;
__device__ __forceinline__ void mix_c_mlstm(const Ctx& c, int u, LAS unsigned char* lds, int tid, int lane, int wave) {
    const int bh = u >> 5, ck = u & 31, b = bh >> 2, h = bh & 3; const size_t t0 = (size_t)b * SEQ + (size_t)ck * 128;
    LAS unsigned char* TKW = lds; LAS unsigned char* TV = lds + TILE_B; LAS float* fw = (LAS float*)(lds + 2 * TILE_B); LAS float* np = fw + 128;
    const float* ifp = (const float*)(c.ws + WS_IFP); const bf16* z = (const bf16*)(c.ws + WS_Z);
    u32x4 kv[8], vv[8];
#pragma unroll
    for (int i = 0; i < 8; ++i) { const int ch = tid + 256 * i, r = ch >> 4, c16 = ch & 15; const bf16* row = z + (t0 + r) * NZ + h * DH + c16 * 8; kv[i] = *(const u32x4*)(row + ZK); vv[i] = *(const u32x4*)(row + ZV); }
    if (wave == 0) {
        const float x0 = ifp[(t0 + 2 * lane) * 8 + 4 + h], x1 = ifp[(t0 + 2 * lane + 1) * 8 + 4 + h];
        const float li0 = ifp[(t0 + 2 * lane) * 8 + h], li1 = ifp[(t0 + 2 * lane + 1) * 8 + h];
        const float lf0 = logsigmoidf_(x0), lf1 = logsigmoidf_(x1), s = lf0 + lf1, inc = wscan_add(s, lane), ex = inc - s, b0 = ex + lf0, b1 = b0 + lf1;
        const float g = __shfl(inc, 63);
        const float a0 = g - b0 + li0, a1 = g - b1 + li1, m = wave_max(fmaxf(a0, a1));
        fw[2 * lane] = __expf(a0 - m) * KSC; fw[2 * lane + 1] = __expf(a1 - m) * KSC;
        if (lane == 0) { ((float*)(c.ws + SM_CG))[bh * 32 + ck] = g; ((float*)(c.ws + SM_CM))[bh * 32 + ck] = m; }
    }
    __syncthreads();
#pragma unroll
    for (int i = 0; i < 8; ++i) { const int ch = tid + 256 * i, r = ch >> 4, c16 = ch & 15; const float sc = fw[r]; u32x4 ko;
        ko.x = cvt_pk_bf16(bflo(kv[i].x) * sc, bfhi(kv[i].x) * sc); ko.y = cvt_pk_bf16(bflo(kv[i].y) * sc, bfhi(kv[i].y) * sc); ko.z = cvt_pk_bf16(bflo(kv[i].z) * sc, bfhi(kv[i].z) * sc); ko.w = cvt_pk_bf16(bflo(kv[i].w) * sc, bfhi(kv[i].w) * sc);
        *(LAS u32x4*)(TKW + r * TROW + c16 * 16) = ko; *(LAS u32x4*)(TV + r * TROW + c16 * 16) = vv[i]; }
    __syncthreads();
    { const int d = tid & 127, q = tid >> 7; float s = 0.f;
#pragma unroll 16
      for (int l = 64 * q; l < 64 * q + 64; ++l) s += bf2f(*(const LAS bf16*)(TKW + l * TROW + d * 2));
      np[q * 128 + d] = s; }
    const int wr = wave >> 1, wc = wave & 1, fr = lane & 15, fq = lane >> 4;
    f32x4 acc[4][4];
#pragma unroll
    for (int i = 0; i < 4; ++i)
#pragma unroll
        for (int j = 0; j < 4; ++j) acc[i][j] = (f32x4){0.f, 0.f, 0.f, 0.f};
#pragma unroll
    for (int ks = 0; ks < 4; ++ks) { bf16x8 A[4], B[4];
#pragma unroll
        for (int dt = 0; dt < 4; ++dt) A[dt] = frag_tr(TKW, 64 * wr + 16 * dt, ks, lane);
#pragma unroll
        for (int et = 0; et < 4; ++et) B[et] = frag_tr(TV, 64 * wc + 16 * et, ks, lane);
#pragma unroll
        for (int dt = 0; dt < 4; ++dt)
#pragma unroll
            for (int et = 0; et < 4; ++et) acc[dt][et] = MFMA16(A[dt], B[et], acc[dt][et]); }
    float* CTL = (float*)(c.ws + WS_CTL_LOC) + ((size_t)(bh * 32 + ck) << 14);
#pragma unroll
    for (int dt = 0; dt < 4; ++dt)
#pragma unroll
        for (int et = 0; et < 4; ++et) *(f32x4*)(CTL + (size_t)(64 * wc + 16 * et + fr) * 128 + 64 * wr + 16 * dt + 4 * fq) = acc[dt][et];
    __syncthreads();
    if (tid < 128) ((float*)(c.ws + SM_NL))[(size_t)(bh * 32 + ck) * 128 + tid] = np[tid] + np[128 + tid];
    __syncthreads();
}

__device__ __forceinline__ float fsig(float x) { return __builtin_amdgcn_rcpf(1.f + __expf(-x)); }
__device__ __forceinline__ void mix_c_rg(const Ctx& c, int l, int u, LAS unsigned char* lds, int lane, int wave) {
    const int b = u >> 6, ck = u & 63, g = wave; const size_t t0 = (size_t)b * SEQ + (size_t)ck * 64;
    LAS unsigned char* XC = lds + wave * 9216;
    const bf16* z = (const bf16*)(c.ws + WS_Z); const int l15 = lane & 15, fq = lane >> 4;
    {
        const int c4 = 64 * g + 4 * l15; const float* cw = c.in[IN_CONV_W] + l * 4 * RGW + c4; const f32x4 w0 = *(const f32x4*)cw, w1 = *(const f32x4*)(cw + RGW), w2 = *(const f32x4*)(cw + 2 * RGW), w3 = *(const f32x4*)(cw + 3 * RGW), cb = *(const f32x4*)(c.in[IN_CONV_B] + l * RGW + c4);
        u32x2 xr[19];
#pragma unroll
        for (int j = 0; j < 19; ++j) { const int tt = 16 * fq - 3 + j; const bool okk = (ck * 64 + tt >= 0); const u32x2 v = *(const u32x2*)(z + (size_t)((long)t0 + (okk ? tt : 0)) * NZ + ZRX + c4); xr[j].x = okk ? v.x : 0u; xr[j].y = okk ? v.y : 0u; }
#pragma unroll
        for (int j = 0; j < 16; ++j) { f32x4 xc;
            xc[0] = cb[0] + w0[0] * bflo(xr[j].x) + w1[0] * bflo(xr[j + 1].x) + w2[0] * bflo(xr[j + 2].x) + w3[0] * bflo(xr[j + 3].x);
            xc[1] = cb[1] + w0[1] * bfhi(xr[j].x) + w1[1] * bfhi(xr[j + 1].x) + w2[1] * bfhi(xr[j + 2].x) + w3[1] * bfhi(xr[j + 3].x);
            xc[2] = cb[2] + w0[2] * bflo(xr[j].y) + w1[2] * bflo(xr[j + 1].y) + w2[2] * bflo(xr[j + 2].y) + w3[2] * bflo(xr[j + 3].y);
            xc[3] = cb[3] + w0[3] * bfhi(xr[j].y) + w1[3] * bfhi(xr[j + 1].y) + w2[3] * bfhi(xr[j + 2].y) + w3[3] * bfhi(xr[j + 3].y);
            u32x2 o; o.x = cvt_pk_bf16(xc[0], xc[1]); o.y = cvt_pk_bf16(xc[2], xc[3]); *(LAS u32x2*)(XC + (16 * fq + j) * 144 + l15 * 8) = o; }
    }
    bf16x8 Af[4][2];
#pragma unroll
    for (int m = 0; m < 4; ++m)
#pragma unroll
        for (int ks = 0; ks < 2; ++ks) Af[m][ks] = *(const LAS bf16x8*)(XC + (16 * m + l15) * 144 + (32 * ks + 8 * fq) * 2);
    const bf16* WTa = (const bf16*)(c.ws + WS_WRG) + (size_t)((l * 2 + 0) * RGB + g) * RGD * RGD; const bf16* WTx = (const bf16*)(c.ws + WS_WRG) + (size_t)((l * 2 + 1) * RGB + g) * RGD * RGD;
    unsigned* RP = (unsigned*)(c.ws + WS_RA);
#pragma unroll
    for (int n = 0; n < 4; ++n) {
        const int jo = 16 * n + l15, cc = 64 * g + jo;
        f32x4 aa[4], ax[4];
#pragma unroll
        for (int m = 0; m < 4; ++m) { aa[m] = (f32x4){0.f, 0.f, 0.f, 0.f}; ax[m] = (f32x4){0.f, 0.f, 0.f, 0.f}; }
#pragma unroll
        for (int ks = 0; ks < 2; ++ks) { const bf16x8 Ba = *(const bf16x8*)(WTa + jo * RGD + 32 * ks + 8 * fq), Bx = *(const bf16x8*)(WTx + jo * RGD + 32 * ks + 8 * fq);
#pragma unroll
            for (int m = 0; m < 4; ++m) { aa[m] = MFMA16(Af[m][ks], Ba, aa[m]); ax[m] = MFMA16(Af[m][ks], Bx, ax[m]); } }
        const float ba = c.in[IN_RG_B_A][l * RGW + cc], bx = c.in[IN_RG_B_X][l * RGW + cc], sp8 = -8.f * __logf(1.f + __expf(-c.in[IN_RG_LAM][l * RGW + cc]));
        float cA[4][4], hL[4][4], SA[4], SH[4];
#pragma unroll
        for (int m = 0; m < 4; ++m) { float Ar = 1.f, Hr = 0.f;
#pragma unroll
            for (int r = 0; r < 4; ++r) { const int t = 16 * m + 4 * fq + r;
                const float la = sp8 * fsig(aa[m][r] + ba), a = __expf(la), ig = fsig(ax[m][r] + bx), xcv = bf2f(*(const LAS bf16*)(XC + t * 144 + jo * 2));
                const float tt = -2.f * la, ser = tt * (1.f - tt * (0.5f - tt * (0.16666667f - tt * (0.041666668f - tt * 0.0083333333f)))), om = tt < 0.25f ? ser : 1.f - a * a;
                const float uu = __builtin_amdgcn_sqrtf(om) * (ig * xcv);
                Hr = a * Hr + uu; Ar *= a; cA[m][r] = Ar; hL[m][r] = Hr; }
            SA[m] = Ar; SH[m] = Hr; }
        float CA = 1.f, CH = 0.f; unsigned* rp = RP + (t0 + 4 * fq) * RGW + cc;
#pragma unroll
        for (int m = 0; m < 4; ++m) {
            float IA = SA[m], IH = SH[m];
            { const float Ap = __shfl_up(IA, 16), Hp = __shfl_up(IH, 16); if (fq >= 1) { IH = IA * Hp + IH; IA = IA * Ap; } }
            { const float Ap = __shfl_up(IA, 32), Hp = __shfl_up(IH, 32); if (fq >= 2) { IH = IA * Hp + IH; IA = IA * Ap; } }
            float EA = __shfl_up(IA, 16), EH = __shfl_up(IH, 16); if (fq == 0) { EA = 1.f; EH = 0.f; }
            const float TA = __shfl(IA, l15 + 48), TH = __shfl(IH, l15 + 48);
            const float PA = CA * EA, PH = EA * CH + EH;
#pragma unroll
            for (int r = 0; r < 4; ++r) rp[(size_t)(16 * m + r) * RGW] = cvt_pk_bf16(PA * cA[m][r], hL[m][r] + cA[m][r] * PH);
            CH = TA * CH + TH; CA = CA * TA;
        }
        if (fq == 0) { ((float*)(c.ws + SM_RGA))[(size_t)(b * 64 + ck) * RGW + cc] = CA; ((float*)(c.ws + SM_RGH))[(size_t)(b * 64 + ck) * RGW + cc] = CH; }
    }
}

__device__ __forceinline__ void mix_d(const Ctx& c, LAS unsigned char* lds, int tid, int lane, int wave) {
    for (int w = opaque_bid(); w < 256; w += gridDim.x) {
        const int bh = w >> 4, sl = w & 15; LAS float* sg = (LAS float*)lds; LAS float* sm = sg + 32;
        __syncthreads();
        if (tid < 32) { sg[tid] = ((const float*)(c.ws + SM_CG))[bh * 32 + tid]; sm[tid] = ((const float*)(c.ws + SM_CM))[bh * 32 + tid]; }
        __syncthreads();
        const int idx = tid * 2, el = idx >> 7, d = idx & 127; const size_t off = (size_t)(8 * sl + el) * 128 + d;
        const float* CTL = (const float*)(c.ws + WS_CTL_LOC) + ((size_t)(bh * 32) << 14) + off; bf16* CTP = (bf16*)(c.ws + WS_CTP) + ((size_t)(bh * 32) << 14) + off;
        const bool nown = (sl == 0 && tid < 128);
        const float* NL = (const float*)(c.ws + SM_NL) + (size_t)(bh * 32) * 128 + (tid & 127); float* NP = (float*)(c.ws + SM_NP) + (size_t)(bh * 32) * 128 + (tid & 127);
        f32x2 ld[32]; float nl[32];
#pragma unroll
        for (int ck = 0; ck < 32; ++ck) { ld[ck] = *(const f32x2*)(CTL + ((size_t)ck << 14)); nl[ck] = nown ? NL[ck * 128] : 0.f; }
        f32x2 st = {0.f, 0.f}; float nst = 0.f, m = 0.f;
#pragma unroll
        for (int ck = 0; ck < 32; ++ck) {
            *(unsigned*)(CTP + ((size_t)ck << 14)) = cvt_pk_bf16(st.x, st.y);
            if (nown) NP[ck * 128] = nst;
            if (sl == 0 && tid == 0) ((float*)(c.ws + SM_MP))[bh * 32 + ck] = m;
            const float g = sg[ck], ml = sm[ck], mn = fmaxf(g + m, ml), so = __expf(g + m - mn), sc = __expf(ml - mn);
            st = st * so + ld[ck] * sc; nst = nst * so + nl[ck] * sc; m = mn;
        }
    }
    for (int gw = opaque_bid() * NWAVES + wave; gw < BATCH * RGW; gw += gridDim.x * NWAVES) {
        const int b = gw >> 9, ch = gw & 511; const size_t o = (size_t)(b * 64 + lane) * RGW + ch;
        float A = ((const float*)(c.ws + SM_RGA))[o], H = ((const float*)(c.ws + SM_RGH))[o];
#pragma unroll
        for (int s = 1; s < 64; s <<= 1) { const float Ap = __shfl_up(A, s), Hp = __shfl_up(H, s); if (lane >= s) { H = A * Hp + H; A = A * Ap; } }
        float cin = __shfl_up(H, 1); if (lane == 0) cin = 0.f;
        ((float*)(c.ws + SM_RGC))[o] = cin;
    }
}

__device__ __forceinline__ void mix_e_mlstm(const Ctx& c, int l, int u, LAS unsigned char* lds, int tid, int lane, int wave) {
    const int bh = u >> 5, ck = u & 31, b = bh >> 2, h = bh & 3; const size_t t0 = (size_t)b * SEQ + (size_t)ck * 128;
    LAS unsigned char* TQ = lds; LAS unsigned char* TK = lds + TILE_B; LAS unsigned char* TV = lds + 2 * TILE_B; LAS unsigned char* TC = lds + 3 * TILE_B; LAS unsigned char* TS = TK;
    LAS float* fb = (LAS float*)(lds + 4 * TILE_B); LAS float* fcs = fb + 128; LAS float* fpm = fb + 256; LAS float* fisc = fb + 384; LAS float* fqn = fb + 512; LAS float* fnp = fb + 640;
    LAS float* pden = fb + 768; LAS float* pss = fb + 1280;
    const float* ifp = (const float*)(c.ws + WS_IFP); const bf16* z = (const bf16*)(c.ws + WS_Z);
    if (wave == 0) {
        const float x0 = ifp[(t0 + 2 * lane) * 8 + 4 + h], x1 = ifp[(t0 + 2 * lane + 1) * 8 + 4 + h];
        const float lf0 = logsigmoidf_(x0), lf1 = logsigmoidf_(x1), s = lf0 + lf1, inc = wscan_add(s, lane), ex = inc - s, b0 = ex + lf0, b1 = b0 + lf1;
        const float li0 = ifp[(t0 + 2 * lane) * 8 + h], li1 = ifp[(t0 + 2 * lane + 1) * 8 + h];
        const float cs0 = li0 - b0, cs1 = li1 - b1, p1 = fmaxf(cs0, cs1), incm = wscan_max(p1, lane);
        float exm = __shfl_up(incm, 1); if (lane == 0) exm = -3.0e38f;
        const float mp = ((const float*)(c.ws + SM_MP))[bh * 32 + ck];
        const float pm0 = fmaxf(fmaxf(exm, cs0), mp), pm1 = fmaxf(fmaxf(exm, p1), mp);
        fb[2 * lane] = b0; fb[2 * lane + 1] = b1; fcs[2 * lane] = cs0; fcs[2 * lane + 1] = cs1; fpm[2 * lane] = pm0; fpm[2 * lane + 1] = pm1;
        fisc[2 * lane] = __expf(mp - pm0); fisc[2 * lane + 1] = __expf(mp - pm1);
    }
    stage_tile(z + t0 * NZ + ZQ + h * DH, NZ, TQ, tid); stage_tile(z + t0 * NZ + ZK + h * DH, NZ, TK, tid); stage_tile(z + t0 * NZ + ZV + h * DH, NZ, TV, tid);
    stage_tile((const bf16*)(c.ws + WS_CTP) + ((size_t)(bh * 32 + ck) << 14), 128, TC, tid);
    if (tid < 128) fnp[tid] = ((const float*)(c.ws + SM_NP))[(size_t)(bh * 32 + ck) * 128 + tid];
    __syncthreads();
    { const int row = tid >> 2, qt = tid & 3; float s = 0.f;
#pragma unroll
      for (int i = 0; i < 4; ++i) { const u32x4 qv = *(const LAS u32x4*)(TQ + row * TROW + (32 * qt + 8 * i) * 2); const LAS float* nn = fnp + 32 * qt + 8 * i;
          s += bflo(qv.x) * nn[0] + bfhi(qv.x) * nn[1] + bflo(qv.y) * nn[2] + bfhi(qv.y) * nn[3] + bflo(qv.z) * nn[4] + bfhi(qv.z) * nn[5] + bflo(qv.w) * nn[6] + bfhi(qv.w) * nn[7]; }
      s += __shfl_xor(s, 1); s += __shfl_xor(s, 2); if (qt == 0) fqn[row] = s; }
    const int wr = wave >> 2, wc = wave & 3, fr = lane & 15, fq = lane >> 4;
    f32x4 aS[4][2];
#pragma unroll
    for (int i = 0; i < 4; ++i)
#pragma unroll
        for (int j = 0; j < 2; ++j) aS[i][j] = (f32x4){0.f, 0.f, 0.f, 0.f};
#pragma unroll
    for (int ks = 0; ks < 4; ++ks) { bf16x8 A[4], B[2];
#pragma unroll
        for (int m = 0; m < 4; ++m) A[m] = frag_row(TQ, 64 * wr + 16 * m + fr, ks, fq);
#pragma unroll
        for (int n = 0; n < 2; ++n) B[n] = frag_row(TK, 32 * wc + 16 * n + fr, ks, fq);
#pragma unroll
        for (int m = 0; m < 4; ++m)
#pragma unroll
            for (int n = 0; n < 2; ++n) aS[m][n] = MFMA16(B[n], A[m], aS[m][n]); }
    __syncthreads();
#pragma unroll
    for (int m = 0; m < 4; ++m) { const int lr = 64 * wr + 16 * m + fr; const float pm = fpm[lr]; float ds = 0.f;
#pragma unroll
        for (int n = 0; n < 2; ++n) { const int s0 = 32 * wc + 16 * n + 4 * fq; float v[4];
#pragma unroll
            for (int j = 0; j < 4; ++j) { const int s = s0 + j; const float wgt = (s <= lr) ? __expf(fcs[s] - pm) : 0.f; v[j] = aS[m][n][j] * wgt * KSC; ds += v[j]; }
            u32x2 o; o.x = cvt_pk_bf16(v[0], v[1]); o.y = cvt_pk_bf16(v[2], v[3]); *(LAS u32x2*)(TS + lr * TROW + s0 * 2) = o; }
        ds += __shfl_xor(ds, 16); ds += __shfl_xor(ds, 32); if (fq == 0) pden[lr * 4 + wc] = ds; }
    __syncthreads();
    f32x4 a1[4][2], a2[4][2];
#pragma unroll
    for (int i = 0; i < 4; ++i)
#pragma unroll
        for (int j = 0; j < 2; ++j) { a1[i][j] = (f32x4){0.f, 0.f, 0.f, 0.f}; a2[i][j] = (f32x4){0.f, 0.f, 0.f, 0.f}; }
#pragma unroll
    for (int ks = 0; ks < 4; ++ks) { bf16x8 A[4], B[2];
#pragma unroll
        for (int m = 0; m < 4; ++m) A[m] = frag_row(TS, 64 * wr + 16 * m + fr, ks, fq);
#pragma unroll
        for (int n = 0; n < 2; ++n) B[n] = frag_tr(TV, 32 * wc + 16 * n, ks, lane);
#pragma unroll
        for (int m = 0; m < 4; ++m)
#pragma unroll
            for (int n = 0; n < 2; ++n) a1[m][n] = MFMA16(B[n], A[m], a1[m][n]); }
#pragma unroll
    for (int ks = 0; ks < 4; ++ks) { bf16x8 A[4], B[2];
#pragma unroll
        for (int m = 0; m < 4; ++m) A[m] = frag_row(TQ, 64 * wr + 16 * m + fr, ks, fq);
#pragma unroll
        for (int n = 0; n < 2; ++n) B[n] = frag_row(TC, 32 * wc + 16 * n + fr, ks, fq);
#pragma unroll
        for (int m = 0; m < 4; ++m)
#pragma unroll
            for (int n = 0; n < 2; ++n) a2[m][n] = MFMA16(B[n], A[m], a2[m][n]); }
#pragma unroll
    for (int m = 0; m < 4; ++m) { const int lr = 64 * wr + 16 * m + fr; const float isc = fisc[lr];
        const float den = (pden[lr * 4] + pden[lr * 4 + 1]) + (pden[lr * 4 + 2] + pden[lr * 4 + 3]) + isc * fqn[lr];
        const float inv = 1.f / fmaxf(fabsf(den), __expf(-(fb[lr] + fpm[lr]))); float ss = 0.f;
#pragma unroll
        for (int n = 0; n < 2; ++n) { a1[m][n] = (a1[m][n] + a2[m][n] * isc) * inv; ss += (a1[m][n][0] * a1[m][n][0] + a1[m][n][1] * a1[m][n][1]) + (a1[m][n][2] * a1[m][n][2] + a1[m][n][3] * a1[m][n][3]); }
        ss += __shfl_xor(ss, 16); ss += __shfl_xor(ss, 32); if (fq == 0) pss[lr * 4 + wc] = ss; }
    __syncthreads();
    const float* gn = c.in[IN_ML_NORM_G] + l * MLW + h * DH; bf16* Y = (bf16*)(c.ws + WS_Y);
#pragma unroll
    for (int m = 0; m < 4; ++m) { const int lr = 64 * wr + 16 * m + fr; const float rstd = rsqrtf(((pss[lr * 4] + pss[lr * 4 + 1]) + (pss[lr * 4 + 2] + pss[lr * 4 + 3])) * (1.f / DH) + EPS);
#pragma unroll
        for (int n = 0; n < 2; ++n) { const int e0 = 32 * wc + 16 * n + 4 * fq; const u32x2 ov = *(const u32x2*)(z + (t0 + lr) * NZ + ZO + h * DH + e0); const f32x4 gv = *(const f32x4*)(gn + e0);
            const float y0 = sigmoidf_(bflo(ov.x)) * a1[m][n][0] * rstd * gv[0], y1 = sigmoidf_(bfhi(ov.x)) * a1[m][n][1] * rstd * gv[1];
            const float y2 = sigmoidf_(bflo(ov.y)) * a1[m][n][2] * rstd * gv[2], y3 = sigmoidf_(bfhi(ov.y)) * a1[m][n][3] * rstd * gv[3];
            u32x2 o; o.x = cvt_pk_bf16(y0, y1); o.y = cvt_pk_bf16(y2, y3); *(u32x2*)(Y + (t0 + lr) * D + h * DH + e0) = o; } }
    __syncthreads();
}

__device__ __forceinline__ void mix_e_rg(const Ctx& c, int l, int u, int lane, int wave) {
    const int b = u >> 6, ck = u & 63; const size_t t0 = (size_t)b * SEQ + (size_t)ck * 64;
    const unsigned* RP = (const unsigned*)(c.ws + WS_RA); const bf16* z = (const bf16*)(c.ws + WS_Z); bf16* Y = (bf16*)(c.ws + WS_Y);
    const float* cinp = (const float*)(c.ws + SM_RGC) + (size_t)(b * 64 + ck) * RGW + 8 * lane; const float* gp = c.in[IN_RG_NORM_G] + l * RGW + 8 * lane;
    const f32x4 ci0 = *(const f32x4*)cinp, ci1 = *(const f32x4*)(cinp + 4), g0 = *(const f32x4*)gp, g1 = *(const f32x4*)(gp + 4);
    for (int i = 0; i < 8; ++i) { const size_t t = t0 + wave * 8 + i;
        const u32x4 p0 = *(const u32x4*)(RP + t * RGW + 8 * lane), p1 = *(const u32x4*)(RP + t * RGW + 8 * lane + 4);
        const f32x4 h0 = {bfhi(p0.x), bfhi(p0.y), bfhi(p0.z), bfhi(p0.w)}, h1 = {bfhi(p1.x), bfhi(p1.y), bfhi(p1.z), bfhi(p1.w)}, c0 = {bflo(p0.x), bflo(p0.y), bflo(p0.z), bflo(p0.w)}, c1 = {bflo(p1.x), bflo(p1.y), bflo(p1.z), bflo(p1.w)};
        const u32x4 rg = *(const u32x4*)(z + t * NZ + ZRG + 8 * lane);
        const float gt[8] = {bflo(rg.x), bfhi(rg.x), bflo(rg.y), bfhi(rg.y), bflo(rg.z), bfhi(rg.z), bflo(rg.w), bfhi(rg.w)};
        const f32x4 hh0 = h0 + c0 * ci0, hh1 = h1 + c1 * ci1; float v[8]; float s = 0.f;
#pragma unroll
        for (int j = 0; j < 8; ++j) { const float x = gt[j], uu = 1.5957691216057308f * (x + 0.044715f * x * x * x), ge = x / (1.f + __expf(-uu)); v[j] = (j < 4 ? hh0[j] : hh1[j - 4]) * ge; s += v[j] * v[j]; }
        const float r = rsqrtf(wave_sum(s) * (1.f / RGW) + EPS);
        u32x4 o; o.x = cvt_pk_bf16(v[0] * r * g0[0], v[1] * r * g0[1]); o.y = cvt_pk_bf16(v[2] * r * g0[2], v[3] * r * g0[3]); o.z = cvt_pk_bf16(v[4] * r * g1[0], v[5] * r * g1[1]); o.w = cvt_pk_bf16(v[6] * r * g1[2], v[7] * r * g1[3]);
        *(u32x4*)(Y + t * D + MLW + 8 * lane) = o; }
}
__device__ __forceinline__ void mix_c_phase(const Ctx& c, int l, LAS unsigned char* lds) {
    int tid_o = threadIdx.x; asm volatile("" : "+v"(tid_o)); const int tid = tid_o, lane = tid & 63, wave = __builtin_amdgcn_readfirstlane(tid >> 6);
    for (int w = opaque_bid(); w < 256; w += gridDim.x) mix_c_mlstm(c, 2 * w + (wave >> 2), lds + (wave >> 2) * CGRP_B, tid & 255, lane, wave & 3);
    for (int u = opaque_bid(); u < 256; u += gridDim.x) { mix_c_rg(c, l, u, lds, lane, wave); __syncthreads(); }
}
__device__ __forceinline__ void mix_d_phase(const Ctx& c, LAS unsigned char* lds) {
    int tid_o = threadIdx.x; asm volatile("" : "+v"(tid_o)); const int tid = tid_o, lane = tid & 63, wave = __builtin_amdgcn_readfirstlane(tid >> 6);
    mix_d(c, lds, tid, lane, wave);
}
__device__ __forceinline__ void mix_e_phase(const Ctx& c, int l, LAS unsigned char* lds) {
    int tid_o = threadIdx.x; asm volatile("" : "+v"(tid_o)); const int tid = tid_o, lane = tid & 63, wave = __builtin_amdgcn_readfirstlane(tid >> 6);
    for (int u = opaque_bid(); u < 512; u += gridDim.x) mix_e_mlstm(c, l, u, lds, tid, lane, wave);
    for (int u = opaque_bid(); u < 256; u += gridDim.x) mix_e_rg(c, l, u, lane, wave);
}
#ifndef STAG
#define STAG 0
#endif
#ifndef NULL_EPI
#define NULL_EPI 0
#endif
#ifndef REP_MASK
#define REP_MASK 0
#endif
#ifndef ONE_LAUNCH
#define ONE_LAUNCH 1
#endif
__global__ void __launch_bounds__(NTHR, 2) mega(Ctx c) {
    extern __shared__ __attribute__((aligned(16))) unsigned char lds_raw[];
    LAS unsigned char* lds = (LAS unsigned char*)lds_raw;
    const int tid = threadIdx.x;
    if (tid < 64) ((LAS unsigned*)(lds + MISC_OFF))[tid] = 0u;
    __syncthreads();
    XcdBarrier bar; bar.bar = (unsigned*)(c.ws + WS_CTL) + CW_BAR; bar.x = 0; bar.st = (volatile LAS unsigned*)(lds + MISC_OFF + 32);
    if (c.s_hi - c.s_lo > 1) bar = xcd_barrier_post((unsigned*)(c.ws + WS_CTL) + CW_BAR, (volatile LAS unsigned*)(lds + MISC_OFF + 32));
#define STEP_ON(s) (c.s_lo <= (s) && (s) < c.s_hi)
#define REPN(id) ((((REP_MASK) >> (id)) & 1) ? 2 : 1)
#define RP(id) for (int rr = 0; rr < REPN(id); ++rr)
#define SEAM(s) do { if ((s) + 1 < c.s_hi) { RP(15) xcd_barrier(bar); } } while (0)
    if (STEP_ON(0)) { RP(0) cvt_phase(c, lds); SEAM(0); }
    for (int l = 0; l < DEPTH; ++l) {
        const int s0 = 1 + 10 * l; const bool moe = (l & 1) != 0; const int jl = l >> 1;
        if (s0 + 9 < c.s_lo || s0 >= c.s_hi) continue;
        if (STEP_ON(s0 + 0)) { RP(1) norm_phase<1>(c, l, l == 2 && rr == 0, lds); SEAM(s0 + 0); }
        if (STEP_ON(s0 + 1)) {
            pg8::Gemm g{(const bf16*)(c.ws + WS_XN), (const bf16*)(c.ws + WS_WIN) + (size_t)l * NZ * D, T, NZ, D, D, STAG}; pg8::StaticOrder S; S.init(T, NZ, gridDim.x, opaque_bid());
            pg8::EpiBf16 E{(bf16*)(c.ws + WS_Z), NZ, 0};
            RP(2) { if (NULL_EPI && rr) { pg8::EpiNull EN; pg8::gemm_phase<pg8::EpiNull, pg8::StaticOrder, true, true>(lds, g, S, EN); } else pg8::gemm_phase<pg8::EpiBf16, pg8::StaticOrder, true, true>(lds, g, S, E); } SEAM(s0 + 1); }
        if (STEP_ON(s0 + 2)) { RP(3) mix_c_phase(c, l, lds); SEAM(s0 + 2); }
        if (STEP_ON(s0 + 3)) { RP(4) mix_d_phase(c, lds); SEAM(s0 + 3); }
        if (STEP_ON(s0 + 4)) { RP(5) mix_e_phase(c, l, lds); SEAM(s0 + 4); }
        if (STEP_ON(s0 + 5)) {
            pg8::Gemm g{(const bf16*)(c.ws + WS_Y), (const bf16*)(c.ws + WS_WOUT) + (size_t)l * D * D, T, D, D, D, 0}; pg8::StaticOrder S; S.init(T, D, gridDim.x, opaque_bid());
            RP(6) { pg8::EpiResF32 E{rr ? (const float*)(c.ws + WS_SCR) : (l == 0 ? c.in[IN_X] : (const float*)(c.ws + WS_H)), rr ? (float*)(c.ws + WS_SCR) : (float*)(c.ws + WS_H), D};
            pg8::gemm_phase<pg8::EpiResF32, pg8::StaticOrder, true, true>(lds, g, S, E); } SEAM(s0 + 5); }
        if (!moe) {
            if (STEP_ON(s0 + 6)) { RP(7) norm_phase<0>(c, l, false, lds); SEAM(s0 + 6); }
            if (STEP_ON(s0 + 7)) {
                pg8::Gemm g{(const bf16*)(c.ws + WS_XN), (const bf16*)(c.ws + WS_WGU) + (size_t)jl * 2 * FFD * D, T, 2 * FFD, D, D, STAG}; pg8::StaticOrder S; S.init(T, 2 * FFD, gridDim.x, opaque_bid());
                pg8::EpiSwiglu E{(bf16*)(c.ws + WS_HID), FFD};
                RP(8) pg8::gemm_phase<pg8::EpiSwiglu, pg8::StaticOrder, true, true>(lds, g, S, E); SEAM(s0 + 7); }
            if (STEP_ON(s0 + 8)) {
                pg8::Gemm g{(const bf16*)(c.ws + WS_HID), (const bf16*)(c.ws + WS_WD) + (size_t)jl * D * FFD, T, D, FFD, FFD, 0}; pg8::StaticOrder S; S.init(T, D, gridDim.x, opaque_bid());
                RP(9) { pg8::EpiResF32 E{rr ? (const float*)(c.ws + WS_SCR) : (const float*)(c.ws + WS_H), rr ? (float*)(c.ws + WS_SCR) : (float*)(c.ws + WS_H), D};
                pg8::gemm_phase<pg8::EpiResF32, pg8::StaticOrder, true, true>(lds, g, S, E); } SEAM(s0 + 8); }
        } else {
            if (STEP_ON(s0 + 6)) { RP(7) norm_phase<2>(c, l, false, lds); SEAM(s0 + 6); }
            if (STEP_ON(s0 + 7)) { RP(10) moe_gather_phase(c, lds); SEAM(s0 + 7); }
            if (STEP_ON(s0 + 8)) {
                const int* meta = (const int*)(c.ws + WS_META); const int nM = __builtin_amdgcn_readfirstlane(meta[16]);
                pg8::Gemm g{(const bf16*)(c.ws + WS_XG), (const bf16*)(c.ws + WS_MWGU) + (size_t)jl * NE * 2 * FFE * D, nM * 256, 2 * FFE, D, D, STAG}; pg8::MoeOrder S; S.init(nM, 2 * FFE, 1, gridDim.x, opaque_bid(), meta + 32);
                pg8::EpiSwiglu E{(bf16*)(c.ws + WS_MHID), FFE};
                RP(11) pg8::gemm_phase<pg8::EpiSwiglu, pg8::MoeOrder, true, true>(lds, g, S, E); SEAM(s0 + 8); }
            if (STEP_ON(s0 + 9)) {
                const int* meta = (const int*)(c.ws + WS_META); const int nM = __builtin_amdgcn_readfirstlane(meta[16]);
                pg8::Gemm g{(const bf16*)(c.ws + WS_MHID), (const bf16*)(c.ws + WS_MWD) + (size_t)jl * NE * D * FFE, nM * 256, D, FFE / MOE_KS, FFE, STAG}; pg8::MoeOrder S; S.init(nM, D, MOE_KS, gridDim.x, opaque_bid(), meta + 32);
                pg8::EpiBf16 E{(bf16*)(c.ws + WS_XG), D, (size_t)(WS_Y1 - WS_XG) / 2};
                RP(12) pg8::gemm_phase<pg8::EpiBf16, pg8::MoeOrder, true, true>(lds, g, S, E); SEAM(s0 + 9); }
        }
    }
    if (STEP_ON(41)) { RP(13) norm_phase<3>(c, 0, true, lds); }
}

namespace nv {
__global__ __launch_bounds__(256) void mlstm_rec(const bf16* __restrict__ z, const float* __restrict__ ifp, float* __restrict__ ht) {
    const int wave = (blockIdx.x * 256 + threadIdx.x) >> 6, lane = threadIdx.x & 63;
    const int bh = wave >> 5, es = wave & 31, b = bh >> 2, h = bh & 3, e0 = es * 4;
    float C[2][4] = {}, n[2] = {0.f, 0.f};
    const float ksc = 0.08838834764831845f;
    for (int t0 = 0; t0 < SEQ; t0 += 8) {
        float kk[8][2], qq[8][2], vv[8][4], ii[8], ff[8];
#pragma unroll
        for (int j = 0; j < 8; ++j) { const size_t t = (size_t)(b * SEQ + t0 + j); const bf16* row = z + t * NZ;
            kk[j][0] = bf2f(row[ZK + h * DH + lane]) * ksc; kk[j][1] = bf2f(row[ZK + h * DH + lane + 64]) * ksc; qq[j][0] = bf2f(row[ZQ + h * DH + lane]); qq[j][1] = bf2f(row[ZQ + h * DH + lane + 64]);
#pragma unroll
            for (int e = 0; e < 4; ++e) vv[j][e] = bf2f(row[ZV + h * DH + e0 + e]);
            ii[j] = __expf(ifp[t * 8 + h]); ff[j] = sigmoidf_(ifp[t * 8 + 4 + h]); }
#pragma unroll
        for (int j = 0; j < 8; ++j) { float s[5] = {0.f, 0.f, 0.f, 0.f, 0.f};
#pragma unroll
            for (int d = 0; d < 2; ++d) { n[d] = ff[j] * n[d] + ii[j] * kk[j][d]; s[4] += n[d] * qq[j][d];
#pragma unroll
                for (int e = 0; e < 4; ++e) { C[d][e] = ff[j] * C[d][e] + ii[j] * kk[j][d] * vv[j][e]; s[e] += C[d][e] * qq[j][d]; } }
#pragma unroll
            for (int e = 0; e < 5; ++e) s[e] = wave_sum(s[e]);
            const float den = fmaxf(fabsf(s[4]), 1.f);
            if (lane == 0) { float* o = ht + (size_t)(b * SEQ + t0 + j) * MLW + h * DH + e0; o[0] = s[0] / den; o[1] = s[1] / den; o[2] = s[2] / den; o[3] = s[3] / den; } }
    }
}
__global__ __launch_bounds__(256) void ml_out(const bf16* __restrict__ z, const float* __restrict__ ht, const float* __restrict__ g, bf16* __restrict__ y) {
    const int w = (blockIdx.x * 256 + threadIdx.x) >> 6, lane = threadIdx.x & 63, t = w >> 2, h = w & 3;
    const float a = ht[(size_t)t * MLW + h * DH + lane], b = ht[(size_t)t * MLW + h * DH + lane + 64];
    const float r = rsqrtf(wave_sum(a * a + b * b) * (1.f / DH) + EPS);
    const float oa = bf2f(z[(size_t)t * NZ + ZO + h * DH + lane]), ob = bf2f(z[(size_t)t * NZ + ZO + h * DH + lane + 64]);
    y[(size_t)t * D + h * DH + lane] = f2bf(sigmoidf_(oa) * a * r * g[h * DH + lane]); y[(size_t)t * D + h * DH + lane + 64] = f2bf(sigmoidf_(ob) * b * r * g[h * DH + lane + 64]);
}
__global__ __launch_bounds__(512) void rg_gates(const bf16* __restrict__ z, const float* __restrict__ cw, const float* __restrict__ cb, const float* __restrict__ wa, const float* __restrict__ ba,
                                                const float* __restrict__ wx, const float* __restrict__ bx, const float* __restrict__ lam, float* __restrict__ av, float* __restrict__ uv) {
    __shared__ float xs[RGW]; const int t = blockIdx.x, c = threadIdx.x, tl = t % SEQ;
    float xc = cb[c];
#pragma unroll
    for (int j = 0; j < 4; ++j) { const int tt = tl - 3 + j; if (tt >= 0) xc += cw[j * RGW + c] * bf2f(z[(size_t)(t - 3 + j) * NZ + ZRX + c]); }
    xs[c] = xc; __syncthreads();
    const int g = c >> 6, jj = c & 63; float ra = ba[c], rx = bx[c];
    for (int i = 0; i < RGD; ++i) { const float xv = xs[g * RGD + i]; ra += xv * wa[(g * RGD + i) * RGD + jj]; rx += xv * wx[(g * RGD + i) * RGD + jj]; }
    const float r = sigmoidf_(ra), ig = sigmoidf_(rx);
    const float sp = log1pf(__expf(-lam[c])); const float la = -8.f * r * sp;
    av[(size_t)t * RGW + c] = __expf(la); uv[(size_t)t * RGW + c] = sqrtf(-expm1f(2.f * la)) * (ig * xc);
}
__global__ __launch_bounds__(256) void rg_scan(const float* __restrict__ av, float* __restrict__ uv) {
    const int id = blockIdx.x * 256 + threadIdx.x, b = id / RGW, c = id % RGW; float h = 0.f;
    for (int t0 = 0; t0 < SEQ; t0 += 8) { float a[8], u[8];
#pragma unroll
        for (int j = 0; j < 8; ++j) { a[j] = av[(size_t)(b * SEQ + t0 + j) * RGW + c]; u[j] = uv[(size_t)(b * SEQ + t0 + j) * RGW + c]; }
#pragma unroll
        for (int j = 0; j < 8; ++j) { h = a[j] * h + u[j]; uv[(size_t)(b * SEQ + t0 + j) * RGW + c] = h; } }
}
__global__ __launch_bounds__(256) void rg_out(const bf16* __restrict__ z, const float* __restrict__ hr, const float* __restrict__ g, bf16* __restrict__ y) {
    const int t = (blockIdx.x * 256 + threadIdx.x) >> 6, lane = threadIdx.x & 63; float v[8]; float s = 0.f;
#pragma unroll
    for (int j = 0; j < 8; ++j) { const int c = lane + 64 * j; v[j] = hr[(size_t)t * RGW + c] * gelu_tanh(bf2f(z[(size_t)t * NZ + ZRG + c])); s += v[j] * v[j]; }
    const float r = rsqrtf(wave_sum(s) * (1.f / RGW) + EPS);
#pragma unroll
    for (int j = 0; j < 8; ++j) { const int c = lane + 64 * j; y[(size_t)t * D + MLW + c] = f2bf(v[j] * r * g[c]); }
}
}

extern "C" void kernel_launch(void* const* d_in, const int* in_sizes, int n_in, void* d_out, int out_size, void* d_ws, size_t ws_size, hipStream_t stream) {
    static int ok = 0; static int grid_g = 256;
    if (ok == 0) {
        if (n_in != 23 || ws_size < WS_END || out_size != T * D) { fprintf(stderr, "kernel_launch: unexpected shapes (n_in %d, ws %zu, out %d)\n", n_in, ws_size, out_size); ok = -1; return; }
        if (hipFuncSetAttribute((const void*)mega, hipFuncAttributeMaxDynamicSharedMemorySize, LDS_BYTES) != hipSuccess) { fprintf(stderr, "kernel_launch: hipFuncSetAttribute failed\n"); ok = -1; return; }
        int dev = 0, cus = 0, per_cu = 0; (void)hipGetDevice(&dev); (void)hipDeviceGetAttribute(&cus, hipDeviceAttributeMultiprocessorCount, dev);
        if (hipOccupancyMaxActiveBlocksPerMultiprocessor(&per_cu, (const void*)mega, NTHR, LDS_BYTES) != hipSuccess || per_cu < 1) { fprintf(stderr, "kernel_launch: occupancy query says %d blocks per CU\n", per_cu); (void)hipGetLastError(); }
        grid_g = cus > 0 ? cus : 256;
        ok = 1;
    }
    if (ok < 0) return;
    unsigned char* ws = (unsigned char*)d_ws;
    (void)hipMemsetAsync(ws + WS_CTL, 0, 1 * MiB, stream);
    Ctx base{}; for (int i = 0; i < 23; ++i) base.in[i] = (const float*)d_in[i]; base.out = (float*)d_out; base.ws = ws;
    auto run = [&](int lo, int hi) { Ctx a = base; a.s_lo = lo; a.s_hi = hi; hipLaunchKernelGGL(mega, dim3(grid_g), dim3(NTHR), LDS_BYTES, stream, a); };
    const bf16* z = (const bf16*)(ws + WS_Z); bf16* y = (bf16*)(ws + WS_Y); const float* ifp = (const float*)(ws + WS_IFP);
    float* ht = (float*)(ws + WS_CTL_LOC); float* ra = (float*)(ws + WS_RA); float* ru = (float*)(ws + WS_RU);
#if ONE_LAUNCH
    run(0, 42);
#else
    run(0, 1);
    for (int l = 0; l < DEPTH; ++l) {
        const int s0 = 1 + 10 * l;
        run(s0, s0 + 1); run(s0 + 1, s0 + 2);
#if MIX_FAST
        run(s0 + 2, s0 + 3); run(s0 + 3, s0 + 4); run(s0 + 4, s0 + 5);
#endif
#if !MIX_FAST || NV_ML
        nv::mlstm_rec<<<128, 256, 0, stream>>>(z, ifp, ht);
        nv::ml_out<<<T, 256, 0, stream>>>(z, ht, (const float*)d_in[IN_ML_NORM_G] + l * MLW, y);
#endif
#if !MIX_FAST || NV_RG
        nv::rg_gates<<<T, 512, 0, stream>>>(z, (const float*)d_in[IN_CONV_W] + l * 4 * RGW, (const float*)d_in[IN_CONV_B] + l * RGW, (const float*)d_in[IN_RG_W_A] + (size_t)l * RGB * RGD * RGD,
                                            (const float*)d_in[IN_RG_B_A] + l * RGW, (const float*)d_in[IN_RG_W_X] + (size_t)l * RGB * RGD * RGD, (const float*)d_in[IN_RG_B_X] + l * RGW, (const float*)d_in[IN_RG_LAM] + l * RGW, ra, ru);
        nv::rg_scan<<<BATCH * RGW / 256, 256, 0, stream>>>(ra, ru);
        nv::rg_out<<<T / 4, 256, 0, stream>>>(z, ru, (const float*)d_in[IN_RG_NORM_G] + l * RGW, y);
#endif
        run(s0 + 5, s0 + 6); run(s0 + 6, s0 + 7); run(s0 + 7, s0 + 8); run(s0 + 8, s0 + 9);
        if (l & 1) run(s0 + 9, s0 + 10);
    }
    run(41, 42);
#endif
}
```

```cpp
#include <hip/hip_runtime.h>
#include <cstdio>
#include <cstdint>

constexpr int D = 1024, BATCH = 4, SEQ = 4096, T = BATCH * SEQ, DEPTH = 4;
constexpr int MLW = 512, MLH = 4, DH = 128, RGW = 512, RGB = 8, RGD = 64;
constexpr int DIN = 3080, FFD = 2816, NE = 8, FFE = 3584;
constexpr int NZ = 3072;
constexpr int ZQ = 0, ZK = 512, ZV = 1024, ZO = 1536, ZRX = 2048, ZRG = 2560;
constexpr float EPS = 1e-6f;
constexpr int MAXROWS = 2 * T + NE * 256;
constexpr int MAXT256 = MAXROWS / 256;
constexpr int NWAVES = 8, NTHR = 512;

#define LAS __attribute__((address_space(3)))
#define GAS __attribute__((address_space(1)))
typedef unsigned short bf16;
typedef float f32x4 __attribute__((ext_vector_type(4)));
typedef float f32x2 __attribute__((ext_vector_type(2)));
typedef unsigned u32x4 __attribute__((ext_vector_type(4)));
typedef unsigned u32x2 __attribute__((ext_vector_type(2)));
typedef short bf16x8 __attribute__((ext_vector_type(8)));
typedef _Float16 h16x8 __attribute__((ext_vector_type(8)));
typedef float f32x8 __attribute__((ext_vector_type(8)));

__device__ __forceinline__ float wave_sum(float v) {
#pragma unroll
    for (int o = 1; o < 64; o <<= 1) v += __shfl_xor(v, o);
    return v;
}
__device__ __forceinline__ float sigmoidf_(float x) { return 1.f / (1.f + __expf(-x)); }
__device__ __forceinline__ float gelu_tanh(float x) { const float u = 0.7978845608028654f * (x + 0.044715f * x * x * x); return 0.5f * x * (1.f + tanhf(u)); }
__device__ __forceinline__ unsigned cvt_pk_bf16(float lo, float hi) { unsigned r; asm volatile("v_cvt_pk_bf16_f32 %0, %1, %2" : "=v"(r) : "v"(lo), "v"(hi)); return r; }
__device__ __forceinline__ float bf2f(unsigned short b) { return __uint_as_float(((unsigned)b) << 16); }
__device__ __forceinline__ float bflo(unsigned w) { return __uint_as_float(w << 16); }
__device__ __forceinline__ float bfhi(unsigned w) { return __uint_as_float(w & 0xffff0000u); }
__device__ __forceinline__ bf16 f2bf(float f) { return (bf16)(cvt_pk_bf16(f, 0.f) & 0xffffu); }

namespace pg8 {
#define PG8_LAS __attribute__((address_space(3)))
typedef unsigned short bf16_t;
constexpr int BM = 256, BK = 64, HALF = 128, HTB = HALF * BK * 2  , STAGE_BYTES = 8 * HTB, NXCD = 8, WGM = 8;
__host__ __device__ __forceinline__ int lds_byte(int r, int c) { const int st = (r >> 4) * 2 + (c >> 5), rr = r & 15, cc = c & 31, ob = rr * 64 + cc * 2; return st * 1024 + (ob ^ (((ob >> 9) & 1) << 5)); }
__host__ __device__ __forceinline__ void stage_rc(int b, int& R, int& C) { const int st = b / 1024, sb = b % 1024, swz = sb ^ (((sb >> 9) & 1) << 5); R = (st >> 1) * 16 + swz / 64; C = (st & 1) * 32 + (swz % 64) / 2; }
__host__ __device__ __forceinline__ int perm32(int rho) { const int n = rho >> 4, i = rho & 15; return 8 * (i >> 2) + 4 * n + (i & 3); }

struct Unit { int pm, pn, pb, kz; };
struct Gemm { const bf16_t* A; const bf16_t* Bt; int M, N, K, ld, stag; };

struct StaticOrder {
    int nM, nN, nwg, G, c;
    __host__ __device__ void init(int M, int N, int G_, int c_) { nM = M / BM; nN = N / BM; nwg = nM * nN; G = G_; c = c_; }
    __host__ __device__ bool next(int i, Unit& u) const {
        const long L = (long)i * G + c; if (L >= nwg) return false;
        int wgid = (int)L; { const int q = nwg / NXCD, r = nwg % NXCD, xcd = wgid % NXCD, off = wgid / NXCD; wgid = (xcd < r ? xcd * (q + 1) : r * (q + 1) + (xcd - r) * q) + off; }
        const int nig = WGM * nN, gid = wgid / nig, fm = gid * WGM, gsz = (nM - fm) < WGM ? (nM - fm) : WGM;
        u.pm = fm + ((wgid % nig) % gsz); u.pn = (wgid % nig) / gsz; u.pb = u.pn; u.kz = 0; return true;
    }
    __device__ __forceinline__ void a_ready(const Unit&) const {}
    __device__ __forceinline__ void done(const Unit&) const {}
};
struct MoeOrder {
    int nM, nN, nNo, KS, nwg, G, c; const int* texp;
    __device__ void init(int nM_, int N, int KS_, int G_, int c_, const int* texp_) { nM = nM_; nNo = N / BM; KS = KS_; nN = nNo * KS; nwg = nM * nN; G = G_; c = c_; texp = texp_; }
    __device__ bool next(int i, Unit& u) const {
        const long L = (long)i * G + c; if (L >= nwg) return false;
        int wgid = (int)L; { const int q = nwg / NXCD, r = nwg % NXCD, xcd = wgid % NXCD, off = wgid / NXCD; wgid = (xcd < r ? xcd * (q + 1) : r * (q + 1) + (xcd - r) * q) + off; }
        const int nig = WGM * nN, gid = wgid / nig, fm = gid * WGM, gsz = (nM - fm) < WGM ? (nM - fm) : WGM;
        u.pm = fm + ((wgid % nig) % gsz); const int q = (wgid % nig) / gsz; u.pn = q / KS; u.kz = q % KS; u.pb = __builtin_amdgcn_readfirstlane(texp[u.pm]) * nNo + u.pn; return true;
    }
    __device__ __forceinline__ void a_ready(const Unit&) const {}
    __device__ __forceinline__ void done(const Unit&) const {}
};

struct EpiBf16 {
    static constexpr bool PERM = true, AFTER_DRAIN = false;
    bf16_t* O; int ldc; size_t zstride;
    __device__ __forceinline__ void operator()(const f32x4 (&acc)[2][2][4][2], const Unit& u, int wr, int wc, int fr, int fq) const {
        const int row0 = u.pm * BM + wr * 64 + fr, col0 = u.pn * BM + wc * 32 + 8 * fq;
#pragma unroll
        for (int ai = 0; ai < 2; ++ai)
#pragma unroll
            for (int m = 0; m < 4; ++m) { bf16_t* rowp = O + (size_t)u.kz * zstride + (size_t)(row0 + ai * HALF + m * 16) * ldc + col0;
#pragma unroll
                for (int bj = 0; bj < 2; ++bj) { const f32x4 v0 = acc[ai][bj][m][0], v1 = acc[ai][bj][m][1];
                    u32x4 w; w.x = cvt_pk_bf16(v0[0], v0[1]); w.y = cvt_pk_bf16(v0[2], v0[3]); w.z = cvt_pk_bf16(v1[0], v1[1]); w.w = cvt_pk_bf16(v1[2], v1[3]);
                    *(u32x4*)(rowp + bj * HALF) = w; } }
    }
};
struct EpiNull {
    static constexpr bool PERM = true, AFTER_DRAIN = false;
    __device__ __forceinline__ void operator()(const f32x4 (&acc)[2][2][4][2], const Unit& u, int wr, int wc, int fr, int fq) const {
#pragma unroll
        for (int ai = 0; ai < 2; ++ai)
#pragma unroll
            for (int bj = 0; bj < 2; ++bj)
#pragma unroll
                for (int m = 0; m < 4; ++m)
#pragma unroll
                    for (int n = 0; n < 2; ++n) asm volatile("" :: "v"(acc[ai][bj][m][n]));
    }
};
struct EpiResF16 {
    static constexpr bool PERM = true, AFTER_DRAIN = false;
    const float* X; _Float16* H; int ldc;
    __device__ __forceinline__ void operator()(const f32x4 (&acc)[2][2][4][2], const Unit& u, int wr, int wc, int fr, int fq) const {
        const int row0 = u.pm * BM + wr * 64 + fr, col0 = u.pn * BM + wc * 32 + 8 * fq;
#pragma unroll
        for (int ai = 0; ai < 2; ++ai)
#pragma unroll
            for (int m = 0; m < 4; ++m) { const size_t ro = (size_t)(row0 + ai * HALF + m * 16) * ldc + col0; f32x8 b[2];
                if (X) { b[0] = *(const f32x8*)(X + ro); b[1] = *(const f32x8*)(X + ro + HALF); }
                else { b[0] = __builtin_convertvector(*(const h16x8*)(H + ro), f32x8); b[1] = __builtin_convertvector(*(const h16x8*)(H + ro + HALF), f32x8); }
#pragma unroll
                for (int bj = 0; bj < 2; ++bj) {
#pragma unroll
                    for (int j = 0; j < 4; ++j) { b[bj][j] += acc[ai][bj][m][0][j]; b[bj][4 + j] += acc[ai][bj][m][1][j]; }
                    *(h16x8*)(H + ro + bj * HALF) = __builtin_convertvector(b[bj], h16x8); } }
    }
};
struct EpiSwiglu {
    static constexpr bool PERM = true, AFTER_DRAIN = false;
    bf16_t* O; int ldc;
    __device__ __forceinline__ void operator()(const f32x4 (&acc)[2][2][4][2], const Unit& u, int wr, int wc, int fr, int fq) const {
        const int row0 = u.pm * BM + wr * 64 + fr, col0 = u.pn * HALF + wc * 32 + 8 * fq;
#pragma unroll
        for (int ai = 0; ai < 2; ++ai)
#pragma unroll
            for (int m = 0; m < 4; ++m) { bf16_t* rowp = O + (size_t)(row0 + ai * HALF + m * 16) * ldc + col0; float r[8];
#pragma unroll
                for (int n = 0; n < 2; ++n)
#pragma unroll
                    for (int j = 0; j < 4; ++j) { const float g = acc[ai][0][m][n][j], up = acc[ai][1][m][n][j]; r[4 * n + j] = g * __builtin_amdgcn_rcpf(1.f + __expf(-g)) * up; }
                u32x4 w; w.x = cvt_pk_bf16(r[0], r[1]); w.y = cvt_pk_bf16(r[2], r[3]); w.z = cvt_pk_bf16(r[4], r[5]); w.w = cvt_pk_bf16(r[6], r[7]);
                *(u32x4*)rowp = w; }
    }
};

template <class Epi, class Sched, bool ALIGN_EPI = false, bool SP2 = false>
__device__ __forceinline__ void gemm_phase(PG8_LAS unsigned char* lds, const Gemm g, const Sched& S, const Epi& E) {
    int tid_o = threadIdx.x; asm volatile("" : "+v"(tid_o));
    const int tid = tid_o, wid = __builtin_amdgcn_readfirstlane(tid >> 6), lane = tid & 63, wr = wid >> 2, wc = wid & 3, fr = lane & 15, fq = lane >> 4;
    if (g.stag > 0) { const int sg = (int)((blockIdx.x >> 3) & 3u); for (int i = 0; i < sg * g.stag; ++i) __builtin_amdgcn_s_sleep(63); }
    const int K = g.ld, nt = g.K / BK;
    unsigned voffA[2], voffB[2];
#pragma unroll
    for (int i = 0; i < 2; ++i) { int R, C; stage_rc(tid * 16 + i * 8192, R, C); const int Rb = Epi::PERM ? ((R & ~31) + perm32(R & 31)) : R;
        voffA[i] = (unsigned)(R * K + C) * 2u; voffB[i] = (unsigned)(Rb * K + C) * 2u; }
    const size_t kstep = (size_t)(BK * 2);
    const size_t hstep = (size_t)HALF * K * 2;
    const size_t tstep = 2 * hstep;
    const unsigned ldsw = (unsigned)wid * 1024u;
    const int aoff = lds_byte(wr * 64 + fr, fq * 8), boff = lds_byte(wc * 32 + fr, fq * 8);
#define PG8_SA(b, h) (((b) * 2 + (h)) * HTB)
#define PG8_SB(b, h) ((4 + (b) * 2 + (h)) * HTB)
#define PG8_STAGE(bufoff, gbase, voff) do { _Pragma("unroll") for (int _i = 0; _i < 2; ++_i) \
        __builtin_amdgcn_global_load_lds((const unsigned*)((const char*)(gbase) + (voff)[_i]), (PG8_LAS unsigned*)(lds + (bufoff) + ldsw + _i * 8192), 16, 0, 0); } while (0)
#define PG8_LDA(dst, b, h) do { _Pragma("unroll") for (int m = 0; m < 4; ++m) _Pragma("unroll") for (int k = 0; k < 2; ++k) dst[m][k] = *(const PG8_LAS bf16x8*)(lds + PG8_SA(b, h) + aoff + m * 2048 + k * 1024); } while (0)
#define PG8_LDB(dst, b, h) do { _Pragma("unroll") for (int n = 0; n < 2; ++n) _Pragma("unroll") for (int k = 0; k < 2; ++k) dst[n][k] = *(const PG8_LAS bf16x8*)(lds + PG8_SB(b, h) + boff + n * 2048 + k * 1024); } while (0)
#define PG8_MMA(ai, bj, At, Bt) do { __builtin_amdgcn_s_setprio(1); _Pragma("unroll") for (int m = 0; m < 4; ++m) _Pragma("unroll") for (int n = 0; n < 2; ++n) _Pragma("unroll") for (int k = 0; k < 2; ++k) \
        acc[ai][bj][m][n] = __builtin_amdgcn_mfma_f32_16x16x32_bf16(Bt[n][k], At[m][k], acc[ai][bj][m][n], 0, 0, 0); __builtin_amdgcn_s_setprio(0); } while (0)
#define PG8_WAIT_V(n) asm volatile("s_waitcnt vmcnt(" #n ")" ::: "memory")
#define PG8_WAIT_L(n) asm volatile("s_waitcnt lgkmcnt(" #n ")" ::: "memory")
#define PG8_BAR __builtin_amdgcn_s_barrier()
#define PG8_SCHED __builtin_amdgcn_sched_barrier(0)
    Unit cur, nxt; int ui = 0;
    if (!S.next(0, cur)) return;
    f32x4 acc[2][2][4][2];
#pragma unroll
    for (int a = 0; a < 2; ++a)
#pragma unroll
        for (int b = 0; b < 2; ++b)
#pragma unroll
            for (int m = 0; m < 4; ++m)
#pragma unroll
                for (int n = 0; n < 2; ++n) acc[a][b][m][n] = (f32x4){0.f, 0.f, 0.f, 0.f};
    bf16x8 At[4][2], B0[2][2], B1[2][2];
    const size_t kzb = (size_t)g.K * 2;
    const char* cA = (const char*)g.A + (size_t)cur.pm * tstep + cur.kz * kzb; const char* cB = (const char*)g.Bt + (size_t)cur.pb * tstep + cur.kz * kzb;
    S.a_ready(cur);
    if constexpr (SP2) {
        PG8_STAGE(PG8_SB(0, 0), cB, voffB); PG8_STAGE(PG8_SB(0, 1), cB + hstep, voffB); PG8_STAGE(PG8_SA(0, 0), cA, voffA); PG8_STAGE(PG8_SA(0, 1), cA + hstep, voffA);
        if (wr == 1) PG8_BAR;
        PG8_WAIT_V(2); PG8_BAR;
        PG8_STAGE(PG8_SB(1, 0), cB + kstep, voffB); PG8_STAGE(PG8_SA(1, 0), cA + kstep, voffA); PG8_STAGE(PG8_SB(1, 1), cB + hstep + kstep, voffB);
        PG8_WAIT_V(6); PG8_BAR;
    } else {
        PG8_STAGE(PG8_SB(0, 0), cB, voffB); PG8_STAGE(PG8_SA(0, 0), cA, voffA); PG8_STAGE(PG8_SB(0, 1), cB + hstep, voffB); PG8_STAGE(PG8_SA(0, 1), cA + hstep, voffA);
        if (wr == 1) PG8_BAR;
        PG8_WAIT_V(4); PG8_BAR;
        PG8_STAGE(PG8_SB(1, 0), cB + kstep, voffB); PG8_STAGE(PG8_SA(1, 0), cA + kstep, voffA); PG8_STAGE(PG8_SB(1, 1), cB + hstep + kstep, voffB);
        PG8_WAIT_V(6); PG8_BAR;
    }
    for (;;) {
        const bool has_next = S.next(ui + 1, nxt);
        const char* nA = has_next ? (const char*)g.A + (size_t)nxt.pm * tstep + nxt.kz * kzb : cA; const char* nB = has_next ? (const char*)g.Bt + (size_t)nxt.pb * tstep + nxt.kz * kzb : cB;
        for (int t = 0; t < nt; t += 2) {
            const bool last = (t == nt - 2);
            const char* a1 = cA + (size_t)(t + 1) * kstep;
            const char* a2 = last ? nA : cA + (size_t)(t + 2) * kstep; const char* b2 = last ? nB : cB + (size_t)(t + 2) * kstep;
            const char* a3 = a2 + kstep; const char* b3 = b2 + kstep;
            if (last && has_next) S.a_ready(nxt);
            if constexpr (SP2) {
            PG8_LDB(B0, 0, 0); PG8_LDB(B1, 0, 1); PG8_SCHED; PG8_LDA(At, 0, 0); PG8_STAGE(PG8_SA(1, 1), a1 + hstep, voffA);
            PG8_WAIT_V(8); PG8_WAIT_L(0); PG8_BAR; PG8_MMA(0, 0, At, B0); PG8_MMA(0, 1, At, B1); PG8_BAR; PG8_SCHED;
            PG8_LDA(At, 0, 1); PG8_STAGE(PG8_SB(0, 0), b2, voffB); PG8_STAGE(PG8_SB(0, 1), b2 + hstep, voffB); PG8_STAGE(PG8_SA(0, 0), a2, voffA);
            PG8_WAIT_V(8); PG8_WAIT_L(0); PG8_BAR; PG8_MMA(1, 0, At, B0); PG8_MMA(1, 1, At, B1); PG8_BAR; PG8_SCHED;
            PG8_LDB(B0, 1, 0); PG8_LDB(B1, 1, 1); PG8_SCHED; PG8_LDA(At, 1, 0); PG8_STAGE(PG8_SA(0, 1), a2 + hstep, voffA);
            PG8_WAIT_V(8); PG8_WAIT_L(0); PG8_BAR; PG8_MMA(0, 0, At, B0); PG8_MMA(0, 1, At, B1); PG8_BAR; PG8_SCHED;
            PG8_LDA(At, 1, 1); PG8_STAGE(PG8_SB(1, 0), b3, voffB); PG8_STAGE(PG8_SB(1, 1), b3 + hstep, voffB); PG8_STAGE(PG8_SA(1, 0), a3, voffA);
            PG8_WAIT_V(8); PG8_WAIT_L(0); PG8_BAR; PG8_MMA(1, 0, At, B0); PG8_MMA(1, 1, At, B1); PG8_BAR; PG8_SCHED;
            } else {
            PG8_LDB(B0, 0, 0); PG8_SCHED; PG8_LDA(At, 0, 0); PG8_STAGE(PG8_SA(1, 1), a1 + hstep, voffA);
            PG8_WAIT_L(8); PG8_BAR; PG8_WAIT_L(0); PG8_MMA(0, 0, At, B0); PG8_BAR; PG8_SCHED;
            PG8_LDB(B1, 0, 1); PG8_STAGE(PG8_SB(0, 0), b2, voffB);
            PG8_BAR; PG8_WAIT_L(0); PG8_MMA(0, 1, At, B1); PG8_BAR;
            PG8_LDA(At, 0, 1); PG8_STAGE(PG8_SA(0, 0), a2, voffA);
            PG8_BAR; PG8_WAIT_L(0); PG8_MMA(1, 0, At, B0); PG8_BAR; PG8_SCHED;
            PG8_STAGE(PG8_SB(0, 1), b2 + hstep, voffB);
            PG8_WAIT_V(6); PG8_BAR; PG8_MMA(1, 1, At, B1); PG8_BAR;
            PG8_LDB(B0, 1, 0); PG8_SCHED; PG8_LDA(At, 1, 0); PG8_STAGE(PG8_SA(0, 1), a2 + hstep, voffA);
            PG8_WAIT_L(8); PG8_BAR; PG8_WAIT_L(0); PG8_MMA(0, 0, At, B0); PG8_BAR; PG8_SCHED;
            PG8_LDB(B1, 1, 1); PG8_STAGE(PG8_SB(1, 0), b3, voffB);
            PG8_BAR; PG8_WAIT_L(0); PG8_MMA(0, 1, At, B1); PG8_BAR;
            PG8_LDA(At, 1, 1); PG8_STAGE(PG8_SA(1, 0), a3, voffA);
            PG8_BAR; PG8_WAIT_L(0); PG8_MMA(1, 0, At, B0); PG8_BAR; PG8_SCHED;
            PG8_STAGE(PG8_SB(1, 1), b3 + hstep, voffB);
            PG8_WAIT_V(6); PG8_BAR; PG8_MMA(1, 1, At, B1); PG8_BAR;
            }
        }
        if constexpr (ALIGN_EPI) { if (wr == 0) PG8_BAR; }
        if constexpr (!Epi::AFTER_DRAIN) { E(acc, cur, wr, wc, fr, fq); S.done(cur); }
        if (!has_next) break;
#pragma unroll
        for (int a = 0; a < 2; ++a)
#pragma unroll
            for (int b = 0; b < 2; ++b)
#pragma unroll
                for (int m = 0; m < 4; ++m)
#pragma unroll
                    for (int n = 0; n < 2; ++n) acc[a][b][m][n] = (f32x4){0.f, 0.f, 0.f, 0.f};
        cur = nxt; cA = nA; cB = nB; ++ui;
        if constexpr (ALIGN_EPI) { if (wr == 1) PG8_BAR; }
    }
    PG8_WAIT_V(0);
    if constexpr (!ALIGN_EPI) { if (wr == 0) PG8_BAR; }
    PG8_BAR;
    if constexpr (Epi::AFTER_DRAIN) { E.fused(acc, cur, wr, wc, fr, fq, lds, wid, lane); S.done(cur); }
#undef PG8_SA
#undef PG8_SB
#undef PG8_STAGE
#undef PG8_LDA
#undef PG8_LDB
#undef PG8_MMA
#undef PG8_WAIT_V
#undef PG8_WAIT_L
#undef PG8_BAR
#undef PG8_SCHED
}
}

constexpr size_t MiB = 1u << 20;
constexpr size_t WS_CTL = 0;
constexpr int CW_BAR = 4096;
constexpr size_t WS_IFP = 1 * MiB;
constexpr size_t WS_EIDX = WS_IFP + 512 * 1024;
constexpr size_t WS_EW = WS_EIDX + 128 * 1024;
constexpr size_t WS_POS = WS_EW + 128 * 1024;
constexpr size_t WS_BLKCNT = WS_POS + 128 * 1024;
constexpr size_t WS_META = WS_BLKCNT + 16 * 1024;
constexpr size_t WS_SMALL = 2 * MiB;
constexpr size_t WS_WRG = 4 * MiB;
constexpr size_t WS_WIN = 8 * MiB;
constexpr size_t WS_WOUT = 32 * MiB;
constexpr size_t WS_WGU = 40 * MiB;
constexpr size_t WS_WD = 62 * MiB;
constexpr size_t WS_MWGU = 74 * MiB;
constexpr size_t WS_MWD = 298 * MiB;
constexpr size_t WS_H = 410 * MiB;
constexpr size_t WS_XN = 474 * MiB;
constexpr size_t WS_R = 506 * MiB;
constexpr size_t WS_Z = WS_R;
constexpr size_t WS_Y = WS_R + 96 * MiB;
constexpr size_t WS_CTL_LOC = WS_R + 128 * MiB;
constexpr size_t WS_CTP = WS_R + 160 * MiB;
constexpr size_t WS_RA = WS_R + 176 * MiB;
constexpr size_t WS_RU = WS_R + 208 * MiB;
constexpr size_t WS_HID = WS_R;
constexpr size_t WS_XG = WS_R;
constexpr size_t WS_MHID = WS_R + 68 * MiB;
constexpr size_t WS_Y1 = 812 * MiB;
constexpr size_t WS_SCR = WS_R + 128 * MiB;
constexpr size_t WS_END = 880 * MiB;
constexpr int MOE_KS = 2;

constexpr int LDS_BYTES = 163840;
constexpr int MISC_OFF = LDS_BYTES - 256;

struct Ctx { const float* in[23]; float* out; unsigned char* ws; int s_lo, s_hi; };

#define XB_TMO      128
#define XB_XCNT(j)  (256  + 64 * (j))
#define XB_XSUB(j)  (1280 + 64 * (j))
#define XB_XGEN(j)  (2304 + 64 * (j))
#define XB_TOP      3328
#define XB_TOPGEN   3392
#define XCD_BAR_WORDS 3456
#define XB_SPIN_CAP (1u << 18)

__device__ __forceinline__ unsigned xb_ld(unsigned* p)              { return __hip_atomic_load(p, __ATOMIC_RELAXED, __HIP_MEMORY_SCOPE_AGENT); }
__device__ __forceinline__ unsigned xb_add(unsigned* p, unsigned v) { return __hip_atomic_fetch_add(p, v, __ATOMIC_RELAXED, __HIP_MEMORY_SCOPE_AGENT); }
__device__ __forceinline__ unsigned xb_xcc_id() { return (unsigned)__builtin_amdgcn_s_getreg((3 << 11) | 20) & 0xFu; }
#define XB_SPIN(cond, bar) do { unsigned _sp = 0; while (cond) { __builtin_amdgcn_s_sleep(1); \
    if ((++_sp & 255u) == 0u) { if (xb_ld(&(bar)[XB_TMO])) break; if (_sp > XB_SPIN_CAP) { atomicAdd(&(bar)[XB_TMO], 1u); break; } } } } while (0)

struct XcdBarrier {
    unsigned* bar; unsigned x;
    volatile LAS unsigned* st;
};

__device__ __forceinline__ XcdBarrier xcd_barrier_post(unsigned* bar, volatile LAS unsigned* st) {
    XcdBarrier b; b.bar = bar; b.x = xb_xcc_id(); b.st = st;
    if (threadIdx.x == 0) (void)xb_add(&bar[XB_XCNT(b.x)], 1u);
    return b;
}
__device__ __forceinline__ void xcd_barrier_complete(unsigned* bar, unsigned x, unsigned& nloc, unsigned& nx) {
    const unsigned G = gridDim.x * gridDim.y * gridDim.z;
    unsigned sum, cnt, mine, sp = 0u;
    for (;;) {
        sum = 0u; cnt = 0u; mine = 0u;
#pragma unroll
        for (unsigned j = 0; j < 16; ++j) { const unsigned c = xb_ld(&bar[XB_XCNT(j)]); sum += c; cnt += (c > 0u) ? 1u : 0u; mine = (j == x) ? c : mine; }
        if (sum == G) break;
        __builtin_amdgcn_s_sleep(1);
        if ((++sp & 255u) == 0u) { if (xb_ld(&bar[XB_TMO])) break; if (sp > XB_SPIN_CAP) { atomicAdd(&bar[XB_TMO], 1u); break; } }
    }
    nloc = mine > 0u ? mine : 1u; nx = cnt > 0u ? cnt : 1u;
}

__device__ __forceinline__ void xcd_barrier(const XcdBarrier& b) {
    asm volatile("s_waitcnt vmcnt(0)" ::: "memory");
    __syncthreads();
    if (threadIdx.x == 0) {
        unsigned* bar = b.bar;
        __builtin_amdgcn_s_waitcnt(0);
        unsigned nloc = b.st[0], nx = b.st[1];
        if (nloc == 0u) { xcd_barrier_complete(bar, b.x, nloc, nx); b.st[0] = nloc; b.st[1] = nx; }
        const unsigned old = xb_add(&bar[XB_XSUB(b.x)], 1u);
        const unsigned gen = old / nloc;
        if (old + 1u == (gen + 1u) * nloc) {
            __builtin_amdgcn_fence(__ATOMIC_RELEASE, "agent");
            asm volatile("s_waitcnt vmcnt(0)" ::: "memory");
            const unsigned og = xb_add(&bar[XB_TOP], 1u);
            const unsigned tg = og / nx;
            if (og + 1u == (tg + 1u) * nx) xb_add(&bar[XB_TOPGEN], 1u);
            else XB_SPIN(xb_ld(&bar[XB_TOPGEN]) == tg, bar);
            __builtin_amdgcn_fence(__ATOMIC_ACQUIRE, "agent");
            xb_add(&bar[XB_XGEN(b.x)], 1u);
            asm volatile("s_waitcnt vmcnt(0)" ::: "memory");
        } else {
            XB_SPIN(xb_ld(&bar[XB_XGEN(b.x)]) == gen, bar);
            __builtin_amdgcn_fence(__ATOMIC_ACQUIRE, "agent");
            asm volatile("s_waitcnt vmcnt(0)" ::: "memory");
        }
    }
    __syncthreads();
}

#ifndef MIX_FAST
#define MIX_FAST 1
#endif
#ifndef NV_ML
#define NV_ML 0
#endif
#ifndef NV_RG
#define NV_RG 0
#endif
__device__ __forceinline__ int opaque_bid() { int b = blockIdx.x; asm volatile("" : "+s"(b)); return b; }
#define IN_X 0
#define IN_NORM_MIX_G 1
#define IN_W_IN 2
#define IN_ML_B_IF 3
#define IN_ML_NORM_G 4
#define IN_CONV_W 5
#define IN_CONV_B 6
#define IN_RG_W_A 7
#define IN_RG_B_A 8
#define IN_RG_W_X 9
#define IN_RG_B_X 10
#define IN_RG_LAM 11
#define IN_RG_NORM_G 12
#define IN_W_OUT 13
#define IN_NORM_FFN_G 14
#define IN_FFN_WG 15
#define IN_FFN_WU 16
#define IN_FFN_WD 17
#define IN_MOE_WR 18
#define IN_MOE_WG 19
#define IN_MOE_WU 20
#define IN_MOE_WD 21
#define IN_NORM_FINAL_G 22

__device__ __forceinline__ void cvt_tile(const float* __restrict__ src, int ld, bf16* __restrict__ dst, int K, LAS float* scr, int lane) {
#pragma unroll 4
    for (int i = 0; i < 16; ++i) { const int kk = 4 * i + (lane >> 4); const f32x4 v = __builtin_nontemporal_load((const f32x4*)(src + (size_t)kk * ld + (lane & 15) * 4));
        LAS float* s = scr + kk * 65 + (lane & 15) * 4; s[0] = v[0]; s[1] = v[1]; s[2] = v[2]; s[3] = v[3]; }
    asm volatile("s_waitcnt lgkmcnt(0)" ::: "memory");
    const int c = lane & 7;
#pragma unroll
    for (int j = 0; j < 8; ++j) { const int n = (lane >> 3) + 8 * j; const LAS float* s = scr + (8 * c) * 65 + n;
        u32x4 o; o.x = cvt_pk_bf16(s[0], s[65]); o.y = cvt_pk_bf16(s[130], s[195]); o.z = cvt_pk_bf16(s[260], s[325]); o.w = cvt_pk_bf16(s[390], s[455]);
        *(u32x4*)(dst + (size_t)n * K + 8 * c) = o; }
    asm volatile("s_waitcnt lgkmcnt(0)" ::: "memory");
}
constexpr int CV_IN = 4 * 768, CV_OUT = 4 * 256, CV_GU = 2 * 1408, CV_D = 2 * 704, CV_MGU = 16 * 1792, CV_MD = 16 * 896, CV_RG = 64;
constexpr int CV_TOTAL = CV_IN + CV_OUT + CV_GU + CV_D + CV_MGU + CV_MD + CV_RG;
__device__ __forceinline__ void cvt_phase(const Ctx& c, LAS unsigned char* lds) {
    int tid_o = threadIdx.x; asm volatile("" : "+v"(tid_o));
    const int tid = tid_o, lane = tid & 63, wave = __builtin_amdgcn_readfirstlane(tid >> 6);
    LAS float* scr = (LAS float*)(lds + wave * 16640);
    const int gw = opaque_bid() * NWAVES + wave, NGW = gridDim.x * NWAVES;
    for (int it0 = gw; it0 < CV_TOTAL; it0 += NGW) {
        int it = it0; const float* src; int ld, K; bf16* dst;
        if (it < CV_IN) { const int l = it / 768, r = it % 768, nt = r % 48, kt = r / 48, n0 = 64 * nt, k0 = 64 * kt, sc = n0 < 2048 ? n0 : n0 + 8;
            src = c.in[IN_W_IN] + (size_t)l * D * DIN + (size_t)k0 * DIN + sc; ld = DIN; K = D; dst = (bf16*)(c.ws + WS_WIN) + (size_t)l * NZ * D + (size_t)n0 * D + k0; }
        else if ((it -= CV_IN) < CV_OUT) { const int l = it / 256, r = it % 256, nt = r % 16, kt = r / 16, n0 = 64 * nt, k0 = 64 * kt;
            src = c.in[IN_W_OUT] + (size_t)l * D * D + (size_t)k0 * D + n0; ld = D; K = D; dst = (bf16*)(c.ws + WS_WOUT) + (size_t)l * D * D + (size_t)n0 * D + k0; }
        else if ((it -= CV_OUT) < CV_GU) { const int j = it / 1408, r = it % 1408, nt = r % 88, kt = r / 88, n0 = 64 * nt, k0 = 64 * kt, jj = n0 >> 8, cc = n0 & 255;
            src = (cc < 128 ? c.in[IN_FFN_WG] : c.in[IN_FFN_WU]) + (size_t)j * D * FFD + (size_t)k0 * FFD + jj * 128 + (cc & 127); ld = FFD; K = D;
            dst = (bf16*)(c.ws + WS_WGU) + (size_t)j * 2 * FFD * D + (size_t)n0 * D + k0; }
        else if ((it -= CV_GU) < CV_D) { const int j = it / 704, r = it % 704, nt = r % 16, kt = r / 16, n0 = 64 * nt, k0 = 64 * kt;
            src = c.in[IN_FFN_WD] + (size_t)j * FFD * D + (size_t)k0 * D + n0; ld = D; K = FFD; dst = (bf16*)(c.ws + WS_WD) + (size_t)j * D * FFD + (size_t)n0 * FFD + k0; }
        else if ((it -= CV_D) < CV_MGU) { const int je = it / 1792, r = it % 1792, nt = r % 112, kt = r / 112, n0 = 64 * nt, k0 = 64 * kt, jj = n0 >> 8, cc = n0 & 255;
            src = (cc < 128 ? c.in[IN_MOE_WG] : c.in[IN_MOE_WU]) + (size_t)je * D * FFE + (size_t)k0 * FFE + jj * 128 + (cc & 127); ld = FFE; K = D;
            dst = (bf16*)(c.ws + WS_MWGU) + (size_t)je * 2 * FFE * D + (size_t)n0 * D + k0; }
        else if ((it -= CV_MGU) < CV_MD) { const int je = it / 896, r = it % 896, nt = r % 16, kt = r / 16, n0 = 64 * nt, k0 = 64 * kt;
            src = c.in[IN_MOE_WD] + (size_t)je * FFE * D + (size_t)k0 * D + n0; ld = D; K = FFE; dst = (bf16*)(c.ws + WS_MWD) + (size_t)je * D * FFE + (size_t)n0 * FFE + k0; }
        else { it -= CV_MD; const int l = it >> 4, which = (it >> 3) & 1, g = it & 7;
            src = c.in[which ? IN_RG_W_X : IN_RG_W_A] + (size_t)(l * RGB + g) * RGD * RGD; ld = RGD; K = RGD; dst = (bf16*)(c.ws + WS_WRG) + (size_t)((l * 2 + which) * RGB + g) * RGD * RGD; }
        cvt_tile(src, ld, dst, K, scr, lane);
    }
}

constexpr int W8S = 1028;
template <int MODE>
__device__ __forceinline__ void norm_phase(const Ctx& c, int l, bool combine, LAS unsigned char* lds) {
    int tid_o = threadIdx.x; asm volatile("" : "+v"(tid_o));
    const int tid = tid_o, lane = tid & 63, wave = __builtin_amdgcn_readfirstlane(tid >> 6);
    LAS float* w8 = (LAS float*)lds; LAS int* cnt = (LAS int*)(lds + 8 * W8S * 4);
    _Float16* h = (_Float16*)(c.ws + WS_H); bf16* xn = (bf16*)(c.ws + WS_XN); const bool from_x = (MODE == 1 && l == 0);
    const float* gain = MODE == 1 ? c.in[IN_NORM_MIX_G] + l * D : (MODE == 3 ? c.in[IN_NORM_FINAL_G] : c.in[IN_NORM_FFN_G] + l * D);
    if (MODE == 1 || MODE == 2) {
        const float* wsrc = MODE == 1 ? c.in[IN_W_IN] + (size_t)l * D * DIN + 2048 : c.in[IN_MOE_WR] + (size_t)(l >> 1) * D * NE; const int ldw = MODE == 1 ? DIN : NE;
        for (int i = tid; i < 8 * D; i += NTHR) { const int k = i >> 3, j = i & 7; w8[j * W8S + k] = wsrc[(size_t)k * ldw + j]; }
    }
    f32x8 gg[2];
#pragma unroll
    for (int j = 0; j < 2; ++j) gg[j] = *(const f32x8*)(gain + 8 * (lane + 64 * j));
    const int* pos = (const int*)(c.ws + WS_POS); const float* ew = (const float*)(c.ws + WS_EW); const bf16* Y = (const bf16*)(c.ws + WS_XG); const bf16* Y1 = (const bf16*)(c.ws + WS_Y1);
    for (int tb = opaque_bid(); tb < T / 64; tb += gridDim.x) {
        if (MODE == 2) { if (tid < 8) cnt[tid] = 0; }
        __syncthreads();
        for (int i = 0; i < 8; ++i) {
            const int t = tb * 64 + wave * 8 + i; f32x8 v[2];
            if (from_x) {
#pragma unroll
                for (int j = 0; j < 2; ++j) v[j] = *(const f32x8*)(c.in[IN_X] + (size_t)t * D + 8 * (lane + 64 * j));
            } else {
#pragma unroll
                for (int j = 0; j < 2; ++j) v[j] = __builtin_convertvector(*(const h16x8*)(h + (size_t)t * D + 8 * (lane + 64 * j)), f32x8);
            }
            if (combine) {
                const int p0 = pos[2 * t], p1 = pos[2 * t + 1]; const float w0 = ew[2 * t], w1 = ew[2 * t + 1];
#pragma unroll
                for (int j = 0; j < 2; ++j) { const size_t o0 = (size_t)p0 * D + 8 * (lane + 64 * j), o1 = (size_t)p1 * D + 8 * (lane + 64 * j);
                    const u32x4 a = *(const u32x4*)(Y + o0), b = *(const u32x4*)(Y + o1), a2 = *(const u32x4*)(Y1 + o0), b2 = *(const u32x4*)(Y1 + o1);
#pragma unroll
                    for (int q = 0; q < 4; ++q) { v[j][2 * q] += w0 * (bflo(a[q]) + bflo(a2[q])) + w1 * (bflo(b[q]) + bflo(b2[q])); v[j][2 * q + 1] += w0 * (bfhi(a[q]) + bfhi(a2[q])) + w1 * (bfhi(b[q]) + bfhi(b2[q])); } }
                if (MODE != 3) {
#pragma unroll
                    for (int j = 0; j < 2; ++j) *(h16x8*)(h + (size_t)t * D + 8 * (lane + 64 * j)) = __builtin_convertvector(v[j], h16x8); }
            }
            float s = 0.f;
#pragma unroll
            for (int j = 0; j < 2; ++j)
#pragma unroll
                for (int q = 0; q < 8; ++q) s += v[j][q] * v[j][q];
            const float r = rsqrtf(wave_sum(s) * (1.f / D) + EPS);
#pragma unroll
            for (int j = 0; j < 2; ++j) v[j] = v[j] * r * gg[j];
            if (MODE == 3) {
#pragma unroll
                for (int j = 0; j < 2; ++j) *(f32x8*)(c.out + (size_t)t * D + 8 * (lane + 64 * j)) = v[j];
            } else {
#pragma unroll
                for (int j = 0; j < 2; ++j) { u32x4 o; o.x = cvt_pk_bf16(v[j][0], v[j][1]); o.y = cvt_pk_bf16(v[j][2], v[j][3]); o.z = cvt_pk_bf16(v[j][4], v[j][5]); o.w = cvt_pk_bf16(v[j][6], v[j][7]);
                    *(u32x4*)(xn + (size_t)t * D + 8 * (lane + 64 * j)) = o; }
            }
            if (MODE == 1 || MODE == 2) {
                float d8[8];
#pragma unroll
                for (int g = 0; g < 8; ++g) { float a = 0.f;
#pragma unroll
                    for (int j = 0; j < 2; ++j) { const f32x4 wa = *(const LAS f32x4*)(w8 + g * W8S + 8 * (lane + 64 * j)), wb = *(const LAS f32x4*)(w8 + g * W8S + 8 * (lane + 64 * j) + 4);
                        a += (v[j][0] * wa[0] + v[j][1] * wa[1]) + (v[j][2] * wa[2] + v[j][3] * wa[3]) + (v[j][4] * wb[0] + v[j][5] * wb[1]) + (v[j][6] * wb[2] + v[j][7] * wb[3]); }
                    d8[g] = wave_sum(a); }
                if (MODE == 1) {
                    float sel = d8[0];
#pragma unroll
                    for (int g = 1; g < 8; ++g) sel = (lane == g) ? d8[g] : sel;
                    if (lane < 8) ((float*)(c.ws + WS_IFP))[(size_t)t * 8 + lane] = sel + c.in[IN_ML_B_IF][l * 8 + lane];
                } else {
                    int i0 = 0; float v0 = d8[0];
#pragma unroll
                    for (int e = 1; e < NE; ++e) if (d8[e] > v0) { v0 = d8[e]; i0 = e; }
                    int i1 = -1; float v1 = -3.4e38f;
#pragma unroll
                    for (int e = 0; e < NE; ++e) if (e != i0 && d8[e] > v1) { v1 = d8[e]; i1 = e; }
                    if (lane == 0) { int* eidx = (int*)(c.ws + WS_EIDX); float* eww = (float*)(c.ws + WS_EW); eidx[2 * t] = i0; eidx[2 * t + 1] = i1;
                        const float w0 = 1.f / (1.f + __expf(v1 - v0)); eww[2 * t] = w0; eww[2 * t + 1] = 1.f - w0;
                        __hip_atomic_fetch_add(&cnt[i0], 1, __ATOMIC_RELAXED, __HIP_MEMORY_SCOPE_WORKGROUP); __hip_atomic_fetch_add(&cnt[i1], 1, __ATOMIC_RELAXED, __HIP_MEMORY_SCOPE_WORKGROUP); }
                }
            }
        }
        if (MODE == 2) { __syncthreads(); if (tid < 8) ((int*)(c.ws + WS_BLKCNT))[tb * 8 + tid] = cnt[tid]; }
    }
}

__device__ __forceinline__ void moe_gather_phase(const Ctx& c, LAS unsigned char* lds) {
    int tid_o = threadIdx.x; asm volatile("" : "+v"(tid_o));
    const int tid = tid_o, lane = tid & 63, wave = __builtin_amdgcn_readfirstlane(tid >> 6);
    LAS int* tot = (LAS int*)lds; LAS int* bef = tot + 8; LAS int* off = tot + 16; LAS int* lpos = tot + 32;
    const int* blkcnt = (const int*)(c.ws + WS_BLKCNT); const int* eidx = (const int*)(c.ws + WS_EIDX); int* pos = (int*)(c.ws + WS_POS); int* meta = (int*)(c.ws + WS_META);
    const bf16* xn = (const bf16*)(c.ws + WS_XN); bf16* Xg = (bf16*)(c.ws + WS_XG);
    for (int tb = opaque_bid(); tb < T / 64; tb += gridDim.x) {
        __syncthreads();
        if (tid < 16) tot[tid] = 0;
        __syncthreads();
        { const int e = tid & 7, part = tid >> 3; int st = 0, sb = 0;
#pragma unroll
          for (int q = 0; q < 4; ++q) { const int b = part * 4 + q; const int v = blkcnt[b * 8 + e]; st += v; sb += (b < tb) ? v : 0; }
          __hip_atomic_fetch_add(&tot[e], st, __ATOMIC_RELAXED, __HIP_MEMORY_SCOPE_WORKGROUP); __hip_atomic_fetch_add(&bef[e], sb, __ATOMIC_RELAXED, __HIP_MEMORY_SCOPE_WORKGROUP); }
        __syncthreads();
        if (tid == 0) { int o = 0; for (int e = 0; e < NE; ++e) { off[e] = o; o += (tot[e] + 255) & ~255; } off[NE] = o; }
        __syncthreads();
        if (wave == 0) {
            const int t = tb * 64 + lane; const int e0 = eidx[2 * t], e1 = eidx[2 * t + 1]; int r0 = 0, r1 = 0; const unsigned long long lt = (1ull << lane) - 1ull;
#pragma unroll
            for (int e = 0; e < NE; ++e) { const unsigned long long m0 = __ballot(e0 == e), m1 = __ballot(e1 == e);
                if (e0 == e) r0 = __popcll(m0 & lt); if (e1 == e) r1 = __popcll(m0) + __popcll(m1 & lt); }
            const int p0 = off[e0] + bef[e0] + r0, p1 = off[e1] + bef[e1] + r1;
            pos[2 * t] = p0; pos[2 * t + 1] = p1; lpos[2 * lane] = p0; lpos[2 * lane + 1] = p1;
        }
        __syncthreads();
        for (int q = wave; q < 128; q += NWAVES) { const int t = tb * 64 + (q >> 1); const int p = lpos[q];
            const u32x4* s = (const u32x4*)(xn + (size_t)t * D); u32x4* d = (u32x4*)(Xg + (size_t)p * D); const u32x4 a = s[lane], b = s[lane + 64]; d[lane] = a; d[lane + 64] = b; }
        if (tb < NE) { const int r0 = off[tb] + tot[tb], r1 = off[tb + 1]; const u32x4 zz = {0u, 0u, 0u, 0u};
            for (int r = r0 + wave; r < r1; r += NWAVES) { u32x4* d = (u32x4*)(Xg + (size_t)r * D); d[lane] = zz; d[lane + 64] = zz; } }
        if (tb == 0) { if (tid < 9) meta[tid] = off[tid]; if (tid == 0) meta[16] = off[NE] >> 8;
            for (int tl = tid; tl < MAXT256; tl += NTHR) { const int r = tl * 256; int e = 0;
#pragma unroll
                for (int q = 0; q < NE; ++q) if (r >= off[q]) e = q;
                meta[32 + tl] = e; } }
    }
}


typedef short s16x4 __attribute__((ext_vector_type(4)));
constexpr size_t SM_CG = WS_SMALL, SM_CM = WS_SMALL + 4096, SM_MP = WS_SMALL + 8192;
constexpr size_t SM_NL = WS_SMALL + 65536, SM_NP = WS_SMALL + 327680;
constexpr size_t SM_RGA = WS_SMALL + 589824, SM_RGH = WS_SMALL + 1114112;
constexpr size_t SM_RGC = 5 * MiB;
constexpr int TROW = 272;
constexpr int TILE_B = 128 * TROW;
constexpr float KSC = 0.08838834764831845f;

__device__ __forceinline__ float wscan_add(float v, int lane) {
#pragma unroll
    for (int o = 1; o < 64; o <<= 1) { const float t = __shfl_up(v, o); v = (lane >= o) ? v + t : v; }
    return v;
}
__device__ __forceinline__ float wscan_max(float v, int lane) {
#pragma unroll
    for (int o = 1; o < 64; o <<= 1) { const float t = __shfl_up(v, o); v = (lane >= o) ? fmaxf(v, t) : v; }
    return v;
}
__device__ __forceinline__ float wave_max(float v) {
#pragma unroll
    for (int o = 1; o < 64; o <<= 1) v = fmaxf(v, __shfl_xor(v, o));
    return v;
}
__device__ __forceinline__ float logsigmoidf_(float x) { return -log1pf(__expf(-x)); }
__device__ __forceinline__ void stage_tile(const bf16* __restrict__ g, int ldg, LAS unsigned char* tile, int tid) {
#pragma unroll
    for (int i = 0; i < 4; ++i) { const int ch = tid + NTHR * i, r = ch >> 4, c16 = ch & 15; const u32x4 v = *(const u32x4*)(g + (size_t)r * ldg + c16 * 8); *(LAS u32x4*)(tile + r * TROW + c16 * 16) = v; }
}
__device__ __forceinline__ bf16x8 frag_row(const LAS unsigned char* tile, int row, int ks, int fq) { return *(const LAS bf16x8*)(tile + row * TROW + (32 * ks + 8 * fq) * 2); }
__device__ __forceinline__ bf16x8 frag_tr(const LAS unsigned char* tile, int n0, int ks, int lane) {
    const int i16 = lane & 15, q = i16 >> 2, p = i16 & 3, fq = lane >> 4;
    const LAS unsigned char* a = tile + (32 * ks + 8 * fq + q) * TROW + n0 * 2 + 8 * p;
    const s16x4 lo = __builtin_amdgcn_ds_read_tr16_b64_v4i16((LAS s16x4*)a), hi = __builtin_amdgcn_ds_read_tr16_b64_v4i16((LAS s16x4*)(a + 4 * TROW));
    return __builtin_shufflevector(lo, hi, 0, 1, 2, 3, 4, 5, 6, 7);
}
#define MFMA16(a, b, c) __builtin_amdgcn_mfma_f32_16x16x32_bf16((a), (b), (c), 0, 0, 0)

constexpr int CGRP_B = 73728;
__device__ __forceinline__ void mix_c_mlstm(const Ctx& c, int u, LAS unsigned char* lds, int tid, int lane, int wave) {
    const int bh = u >> 5, ck = u & 31, b = bh >> 2, h = bh & 3; const size_t t0 = (size_t)b * SEQ + (size_t)ck * 128;
    LAS unsigned char* TKW = lds; LAS unsigned char* TV = lds + TILE_B; LAS float* fw = (LAS float*)(lds + 2 * TILE_B); LAS float* np = fw + 128;
    const float* ifp = (const float*)(c.ws + WS_IFP); const bf16* z = (const bf16*)(c.ws + WS_Z);
    u32x4 kv[8], vv[8];
#pragma unroll
    for (int i = 0; i < 8; ++i) { const int ch = tid + 256 * i, r = ch >> 4, c16 = ch & 15; const bf16* row = z + (t0 + r) * NZ + h * DH + c16 * 8; kv[i] = *(const u32x4*)(row + ZK); vv[i] = *(const u32x4*)(row + ZV); }
    if (wave == 0) {
        const float x0 = ifp[(t0 + 2 * lane) * 8 + 4 + h], x1 = ifp[(t0 + 2 * lane + 1) * 8 + 4 + h];
        const float li0 = ifp[(t0 + 2 * lane) * 8 + h], li1 = ifp[(t0 + 2 * lane + 1) * 8 + h];
        const float lf0 = logsigmoidf_(x0), lf1 = logsigmoidf_(x1), s = lf0 + lf1, inc = wscan_add(s, lane), ex = inc - s, b0 = ex + lf0, b1 = b0 + lf1;
        const float g = __shfl(inc, 63);
        const float a0 = g - b0 + li0, a1 = g - b1 + li1, m = wave_max(fmaxf(a0, a1));
        fw[2 * lane] = __expf(a0 - m) * KSC; fw[2 * lane + 1] = __expf(a1 - m) * KSC;
        if (lane == 0) { ((float*)(c.ws + SM_CG))[bh * 32 + ck] = g; ((float*)(c.ws + SM_CM))[bh * 32 + ck] = m; }
    }
    __syncthreads();
#pragma unroll
    for (int i = 0; i < 8; ++i) { const int ch = tid + 256 * i, r = ch >> 4, c16 = ch & 15; const float sc = fw[r]; u32x4 ko;
        ko.x = cvt_pk_bf16(bflo(kv[i].x) * sc, bfhi(kv[i].x) * sc); ko.y = cvt_pk_bf16(bflo(kv[i].y) * sc, bfhi(kv[i].y) * sc); ko.z = cvt_pk_bf16(bflo(kv[i].z) * sc, bfhi(kv[i].z) * sc); ko.w = cvt_pk_bf16(bflo(kv[i].w) * sc, bfhi(kv[i].w) * sc);
        *(LAS u32x4*)(TKW + r * TROW + c16 * 16) = ko; *(LAS u32x4*)(TV + r * TROW + c16 * 16) = vv[i]; }
    __syncthreads();
    { const int d = tid & 127, q = tid >> 7; float s = 0.f;
#pragma unroll 16
      for (int l = 64 * q; l < 64 * q + 64; ++l) s += bf2f(*(const LAS bf16*)(TKW + l * TROW + d * 2));
      np[q * 128 + d] = s; }
    const int wr = wave >> 1, wc = wave & 1, fr = lane & 15, fq = lane >> 4;
    f32x4 acc[4][4];
#pragma unroll
    for (int i = 0; i < 4; ++i)
#pragma unroll
        for (int j = 0; j < 4; ++j) acc[i][j] = (f32x4){0.f, 0.f, 0.f, 0.f};
#pragma unroll
    for (int ks = 0; ks < 4; ++ks) { bf16x8 A[4], B[4];
#pragma unroll
        for (int dt = 0; dt < 4; ++dt) A[dt] = frag_tr(TKW, 64 * wr + 16 * dt, ks, lane);
#pragma unroll
        for (int et = 0; et < 4; ++et) B[et] = frag_tr(TV, 64 * wc + 16 * et, ks, lane);
#pragma unroll
        for (int dt = 0; dt < 4; ++dt)
#pragma unroll
            for (int et = 0; et < 4; ++et) acc[dt][et] = MFMA16(A[dt], B[et], acc[dt][et]); }
    float* CTL = (float*)(c.ws + WS_CTL_LOC) + ((size_t)(bh * 32 + ck) << 14);
#pragma unroll
    for (int dt = 0; dt < 4; ++dt)
#pragma unroll
        for (int et = 0; et < 4; ++et) *(f32x4*)(CTL + (size_t)(64 * wc + 16 * et + fr) * 128 + 64 * wr + 16 * dt + 4 * fq) = acc[dt][et];
    __syncthreads();
    if (tid < 128) ((float*)(c.ws + SM_NL))[(size_t)(bh * 32 + ck) * 128 + tid] = np[tid] + np[128 + tid];
    __syncthreads();
}

__device__ __forceinline__ float fsig(float x) { return __builtin_amdgcn_rcpf(1.f + __expf(-x)); }
__device__ __forceinline__ void mix_c_rg(const Ctx& c, int l, int u, LAS unsigned char* lds, int lane, int wave) {
    const int b = u >> 6, ck = u & 63, g = wave; const size_t t0 = (size_t)b * SEQ + (size_t)ck * 64;
    LAS unsigned char* XC = lds + wave * 9216;
    const bf16* z = (const bf16*)(c.ws + WS_Z); const int l15 = lane & 15, fq = lane >> 4;
    {
        const int c4 = 64 * g + 4 * l15; const float* cw = c.in[IN_CONV_W] + l * 4 * RGW + c4; const f32x4 w0 = *(const f32x4*)cw, w1 = *(const f32x4*)(cw + RGW), w2 = *(const f32x4*)(cw + 2 * RGW), w3 = *(const f32x4*)(cw + 3 * RGW), cb = *(const f32x4*)(c.in[IN_CONV_B] + l * RGW + c4);
        u32x2 xr[19];
#pragma unroll
        for (int j = 0; j < 19; ++j) { const int tt = 16 * fq - 3 + j; const bool okk = (ck * 64 + tt >= 0); const u32x2 v = *(const u32x2*)(z + (size_t)((long)t0 + (okk ? tt : 0)) * NZ + ZRX + c4); xr[j].x = okk ? v.x : 0u; xr[j].y = okk ? v.y : 0u; }
#pragma unroll
        for (int j = 0; j < 16; ++j) { f32x4 xc;
            xc[0] = cb[0] + w0[0] * bflo(xr[j].x) + w1[0] * bflo(xr[j + 1].x) + w2[0] * bflo(xr[j + 2].x) + w3[0] * bflo(xr[j + 3].x);
            xc[1] = cb[1] + w0[1] * bfhi(xr[j].x) + w1[1] * bfhi(xr[j + 1].x) + w2[1] * bfhi(xr[j + 2].x) + w3[1] * bfhi(xr[j + 3].x);
            xc[2] = cb[2] + w0[2] * bflo(xr[j].y) + w1[2] * bflo(xr[j + 1].y) + w2[2] * bflo(xr[j + 2].y) + w3[2] * bflo(xr[j + 3].y);
            xc[3] = cb[3] + w0[3] * bfhi(xr[j].y) + w1[3] * bfhi(xr[j + 1].y) + w2[3] * bfhi(xr[j + 2].y) + w3[3] * bfhi(xr[j + 3].y);
            u32x2 o; o.x = cvt_pk_bf16(xc[0], xc[1]); o.y = cvt_pk_bf16(xc[2], xc[3]); *(LAS u32x2*)(XC + (16 * fq + j) * 144 + l15 * 8) = o; }
    }
    bf16x8 Af[4][2];
#pragma unroll
    for (int m = 0; m < 4; ++m)
#pragma unroll
        for (int ks = 0; ks < 2; ++ks) Af[m][ks] = *(const LAS bf16x8*)(XC + (16 * m + l15) * 144 + (32 * ks + 8 * fq) * 2);
    const bf16* WTa = (const bf16*)(c.ws + WS_WRG) + (size_t)((l * 2 + 0) * RGB + g) * RGD * RGD; const bf16* WTx = (const bf16*)(c.ws + WS_WRG) + (size_t)((l * 2 + 1) * RGB + g) * RGD * RGD;
    unsigned* RP = (unsigned*)(c.ws + WS_RA);
#pragma unroll
    for (int n = 0; n < 4; ++n) {
        const int jo = 16 * n + l15, cc = 64 * g + jo;
        f32x4 aa[4], ax[4];
#pragma unroll
        for (int m = 0; m < 4; ++m) { aa[m] = (f32x4){0.f, 0.f, 0.f, 0.f}; ax[m] = (f32x4){0.f, 0.f, 0.f, 0.f}; }
#pragma unroll
        for (int ks = 0; ks < 2; ++ks) { const bf16x8 Ba = *(const bf16x8*)(WTa + jo * RGD + 32 * ks + 8 * fq), Bx = *(const bf16x8*)(WTx + jo * RGD + 32 * ks + 8 * fq);
#pragma unroll
            for (int m = 0; m < 4; ++m) { aa[m] = MFMA16(Af[m][ks], Ba, aa[m]); ax[m] = MFMA16(Af[m][ks], Bx, ax[m]); } }
        const float ba = c.in[IN_RG_B_A][l * RGW + cc], bx = c.in[IN_RG_B_X][l * RGW + cc], sp8 = -8.f * __logf(1.f + __expf(-c.in[IN_RG_LAM][l * RGW + cc]));
        float cA[4][4], hL[4][4], SA[4], SH[4];
#pragma unroll
        for (int m = 0; m < 4; ++m) { float Ar = 1.f, Hr = 0.f;
#pragma unroll
            for (int r = 0; r < 4; ++r) { const int t = 16 * m + 4 * fq + r;
                const float la = sp8 * fsig(aa[m][r] + ba), a = __expf(la), ig = fsig(ax[m][r] + bx), xcv = bf2f(*(const LAS bf16*)(XC + t * 144 + jo * 2));
                const float tt = -2.f * la, ser = tt * (1.f - tt * (0.5f - tt * (0.16666667f - tt * (0.041666668f - tt * 0.0083333333f)))), om = tt < 0.25f ? ser : 1.f - a * a;
                const float uu = __builtin_amdgcn_sqrtf(om) * (ig * xcv);
                Hr = a * Hr + uu; Ar *= a; cA[m][r] = Ar; hL[m][r] = Hr; }
            SA[m] = Ar; SH[m] = Hr; }
        float CA = 1.f, CH = 0.f; unsigned* rp = RP + (t0 + 4 * fq) * RGW + cc;
#pragma unroll
        for (int m = 0; m < 4; ++m) {
            float IA = SA[m], IH = SH[m];
            { const float Ap = __shfl_up(IA, 16), Hp = __shfl_up(IH, 16); if (fq >= 1) { IH = IA * Hp + IH; IA = IA * Ap; } }
            { const float Ap = __shfl_up(IA, 32), Hp = __shfl_up(IH, 32); if (fq >= 2) { IH = IA * Hp + IH; IA = IA * Ap; } }
            float EA = __shfl_up(IA, 16), EH = __shfl_up(IH, 16); if (fq == 0) { EA = 1.f; EH = 0.f; }
            const float TA = __shfl(IA, l15 + 48), TH = __shfl(IH, l15 + 48);
            const float PA = CA * EA, PH = EA * CH + EH;
#pragma unroll
            for (int r = 0; r < 4; ++r) rp[(size_t)(16 * m + r) * RGW] = cvt_pk_bf16(PA * cA[m][r], hL[m][r] + cA[m][r] * PH);
            CH = TA * CH + TH; CA = CA * TA;
        }
        if (fq == 0) { ((float*)(c.ws + SM_RGA))[(size_t)(b * 64 + ck) * RGW + cc] = CA; ((float*)(c.ws + SM_RGH))[(size_t)(b * 64 + ck) * RGW + cc] = CH; }
    }
}

__device__ __forceinline__ void mix_d(const Ctx& c, LAS unsigned char* lds, int tid, int lane, int wave) {
    for (int w = opaque_bid(); w < 256; w += gridDim.x) {
        const int bh = w >> 4, sl = w & 15; LAS float* sg = (LAS float*)lds; LAS float* sm = sg + 32;
        __syncthreads();
        if (tid < 32) { sg[tid] = ((const float*)(c.ws + SM_CG))[bh * 32 + tid]; sm[tid] = ((const float*)(c.ws + SM_CM))[bh * 32 + tid]; }
        __syncthreads();
        const int idx = tid * 2, el = idx >> 7, d = idx & 127; const size_t off = (size_t)(8 * sl + el) * 128 + d;
        const float* CTL = (const float*)(c.ws + WS_CTL_LOC) + ((size_t)(bh * 32) << 14) + off; bf16* CTP = (bf16*)(c.ws + WS_CTP) + ((size_t)(bh * 32) << 14) + off;
        const bool nown = (sl == 0 && tid < 128);
        const float* NL = (const float*)(c.ws + SM_NL) + (size_t)(bh * 32) * 128 + (tid & 127); float* NP = (float*)(c.ws + SM_NP) + (size_t)(bh * 32) * 128 + (tid & 127);
        f32x2 ld[32]; float nl[32];
#pragma unroll
        for (int ck = 0; ck < 32; ++ck) { ld[ck] = *(const f32x2*)(CTL + ((size_t)ck << 14)); nl[ck] = nown ? NL[ck * 128] : 0.f; }
        f32x2 st = {0.f, 0.f}; float nst = 0.f, m = 0.f;
#pragma unroll
        for (int ck = 0; ck < 32; ++ck) {
            *(unsigned*)(CTP + ((size_t)ck << 14)) = cvt_pk_bf16(st.x, st.y);
            if (nown) NP[ck * 128] = nst;
            if (sl == 0 && tid == 0) ((float*)(c.ws + SM_MP))[bh * 32 + ck] = m;
            const float g = sg[ck], ml = sm[ck], mn = fmaxf(g + m, ml), so = __expf(g + m - mn), sc = __expf(ml - mn);
            st = st * so + ld[ck] * sc; nst = nst * so + nl[ck] * sc; m = mn;
        }
    }
    for (int gw = opaque_bid() * NWAVES + wave; gw < BATCH * RGW; gw += gridDim.x * NWAVES) {
        const int b = gw >> 9, ch = gw & 511; const size_t o = (size_t)(b * 64 + lane) * RGW + ch;
        float A = ((const float*)(c.ws + SM_RGA))[o], H = ((const float*)(c.ws + SM_RGH))[o];
#pragma unroll
        for (int s = 1; s < 64; s <<= 1) { const float Ap = __shfl_up(A, s), Hp = __shfl_up(H, s); if (lane >= s) { H = A * Hp + H; A = A * Ap; } }
        float cin = __shfl_up(H, 1); if (lane == 0) cin = 0.f;
        ((float*)(c.ws + SM_RGC))[o] = cin;
    }
}

__device__ __forceinline__ void mix_e_mlstm(const Ctx& c, int l, int u, LAS unsigned char* lds, int tid, int lane, int wave) {
    const int bh = u >> 5, ck = u & 31, b = bh >> 2, h = bh & 3; const size_t t0 = (size_t)b * SEQ + (size_t)ck * 128;
    LAS unsigned char* TQ = lds; LAS unsigned char* TK = lds + TILE_B; LAS unsigned char* TV = lds + 2 * TILE_B; LAS unsigned char* TC = lds + 3 * TILE_B; LAS unsigned char* TS = TK;
    LAS float* fb = (LAS float*)(lds + 4 * TILE_B); LAS float* fcs = fb + 128; LAS float* fpm = fb + 256; LAS float* fisc = fb + 384; LAS float* fqn = fb + 512; LAS float* fnp = fb + 640;
    LAS float* pden = fb + 768; LAS float* pss = fb + 1280;
    const float* ifp = (const float*)(c.ws + WS_IFP); const bf16* z = (const bf16*)(c.ws + WS_Z);
    u32x4 sq[4], sk[4], sv[4], scp[4];
    { const bf16* cp = (const bf16*)(c.ws + WS_CTP) + ((size_t)(bh * 32 + ck) << 14);
#pragma unroll
      for (int i = 0; i < 4; ++i) { const int ch = tid + NTHR * i, r = ch >> 4, c16 = ch & 15; const bf16* row = z + (t0 + r) * NZ + h * DH + c16 * 8;
          sq[i] = *(const u32x4*)(row + ZQ); sk[i] = *(const u32x4*)(row + ZK); sv[i] = *(const u32x4*)(row + ZV); scp[i] = *(const u32x4*)(cp + (size_t)r * 128 + c16 * 8); } }
    const float npv = (tid < 128) ? ((const float*)(c.ws + SM_NP))[(size_t)(bh * 32 + ck) * 128 + tid] : 0.f;
    if (wave == 0) {
        const float x0 = ifp[(t0 + 2 * lane) * 8 + 4 + h], x1 = ifp[(t0 + 2 * lane + 1) * 8 + 4 + h];
        const float lf0 = logsigmoidf_(x0), lf1 = logsigmoidf_(x1), s = lf0 + lf1, inc = wscan_add(s, lane), ex = inc - s, b0 = ex + lf0, b1 = b0 + lf1;
        const float li0 = ifp[(t0 + 2 * lane) * 8 + h], li1 = ifp[(t0 + 2 * lane + 1) * 8 + h];
        const float cs0 = li0 - b0, cs1 = li1 - b1, p1 = fmaxf(cs0, cs1), incm = wscan_max(p1, lane);
        float exm = __shfl_up(incm, 1); if (lane == 0) exm = -3.0e38f;
        const float mp = ((const float*)(c.ws + SM_MP))[bh * 32 + ck];
        const float pm0 = fmaxf(fmaxf(exm, cs0), mp), pm1 = fmaxf(fmaxf(exm, p1), mp);
        fb[2 * lane] = b0; fb[2 * lane + 1] = b1; fcs[2 * lane] = cs0; fcs[2 * lane + 1] = cs1; fpm[2 * lane] = pm0; fpm[2 * lane + 1] = pm1;
        fisc[2 * lane] = __expf(mp - pm0); fisc[2 * lane + 1] = __expf(mp - pm1);
    }
#pragma unroll
    for (int i = 0; i < 4; ++i) { const int ch = tid + NTHR * i, r = ch >> 4, c16 = ch & 15; const int o = r * TROW + c16 * 16;
        *(LAS u32x4*)(TQ + o) = sq[i]; *(LAS u32x4*)(TK + o) = sk[i]; *(LAS u32x4*)(TV + o) = sv[i]; *(LAS u32x4*)(TC + o) = scp[i]; }
    if (tid < 128) fnp[tid] = npv;
    __syncthreads();
    { const int row = tid >> 2, qt = tid & 3; float s = 0.f;
#pragma unroll
      for (int i = 0; i < 4; ++i) { const u32x4 qv = *(const LAS u32x4*)(TQ + row * TROW + (32 * qt + 8 * i) * 2); const LAS float* nn = fnp + 32 * qt + 8 * i;
          s += bflo(qv.x) * nn[0] + bfhi(qv.x) * nn[1] + bflo(qv.y) * nn[2] + bfhi(qv.y) * nn[3] + bflo(qv.z) * nn[4] + bfhi(qv.z) * nn[5] + bflo(qv.w) * nn[6] + bfhi(qv.w) * nn[7]; }
      s += __shfl_xor(s, 1); s += __shfl_xor(s, 2); if (qt == 0) fqn[row] = s; }
    const int wr = wave >> 2, wc = wave & 3, fr = lane & 15, fq = lane >> 4;
    f32x4 aS[4][2];
#pragma unroll
    for (int i = 0; i < 4; ++i)
#pragma unroll
        for (int j = 0; j < 2; ++j) aS[i][j] = (f32x4){0.f, 0.f, 0.f, 0.f};
#pragma unroll
    for (int ks = 0; ks < 4; ++ks) { bf16x8 A[4], B[2];
#pragma unroll
        for (int m = 0; m < 4; ++m) A[m] = frag_row(TQ, 64 * wr + 16 * m + fr, ks, fq);
#pragma unroll
        for (int n = 0; n < 2; ++n) B[n] = frag_row(TK, 32 * wc + 16 * n + fr, ks, fq);
#pragma unroll
        for (int m = 0; m < 4; ++m)
#pragma unroll
            for (int n = 0; n < 2; ++n) aS[m][n] = MFMA16(B[n], A[m], aS[m][n]); }
    __syncthreads();
#pragma unroll
    for (int m = 0; m < 4; ++m) { const int lr = 64 * wr + 16 * m + fr; const float pm = fpm[lr]; float ds = 0.f;
#pragma unroll
        for (int n = 0; n < 2; ++n) { const int s0 = 32 * wc + 16 * n + 4 * fq; float v[4];
#pragma unroll
            for (int j = 0; j < 4; ++j) { const int s = s0 + j; const float wgt = (s <= lr) ? __expf(fcs[s] - pm) : 0.f; v[j] = aS[m][n][j] * wgt * KSC; ds += v[j]; }
            u32x2 o; o.x = cvt_pk_bf16(v[0], v[1]); o.y = cvt_pk_bf16(v[2], v[3]); *(LAS u32x2*)(TS + lr * TROW + s0 * 2) = o; }
        ds += __shfl_xor(ds, 16); ds += __shfl_xor(ds, 32); if (fq == 0) pden[lr * 4 + wc] = ds; }
    __syncthreads();
    f32x4 a1[4][2], a2[4][2];
#pragma unroll
    for (int i = 0; i < 4; ++i)
#pragma unroll
        for (int j = 0; j < 2; ++j) { a1[i][j] = (f32x4){0.f, 0.f, 0.f, 0.f}; a2[i][j] = (f32x4){0.f, 0.f, 0.f, 0.f}; }
#pragma unroll
    for (int ks = 0; ks < 4; ++ks) { bf16x8 A[4], B[2];
#pragma unroll
        for (int m = 0; m < 4; ++m) A[m] = frag_row(TS, 64 * wr + 16 * m + fr, ks, fq);
#pragma unroll
        for (int n = 0; n < 2; ++n) B[n] = frag_tr(TV, 32 * wc + 16 * n, ks, lane);
#pragma unroll
        for (int m = 0; m < 4; ++m)
#pragma unroll
            for (int n = 0; n < 2; ++n) a1[m][n] = MFMA16(B[n], A[m], a1[m][n]); }
#pragma unroll
    for (int ks = 0; ks < 4; ++ks) { bf16x8 A[4], B[2];
#pragma unroll
        for (int m = 0; m < 4; ++m) A[m] = frag_row(TQ, 64 * wr + 16 * m + fr, ks, fq);
#pragma unroll
        for (int n = 0; n < 2; ++n) B[n] = frag_row(TC, 32 * wc + 16 * n + fr, ks, fq);
#pragma unroll
        for (int m = 0; m < 4; ++m)
#pragma unroll
            for (int n = 0; n < 2; ++n) a2[m][n] = MFMA16(B[n], A[m], a2[m][n]); }
#pragma unroll
    for (int m = 0; m < 4; ++m) { const int lr = 64 * wr + 16 * m + fr; const float isc = fisc[lr];
        const float den = (pden[lr * 4] + pden[lr * 4 + 1]) + (pden[lr * 4 + 2] + pden[lr * 4 + 3]) + isc * fqn[lr];
        const float inv = 1.f / fmaxf(fabsf(den), __expf(-(fb[lr] + fpm[lr]))); float ss = 0.f;
#pragma unroll
        for (int n = 0; n < 2; ++n) { a1[m][n] = (a1[m][n] + a2[m][n] * isc) * inv; ss += (a1[m][n][0] * a1[m][n][0] + a1[m][n][1] * a1[m][n][1]) + (a1[m][n][2] * a1[m][n][2] + a1[m][n][3] * a1[m][n][3]); }
        ss += __shfl_xor(ss, 16); ss += __shfl_xor(ss, 32); if (fq == 0) pss[lr * 4 + wc] = ss; }
    __syncthreads();
    const float* gn = c.in[IN_ML_NORM_G] + l * MLW + h * DH; bf16* Y = (bf16*)(c.ws + WS_Y);
#pragma unroll
    for (int m = 0; m < 4; ++m) { const int lr = 64 * wr + 16 * m + fr; const float rstd = rsqrtf(((pss[lr * 4] + pss[lr * 4 + 1]) + (pss[lr * 4 + 2] + pss[lr * 4 + 3])) * (1.f / DH) + EPS);
#pragma unroll
        for (int n = 0; n < 2; ++n) { const int e0 = 32 * wc + 16 * n + 4 * fq; const u32x2 ov = *(const u32x2*)(z + (t0 + lr) * NZ + ZO + h * DH + e0); const f32x4 gv = *(const f32x4*)(gn + e0);
            const float y0 = sigmoidf_(bflo(ov.x)) * a1[m][n][0] * rstd * gv[0], y1 = sigmoidf_(bfhi(ov.x)) * a1[m][n][1] * rstd * gv[1];
            const float y2 = sigmoidf_(bflo(ov.y)) * a1[m][n][2] * rstd * gv[2], y3 = sigmoidf_(bfhi(ov.y)) * a1[m][n][3] * rstd * gv[3];
            u32x2 o; o.x = cvt_pk_bf16(y0, y1); o.y = cvt_pk_bf16(y2, y3); *(u32x2*)(Y + (t0 + lr) * D + h * DH + e0) = o; } }
    __syncthreads();
}

__device__ __forceinline__ void mix_e_rg(const Ctx& c, int l, int u, int lane, int wave) {
    const int b = u >> 6, ck = u & 63; const size_t t0 = (size_t)b * SEQ + (size_t)ck * 64;
    const unsigned* RP = (const unsigned*)(c.ws + WS_RA); const bf16* z = (const bf16*)(c.ws + WS_Z); bf16* Y = (bf16*)(c.ws + WS_Y);
    const float* cinp = (const float*)(c.ws + SM_RGC) + (size_t)(b * 64 + ck) * RGW + 8 * lane; const float* gp = c.in[IN_RG_NORM_G] + l * RGW + 8 * lane;
    const f32x4 ci0 = *(const f32x4*)cinp, ci1 = *(const f32x4*)(cinp + 4), g0 = *(const f32x4*)gp, g1 = *(const f32x4*)(gp + 4);
    for (int i = 0; i < 8; ++i) { const size_t t = t0 + wave * 8 + i;
        const u32x4 p0 = *(const u32x4*)(RP + t * RGW + 8 * lane), p1 = *(const u32x4*)(RP + t * RGW + 8 * lane + 4);
        const f32x4 h0 = {bfhi(p0.x), bfhi(p0.y), bfhi(p0.z), bfhi(p0.w)}, h1 = {bfhi(p1.x), bfhi(p1.y), bfhi(p1.z), bfhi(p1.w)}, c0 = {bflo(p0.x), bflo(p0.y), bflo(p0.z), bflo(p0.w)}, c1 = {bflo(p1.x), bflo(p1.y), bflo(p1.z), bflo(p1.w)};
        const u32x4 rg = *(const u32x4*)(z + t * NZ + ZRG + 8 * lane);
        const float gt[8] = {bflo(rg.x), bfhi(rg.x), bflo(rg.y), bfhi(rg.y), bflo(rg.z), bfhi(rg.z), bflo(rg.w), bfhi(rg.w)};
        const f32x4 hh0 = h0 + c0 * ci0, hh1 = h1 + c1 * ci1; float v[8]; float s = 0.f;
#pragma unroll
        for (int j = 0; j < 8; ++j) { const float x = gt[j], uu = 1.5957691216057308f * (x + 0.044715f * x * x * x), ge = x / (1.f + __expf(-uu)); v[j] = (j < 4 ? hh0[j] : hh1[j - 4]) * ge; s += v[j] * v[j]; }
        const float r = rsqrtf(wave_sum(s) * (1.f / RGW) + EPS);
        u32x4 o; o.x = cvt_pk_bf16(v[0] * r * g0[0], v[1] * r * g0[1]); o.y = cvt_pk_bf16(v[2] * r * g0[2], v[3] * r * g0[3]); o.z = cvt_pk_bf16(v[4] * r * g1[0], v[5] * r * g1[1]); o.w = cvt_pk_bf16(v[6] * r * g1[2], v[7] * r * g1[3]);
        *(u32x4*)(Y + t * D + MLW + 8 * lane) = o; }
}
__device__ __forceinline__ void mix_c_phase(const Ctx& c, int l, LAS unsigned char* lds) {
    int tid_o = threadIdx.x; asm volatile("" : "+v"(tid_o)); const int tid = tid_o, lane = tid & 63, wave = __builtin_amdgcn_readfirstlane(tid >> 6);
    for (int w = opaque_bid(); w < 256; w += gridDim.x) mix_c_mlstm(c, 2 * w + (wave >> 2), lds + (wave >> 2) * CGRP_B, tid & 255, lane, wave & 3);
    for (int u = opaque_bid(); u < 256; u += gridDim.x) { mix_c_rg(c, l, u, lds, lane, wave); __syncthreads(); }
}
__device__ __forceinline__ void mix_d_phase(const Ctx& c, LAS unsigned char* lds) {
    int tid_o = threadIdx.x; asm volatile("" : "+v"(tid_o)); const int tid = tid_o, lane = tid & 63, wave = __builtin_amdgcn_readfirstlane(tid >> 6);
    mix_d(c, lds, tid, lane, wave);
}
__device__ __forceinline__ void mix_e_phase(const Ctx& c, int l, LAS unsigned char* lds) {
    int tid_o = threadIdx.x; asm volatile("" : "+v"(tid_o)); const int tid = tid_o, lane = tid & 63, wave = __builtin_amdgcn_readfirstlane(tid >> 6);
    for (int u = opaque_bid(); u < 512; u += gridDim.x) mix_e_mlstm(c, l, u, lds, tid, lane, wave);
    for (int u = opaque_bid(); u < 256; u += gridDim.x) mix_e_rg(c, l, u, lane, wave);
}
#ifndef ALIGN_E
#define ALIGN_E true
#endif
#ifndef STAG
#define STAG 0
#endif
#ifndef NULL_EPI
#define NULL_EPI 0
#endif
#ifndef REP_MASK
#define REP_MASK 0
#endif
#ifndef ONE_LAUNCH
#define ONE_LAUNCH 1
#endif
__global__ void __launch_bounds__(NTHR, 2) mega(Ctx c) {
    extern __shared__ __attribute__((aligned(16))) unsigned char lds_raw[];
    LAS unsigned char* lds = (LAS unsigned char*)lds_raw;
    const int tid = threadIdx.x;
    if (tid < 64) ((LAS unsigned*)(lds + MISC_OFF))[tid] = 0u;
    __syncthreads();
    XcdBarrier bar; bar.bar = (unsigned*)(c.ws + WS_CTL) + CW_BAR; bar.x = 0; bar.st = (volatile LAS unsigned*)(lds + MISC_OFF + 32);
    if (c.s_hi - c.s_lo > 1) bar = xcd_barrier_post((unsigned*)(c.ws + WS_CTL) + CW_BAR, (volatile LAS unsigned*)(lds + MISC_OFF + 32));
#define STEP_ON(s) (c.s_lo <= (s) && (s) < c.s_hi)
#define REPN(id) ((((REP_MASK) >> (id)) & 1) ? 2 : 1)
#define RP(id) for (int rr = 0; rr < REPN(id); ++rr)
#define SEAM(s) do { if ((s) + 1 < c.s_hi) { RP(15) xcd_barrier(bar); } } while (0)
    if (STEP_ON(0)) { RP(0) cvt_phase(c, lds); SEAM(0); }
    for (int l = 0; l < DEPTH; ++l) {
        const int s0 = 1 + 10 * l; const bool moe = (l & 1) != 0; const int jl = l >> 1;
        if (s0 + 9 < c.s_lo || s0 >= c.s_hi) continue;
        if (STEP_ON(s0 + 0)) { RP(1) norm_phase<1>(c, l, l == 2 && rr == 0, lds); SEAM(s0 + 0); }
        if (STEP_ON(s0 + 1)) {
            pg8::Gemm g{(const bf16*)(c.ws + WS_XN), (const bf16*)(c.ws + WS_WIN) + (size_t)l * NZ * D, T, NZ, D, D, STAG}; pg8::StaticOrder S; S.init(T, NZ, gridDim.x, opaque_bid());
            pg8::EpiBf16 E{(bf16*)(c.ws + WS_Z), NZ, 0};
            RP(2) { if (NULL_EPI && rr) { pg8::EpiNull EN; pg8::gemm_phase<pg8::EpiNull, pg8::StaticOrder, ALIGN_E, true>(lds, g, S, EN); } else pg8::gemm_phase<pg8::EpiBf16, pg8::StaticOrder, ALIGN_E, true>(lds, g, S, E); } SEAM(s0 + 1); }
        if (STEP_ON(s0 + 2)) { RP(3) mix_c_phase(c, l, lds); SEAM(s0 + 2); }
        if (STEP_ON(s0 + 3)) { RP(4) mix_d_phase(c, lds); SEAM(s0 + 3); }
        if (STEP_ON(s0 + 4)) { RP(5) mix_e_phase(c, l, lds); SEAM(s0 + 4); }
        if (STEP_ON(s0 + 5)) {
            pg8::Gemm g{(const bf16*)(c.ws + WS_Y), (const bf16*)(c.ws + WS_WOUT) + (size_t)l * D * D, T, D, D, D, 0}; pg8::StaticOrder S; S.init(T, D, gridDim.x, opaque_bid());
            RP(6) { pg8::EpiResF16 E{(l == 0 && !rr) ? c.in[IN_X] : nullptr, rr ? (_Float16*)(c.ws + WS_SCR) : (_Float16*)(c.ws + WS_H), D};
            pg8::gemm_phase<pg8::EpiResF16, pg8::StaticOrder, ALIGN_E, true>(lds, g, S, E); } SEAM(s0 + 5); }
        if (!moe) {
            if (STEP_ON(s0 + 6)) { RP(7) norm_phase<0>(c, l, false, lds); SEAM(s0 + 6); }
            if (STEP_ON(s0 + 7)) {
                pg8::Gemm g{(const bf16*)(c.ws + WS_XN), (const bf16*)(c.ws + WS_WGU) + (size_t)jl * 2 * FFD * D, T, 2 * FFD, D, D, STAG}; pg8::StaticOrder S; S.init(T, 2 * FFD, gridDim.x, opaque_bid());
                pg8::EpiSwiglu E{(bf16*)(c.ws + WS_HID), FFD};
                RP(8) pg8::gemm_phase<pg8::EpiSwiglu, pg8::StaticOrder, ALIGN_E, true>(lds, g, S, E); SEAM(s0 + 7); }
            if (STEP_ON(s0 + 8)) {
                pg8::Gemm g{(const bf16*)(c.ws + WS_HID), (const bf16*)(c.ws + WS_WD) + (size_t)jl * D * FFD, T, D, FFD, FFD, 0}; pg8::StaticOrder S; S.init(T, D, gridDim.x, opaque_bid());
                RP(9) { pg8::EpiResF16 E{nullptr, rr ? (_Float16*)(c.ws + WS_SCR) : (_Float16*)(c.ws + WS_H), D};
                pg8::gemm_phase<pg8::EpiResF16, pg8::StaticOrder, ALIGN_E, true>(lds, g, S, E); } SEAM(s0 + 8); }
        } else {
            if (STEP_ON(s0 + 6)) { RP(7) norm_phase<2>(c, l, false, lds); SEAM(s0 + 6); }
            if (STEP_ON(s0 + 7)) { RP(10) moe_gather_phase(c, lds); SEAM(s0 + 7); }
            if (STEP_ON(s0 + 8)) {
                const int* meta = (const int*)(c.ws + WS_META); const int nM = __builtin_amdgcn_readfirstlane(meta[16]);
                pg8::Gemm g{(const bf16*)(c.ws + WS_XG), (const bf16*)(c.ws + WS_MWGU) + (size_t)jl * NE * 2 * FFE * D, nM * 256, 2 * FFE, D, D, STAG}; pg8::MoeOrder S; S.init(nM, 2 * FFE, 1, gridDim.x, opaque_bid(), meta + 32);
                pg8::EpiSwiglu E{(bf16*)(c.ws + WS_MHID), FFE};
                RP(11) pg8::gemm_phase<pg8::EpiSwiglu, pg8::MoeOrder, ALIGN_E, true>(lds, g, S, E); SEAM(s0 + 8); }
            if (STEP_ON(s0 + 9)) {
                const int* meta = (const int*)(c.ws + WS_META); const int nM = __builtin_amdgcn_readfirstlane(meta[16]);
                pg8::Gemm g{(const bf16*)(c.ws + WS_MHID), (const bf16*)(c.ws + WS_MWD) + (size_t)jl * NE * D * FFE, nM * 256, D, FFE / MOE_KS, FFE, STAG}; pg8::MoeOrder S; S.init(nM, D, MOE_KS, gridDim.x, opaque_bid(), meta + 32);
                pg8::EpiBf16 E{(bf16*)(c.ws + WS_XG), D, (size_t)(WS_Y1 - WS_XG) / 2};
                RP(12) pg8::gemm_phase<pg8::EpiBf16, pg8::MoeOrder, ALIGN_E, true>(lds, g, S, E); SEAM(s0 + 9); }
        }
    }
    if (STEP_ON(41)) { RP(13) norm_phase<3>(c, 0, true, lds); }
}

namespace nv {
__global__ __launch_bounds__(256) void mlstm_rec(const bf16* __restrict__ z, const float* __restrict__ ifp, float* __restrict__ ht) {
    const int wave = (blockIdx.x * 256 + threadIdx.x) >> 6, lane = threadIdx.x & 63;
    const int bh = wave >> 5, es = wave & 31, b = bh >> 2, h = bh & 3, e0 = es * 4;
    float C[2][4] = {}, n[2] = {0.f, 0.f};
    const float ksc = 0.08838834764831845f;
    for (int t0 = 0; t0 < SEQ; t0 += 8) {
        float kk[8][2], qq[8][2], vv[8][4], ii[8], ff[8];
#pragma unroll
        for (int j = 0; j < 8; ++j) { const size_t t = (size_t)(b * SEQ + t0 + j); const bf16* row = z + t * NZ;
            kk[j][0] = bf2f(row[ZK + h * DH + lane]) * ksc; kk[j][1] = bf2f(row[ZK + h * DH + lane + 64]) * ksc; qq[j][0] = bf2f(row[ZQ + h * DH + lane]); qq[j][1] = bf2f(row[ZQ + h * DH + lane + 64]);
#pragma unroll
            for (int e = 0; e < 4; ++e) vv[j][e] = bf2f(row[ZV + h * DH + e0 + e]);
            ii[j] = __expf(ifp[t * 8 + h]); ff[j] = sigmoidf_(ifp[t * 8 + 4 + h]); }
#pragma unroll
        for (int j = 0; j < 8; ++j) { float s[5] = {0.f, 0.f, 0.f, 0.f, 0.f};
#pragma unroll
            for (int d = 0; d < 2; ++d) { n[d] = ff[j] * n[d] + ii[j] * kk[j][d]; s[4] += n[d] * qq[j][d];
#pragma unroll
                for (int e = 0; e < 4; ++e) { C[d][e] = ff[j] * C[d][e] + ii[j] * kk[j][d] * vv[j][e]; s[e] += C[d][e] * qq[j][d]; } }
#pragma unroll
            for (int e = 0; e < 5; ++e) s[e] = wave_sum(s[e]);
            const float den = fmaxf(fabsf(s[4]), 1.f);
            if (lane == 0) { float* o = ht + (size_t)(b * SEQ + t0 + j) * MLW + h * DH + e0; o[0] = s[0] / den; o[1] = s[1] / den; o[2] = s[2] / den; o[3] = s[3] / den; } }
    }
}
__global__ __launch_bounds__(256) void ml_out(const bf16* __restrict__ z, const float* __restrict__ ht, const float* __restrict__ g, bf16* __restrict__ y) {
    const int w = (blockIdx.x * 256 + threadIdx.x) >> 6, lane = threadIdx.x & 63, t = w >> 2, h = w & 3;
    const float a = ht[(size_t)t * MLW + h * DH + lane], b = ht[(size_t)t * MLW + h * DH + lane + 64];
    const float r = rsqrtf(wave_sum(a * a + b * b) * (1.f / DH) + EPS);
    const float oa = bf2f(z[(size_t)t * NZ + ZO + h * DH + lane]), ob = bf2f(z[(size_t)t * NZ + ZO + h * DH + lane + 64]);
    y[(size_t)t * D + h * DH + lane] = f2bf(sigmoidf_(oa) * a * r * g[h * DH + lane]); y[(size_t)t * D + h * DH + lane + 64] = f2bf(sigmoidf_(ob) * b * r * g[h * DH + lane + 64]);
}
__global__ __launch_bounds__(512) void rg_gates(const bf16* __restrict__ z, const float* __restrict__ cw, const float* __restrict__ cb, const float* __restrict__ wa, const float* __restrict__ ba,
                                                const float* __restrict__ wx, const float* __restrict__ bx, const float* __restrict__ lam, float* __restrict__ av, float* __restrict__ uv) {
    __shared__ float xs[RGW]; const int t = blockIdx.x, c = threadIdx.x, tl = t % SEQ;
    float xc = cb[c];
#pragma unroll
    for (int j = 0; j < 4; ++j) { const int tt = tl - 3 + j; if (tt >= 0) xc += cw[j * RGW + c] * bf2f(z[(size_t)(t - 3 + j) * NZ + ZRX + c]); }
    xs[c] = xc; __syncthreads();
    const int g = c >> 6, jj = c & 63; float ra = ba[c], rx = bx[c];
    for (int i = 0; i < RGD; ++i) { const float xv = xs[g * RGD + i]; ra += xv * wa[(g * RGD + i) * RGD + jj]; rx += xv * wx[(g * RGD + i) * RGD + jj]; }
    const float r = sigmoidf_(ra), ig = sigmoidf_(rx);
    const float sp = log1pf(__expf(-lam[c])); const float la = -8.f * r * sp;
    av[(size_t)t * RGW + c] = __expf(la); uv[(size_t)t * RGW + c] = sqrtf(-expm1f(2.f * la)) * (ig * xc);
}
__global__ __launch_bounds__(256) void rg_scan(const float* __restrict__ av, float* __restrict__ uv) {
    const int id = blockIdx.x * 256 + threadIdx.x, b = id / RGW, c = id % RGW; float h = 0.f;
    for (int t0 = 0; t0 < SEQ; t0 += 8) { float a[8], u[8];
#pragma unroll
        for (int j = 0; j < 8; ++j) { a[j] = av[(size_t)(b * SEQ + t0 + j) * RGW + c]; u[j] = uv[(size_t)(b * SEQ + t0 + j) * RGW + c]; }
#pragma unroll
        for (int j = 0; j < 8; ++j) { h = a[j] * h + u[j]; uv[(size_t)(b * SEQ + t0 + j) * RGW + c] = h; } }
}
__global__ __launch_bounds__(256) void rg_out(const bf16* __restrict__ z, const float* __restrict__ hr, const float* __restrict__ g, bf16* __restrict__ y) {
    const int t = (blockIdx.x * 256 + threadIdx.x) >> 6, lane = threadIdx.x & 63; float v[8]; float s = 0.f;
#pragma unroll
    for (int j = 0; j < 8; ++j) { const int c = lane + 64 * j; v[j] = hr[(size_t)t * RGW + c] * gelu_tanh(bf2f(z[(size_t)t * NZ + ZRG + c])); s += v[j] * v[j]; }
    const float r = rsqrtf(wave_sum(s) * (1.f / RGW) + EPS);
#pragma unroll
    for (int j = 0; j < 8; ++j) { const int c = lane + 64 * j; y[(size_t)t * D + MLW + c] = f2bf(v[j] * r * g[c]); }
}
}

extern "C" void kernel_launch(void* const* d_in, const int* in_sizes, int n_in, void* d_out, int out_size, void* d_ws, size_t ws_size, hipStream_t stream) {
    static int ok = 0; static int grid_g = 256;
    if (ok == 0) {
        if (n_in != 23 || ws_size < WS_END || out_size != T * D) { fprintf(stderr, "kernel_launch: unexpected shapes (n_in %d, ws %zu, out %d)\n", n_in, ws_size, out_size); ok = -1; return; }
        if (hipFuncSetAttribute((const void*)mega, hipFuncAttributeMaxDynamicSharedMemorySize, LDS_BYTES) != hipSuccess) { fprintf(stderr, "kernel_launch: hipFuncSetAttribute failed\n"); ok = -1; return; }
        int dev = 0, cus = 0, per_cu = 0; (void)hipGetDevice(&dev); (void)hipDeviceGetAttribute(&cus, hipDeviceAttributeMultiprocessorCount, dev);
        if (hipOccupancyMaxActiveBlocksPerMultiprocessor(&per_cu, (const void*)mega, NTHR, LDS_BYTES) != hipSuccess || per_cu < 1) { fprintf(stderr, "kernel_launch: occupancy query says %d blocks per CU\n", per_cu); (void)hipGetLastError(); }
        grid_g = cus > 0 ? cus : 256;
        ok = 1;
    }
    if (ok < 0) return;
    unsigned char* ws = (unsigned char*)d_ws;
    (void)hipMemsetAsync(ws + WS_CTL, 0, 1 * MiB, stream);
    Ctx base{}; for (int i = 0; i < 23; ++i) base.in[i] = (const float*)d_in[i]; base.out = (float*)d_out; base.ws = ws;
    auto run = [&](int lo, int hi) { Ctx a = base; a.s_lo = lo; a.s_hi = hi; hipLaunchKernelGGL(mega, dim3(grid_g), dim3(NTHR), LDS_BYTES, stream, a); };
    const bf16* z = (const bf16*)(ws + WS_Z); bf16* y = (bf16*)(ws + WS_Y); const float* ifp = (const float*)(ws + WS_IFP);
    float* ht = (float*)(ws + WS_CTL_LOC); float* ra = (float*)(ws + WS_RA); float* ru = (float*)(ws + WS_RU);
#if ONE_LAUNCH
    run(0, 42);
#else
    run(0, 1);
    for (int l = 0; l < DEPTH; ++l) {
        const int s0 = 1 + 10 * l;
        run(s0, s0 + 1); run(s0 + 1, s0 + 2);
#if MIX_FAST
        run(s0 + 2, s0 + 3); run(s0 + 3, s0 + 4); run(s0 + 4, s0 + 5);
#endif
#if !MIX_FAST || NV_ML
        nv::mlstm_rec<<<128, 256, 0, stream>>>(z, ifp, ht);
        nv::ml_out<<<T, 256, 0, stream>>>(z, ht, (const float*)d_in[IN_ML_NORM_G] + l * MLW, y);
#endif
#if !MIX_FAST || NV_RG
        nv::rg_gates<<<T, 512, 0, stream>>>(z, (const float*)d_in[IN_CONV_W] + l * 4 * RGW, (const float*)d_in[IN_CONV_B] + l * RGW, (const float*)d_in[IN_RG_W_A] + (size_t)l * RGB * RGD * RGD,
                                            (const float*)d_in[IN_RG_B_A] + l * RGW, (const float*)d_in[IN_RG_W_X] + (size_t)l * RGB * RGD * RGD, (const float*)d_in[IN_RG_B_X] + l * RGW, (const float*)d_in[IN_RG_LAM] + l * RGW, ra, ru);
        nv::rg_scan<<<BATCH * RGW / 256, 256, 0, stream>>>(ra, ru);
        nv::rg_out<<<T / 4, 256, 0, stream>>>(z, ru, (const float*)d_in[IN_RG_NORM_G] + l * RGW, y);
#endif
        run(s0 + 5, s0 + 6); run(s0 + 6, s0 + 7); run(s0 + 7, s0 + 8); run(s0 + 8, s0 + 9);
        if (l & 1) run(s0 + 9, s0 + 10);
    }
    run(41, 42);
#endif
}
```

```cpp
#include <hip/hip_runtime.h>
#include <cstdio>
#include <cstdint>

constexpr int D = 1024, BATCH = 4, SEQ = 4096, T = BATCH * SEQ, DEPTH = 4;
constexpr int MLW = 512, MLH = 4, DH = 128, RGW = 512, RGB = 8, RGD = 64;
constexpr int DIN = 3080, FFD = 2816, NE = 8, FFE = 3584;
constexpr int NZ = 3072;
constexpr int ZQ = 0, ZK = 512, ZV = 1024, ZO = 1536, ZRX = 2048, ZRG = 2560;
constexpr float EPS = 1e-6f;
constexpr int MAXROWS = 2 * T + NE * 256;
constexpr int MAXT256 = MAXROWS / 256;
constexpr int NWAVES = 8, NTHR = 512;

#define LAS __attribute__((address_space(3)))
#define GAS __attribute__((address_space(1)))
typedef unsigned short bf16;
typedef float f32x4 __attribute__((ext_vector_type(4)));
typedef float f32x2 __attribute__((ext_vector_type(2)));
typedef unsigned u32x4 __attribute__((ext_vector_type(4)));
typedef unsigned u32x2 __attribute__((ext_vector_type(2)));
typedef short bf16x8 __attribute__((ext_vector_type(8)));
typedef _Float16 h16x8 __attribute__((ext_vector_type(8)));
typedef float f32x8 __attribute__((ext_vector_type(8)));

__device__ __forceinline__ float wave_sum(float v) {
#pragma unroll
    for (int o = 1; o < 64; o <<= 1) v += __shfl_xor(v, o);
    return v;
}
__device__ __forceinline__ float sigmoidf_(float x) { return 1.f / (1.f + __expf(-x)); }
__device__ __forceinline__ float gelu_tanh(float x) { const float u = 0.7978845608028654f * (x + 0.044715f * x * x * x); return 0.5f * x * (1.f + tanhf(u)); }
__device__ __forceinline__ unsigned cvt_pk_bf16(float lo, float hi) { unsigned r; asm volatile("v_cvt_pk_bf16_f32 %0, %1, %2" : "=v"(r) : "v"(lo), "v"(hi)); return r; }
typedef __bf16 bf16x2_t __attribute__((ext_vector_type(2)));
__device__ __forceinline__ unsigned cvt_pk_bf16_c(float lo, float hi) { const bf16x2_t r = __builtin_convertvector((f32x2){lo, hi}, bf16x2_t); return __builtin_bit_cast(unsigned, r); }
__device__ __forceinline__ float bf2f(unsigned short b) { return __uint_as_float(((unsigned)b) << 16); }
__device__ __forceinline__ float bflo(unsigned w) { return __uint_as_float(w << 16); }
__device__ __forceinline__ float bfhi(unsigned w) { return __uint_as_float(w & 0xffff0000u); }
__device__ __forceinline__ bf16 f2bf(float f) { return (bf16)(cvt_pk_bf16(f, 0.f) & 0xffffu); }

#ifndef WGM_E
#define WGM_E 8
#endif
namespace pg8 {
#define PG8_LAS __attribute__((address_space(3)))
typedef unsigned short bf16_t;
constexpr int BM = 256, BK = 64, HALF = 128, HTB = HALF * BK * 2  , STAGE_BYTES = 8 * HTB, NXCD = 8, WGM = WGM_E;
__host__ __device__ __forceinline__ int lds_byte(int r, int c) { const int st = (r >> 4) * 2 + (c >> 5), rr = r & 15, cc = c & 31, ob = rr * 64 + cc * 2; return st * 1024 + (ob ^ (((ob >> 9) & 1) << 5)); }
__host__ __device__ __forceinline__ void stage_rc(int b, int& R, int& C) { const int st = b / 1024, sb = b % 1024, swz = sb ^ (((sb >> 9) & 1) << 5); R = (st >> 1) * 16 + swz / 64; C = (st & 1) * 32 + (swz % 64) / 2; }
__host__ __device__ __forceinline__ int perm32(int rho) { const int n = rho >> 4, i = rho & 15; return 8 * (i >> 2) + 4 * n + (i & 3); }

struct Unit { int pm, pn, pb, kz, ord, hf; };
struct Gemm { const bf16_t* A; const bf16_t* Bt; int M, N, K, ld, stag; };

struct StaticOrder {
    int nM, nN, nwg, G, c;
    __host__ __device__ void init(int M, int N, int G_, int c_) { nM = M / BM; nN = N / BM; nwg = nM * nN; G = G_; c = c_; }
    int L0 = 0, L1 = 0x7fffffff, halves = 0;
    __host__ __device__ bool next(int i, Unit& u) const {
        long L = (long)i * G + c; int hf = 0; if (halves) { hf = (int)(L & 1); L >>= 1; } L += L0; if (L >= nwg || L >= L1) return false; u.hf = hf;
        int wgid = (int)L; { const int q = nwg / NXCD, r = nwg % NXCD, xcd = wgid % NXCD, off = wgid / NXCD; wgid = (xcd < r ? xcd * (q + 1) : r * (q + 1) + (xcd - r) * q) + off; }
        const int nig = WGM * nN, gid = wgid / nig, fm = gid * WGM, gsz = (nM - fm) < WGM ? (nM - fm) : WGM;
        u.pm = fm + ((wgid % nig) % gsz); u.pn = (wgid % nig) / gsz; u.pb = u.pn; u.kz = 0; u.ord = i; return true;
    }
    __device__ __forceinline__ void a_ready(const Unit&) const {}
    __device__ __forceinline__ void done(const Unit&) const {}
};
struct MoeOrder {
    int nM, nN, nNo, KS, nwg, G, c, pm0; const PG8_LAS int* texp;
    __device__ void init(int nM_, int N, int KS_, int G_, int c_, const PG8_LAS int* texp_) { nM = nM_; nNo = N / BM; KS = KS_; nN = nNo * KS; nwg = nM * nN; G = G_; c = c_; texp = texp_; pm0 = 0; }
    int L0 = 0, L1 = 0x7fffffff, halves = 0;
    __device__ bool next(int i, Unit& u) const {
        long L = (long)i * G + c; int hf = 0; if (halves) { hf = (int)(L & 1); L >>= 1; } L += L0; if (L >= nwg || L >= L1) return false; u.hf = hf;
        int wgid = (int)L; { const int q = nwg / NXCD, r = nwg % NXCD, xcd = wgid % NXCD, off = wgid / NXCD; wgid = (xcd < r ? xcd * (q + 1) : r * (q + 1) + (xcd - r) * q) + off; }
        const int nig = WGM * nN, gid = wgid / nig, fm = gid * WGM, gsz = (nM - fm) < WGM ? (nM - fm) : WGM;
        u.pm = pm0 + fm + ((wgid % nig) % gsz); const int q = (wgid % nig) / gsz; u.pn = q / KS; u.kz = q % KS; u.pb = __builtin_amdgcn_readfirstlane(texp[u.pm]) * nNo + u.pn; u.ord = i; return true;
    }
    __device__ __forceinline__ void a_ready(const Unit&) const {}
    __device__ __forceinline__ void done(const Unit&) const {}
};

struct MoeOrderPub : MoeOrder {
    unsigned* cnt; mutable int prev_pm;
    __device__ __forceinline__ void done(const Unit& u) const {
        if (prev_pm >= 0 && (threadIdx.x & 63) == 0) __hip_atomic_fetch_add(cnt + 64 * prev_pm, 1u, __ATOMIC_RELAXED, __HIP_MEMORY_SCOPE_AGENT);
        prev_pm = u.pm; }
    __device__ __forceinline__ void flush() const { if (prev_pm >= 0 && (threadIdx.x & 63) == 0) __hip_atomic_fetch_add(cnt + 64 * prev_pm, 1u, __ATOMIC_RELAXED, __HIP_MEMORY_SCOPE_AGENT); prev_pm = -1; }
};
struct MoeOrderWait : MoeOrder {
    const unsigned* cnt; unsigned need; unsigned* tmo;
    __device__ __forceinline__ void a_ready(const Unit& u) const {
        if (threadIdx.x < 64) {
            const unsigned long long t0 = __builtin_amdgcn_s_memrealtime(); unsigned polls = 0;
            while ((unsigned)__builtin_amdgcn_readfirstlane(__hip_atomic_load(cnt + 64 * u.pm, __ATOMIC_RELAXED, __HIP_MEMORY_SCOPE_AGENT)) < need) {
                if ((++polls & 255u) == 0u && __builtin_amdgcn_readfirstlane(__hip_atomic_load(tmo, __ATOMIC_RELAXED, __HIP_MEMORY_SCOPE_AGENT)) != 0u) break;
                if (__builtin_amdgcn_s_memrealtime() - t0 > 2000000ull) { if (threadIdx.x == 0) __hip_atomic_store(tmo, 1u, __ATOMIC_RELAXED, __HIP_MEMORY_SCOPE_AGENT); break; }
                __builtin_amdgcn_s_sleep(2); }
            __builtin_amdgcn_fence(__ATOMIC_ACQUIRE, "agent");
            asm volatile("s_waitcnt vmcnt(0)" ::: "memory");
        }
        asm volatile("" ::: "memory"); __builtin_amdgcn_s_barrier(); asm volatile("" ::: "memory");
    }
};

__device__ __forceinline__ float row_rstd(const float* SSQ, int row, int fq) {
    const f32x4 p = *(const f32x4*)(SSQ + (size_t)row * 16 + 4 * fq); float s = (p[0] + p[1]) + (p[2] + p[3]);
    s += __shfl_xor(s, 16); s += __shfl_xor(s, 32); return rsqrtf(s * (1.0f / 1024.0f) + 1e-6f);
}
__device__ __forceinline__ void row_rstd8(const float* SSQ, int row0, int fq, float (&rs)[2][4]) {
    f32x4 p[2][4];
#pragma unroll
    for (int ai = 0; ai < 2; ++ai)
#pragma unroll
        for (int m = 0; m < 4; ++m) p[ai][m] = *(const f32x4*)(SSQ + (size_t)(row0 + ai * 128 + m * 16) * 16 + 4 * fq);
#pragma unroll
    for (int ai = 0; ai < 2; ++ai)
#pragma unroll
        for (int m = 0; m < 4; ++m) { float s = (p[ai][m][0] + p[ai][m][1]) + (p[ai][m][2] + p[ai][m][3]); s += __shfl_xor(s, 16); s += __shfl_xor(s, 32); rs[ai][m] = rsqrtf(s * (1.0f / 1024.0f) + 1e-6f); }
}
template <bool USE_RS> struct EpiBf16T {
    static constexpr bool PERM = true, AFTER_DRAIN = false;
    bf16_t* O; int ldc; size_t zstride; const PG8_LAS float* RS;
    __device__ __forceinline__ void operator()(const f32x4 (&acc)[2][2][4][2], const Unit& u, int wr, int wc, int fr, int fq) const {
        const int row0 = u.pm * BM + wr * 64 + fr, col0 = u.pn * BM + wc * 32 + 8 * fq;
#pragma unroll
        for (int ai = 0; ai < 2; ++ai)
#pragma unroll
            for (int m = 0; m < 4; ++m) { const int row = row0 + ai * HALF + m * 16; bf16_t* rowp = O + (size_t)u.kz * zstride + (size_t)row * ldc + col0; float rs = 1.f; if constexpr (USE_RS) rs = RS[u.ord * 256 + wr * 64 + fr + ai * HALF + m * 16];
#pragma unroll
                for (int bj = 0; bj < 2; ++bj) { const f32x4 v0 = acc[ai][bj][m][0] * rs, v1 = acc[ai][bj][m][1] * rs;
                    u32x4 w; w.x = cvt_pk_bf16_c(v0[0], v0[1]); w.y = cvt_pk_bf16_c(v0[2], v0[3]); w.z = cvt_pk_bf16_c(v1[0], v1[1]); w.w = cvt_pk_bf16_c(v1[2], v1[3]);
                    *(u32x4*)(rowp + bj * HALF) = w; } }
    }
};
typedef EpiBf16T<false> EpiBf16;
struct EpiNull {
    static constexpr bool PERM = true, AFTER_DRAIN = false;
    __device__ __forceinline__ void operator()(const f32x4 (&acc)[2][2][4][2], const Unit& u, int wr, int wc, int fr, int fq) const {
#pragma unroll
        for (int ai = 0; ai < 2; ++ai)
#pragma unroll
            for (int bj = 0; bj < 2; ++bj)
#pragma unroll
                for (int m = 0; m < 4; ++m)
#pragma unroll
                    for (int n = 0; n < 2; ++n) asm volatile("" :: "v"(acc[ai][bj][m][n]));
    }
};
template <bool WITH_XO> struct EpiResF16T {
    static constexpr bool PERM = true, AFTER_DRAIN = false;
    const float* X; _Float16* H; int ldc; bf16_t* XO; const float* gain; float* SSQ;
    __device__ __forceinline__ void operator()(const f32x4 (&acc)[2][2][4][2], const Unit& u, int wr, int wc, int fr, int fq) const {
        const int row0 = u.pm * BM + wr * 64 + fr, col0 = u.pn * BM + wc * 32 + 8 * fq;
        f32x8 gv[2];
        if constexpr (WITH_XO) { gv[0] = *(const f32x8*)(gain + col0); gv[1] = *(const f32x8*)(gain + col0 + HALF); }
#pragma unroll
        for (int ai = 0; ai < 2; ++ai)
#pragma unroll
            for (int m = 0; m < 4; ++m) { const int row = row0 + ai * HALF + m * 16; const size_t ro = (size_t)row * ldc + col0; f32x8 b[2];
                if (X) { b[0] = *(const f32x8*)(X + ro); b[1] = *(const f32x8*)(X + ro + HALF); }
                else { b[0] = __builtin_convertvector(*(const h16x8*)(H + ro), f32x8); b[1] = __builtin_convertvector(*(const h16x8*)(H + ro + HALF), f32x8); }
#pragma unroll
                for (int bj = 0; bj < 2; ++bj) {
#pragma unroll
                    for (int j = 0; j < 4; ++j) { b[bj][j] += acc[ai][bj][m][0][j]; b[bj][4 + j] += acc[ai][bj][m][1][j]; }
                    *(h16x8*)(H + ro + bj * HALF) = __builtin_convertvector(b[bj], h16x8); }
                if constexpr (WITH_XO) { float ss = 0.f;
#pragma unroll
                    for (int bj = 0; bj < 2; ++bj) {
#pragma unroll
                        for (int j = 0; j < 8; ++j) ss += b[bj][j] * b[bj][j];
                        const f32x8 o = b[bj] * gv[bj]; u32x4 w; w.x = cvt_pk_bf16(o[0], o[1]); w.y = cvt_pk_bf16(o[2], o[3]); w.z = cvt_pk_bf16(o[4], o[5]); w.w = cvt_pk_bf16(o[6], o[7]);
                        *(u32x4*)(XO + ro + bj * HALF) = w; }
                    ss += __shfl_xor(ss, 16); ss += __shfl_xor(ss, 32);
                    if (fq == 0) SSQ[(size_t)row * 16 + 4 * u.pn + wc] = ss; } }
    }
};
typedef EpiResF16T<false> EpiResF16;
template <bool USE_RS, bool WT = false, bool HM = false> struct EpiSwigluT {
    static constexpr bool PERM = true, AFTER_DRAIN = false;
    bf16_t* O; int ldc; const PG8_LAS float* RS; int obytes;
    __device__ __forceinline__ void operator()(const f32x4 (&acc)[2][2][4][2], const Unit& u, int wr, int wc, int fr, int fq) const {
        const int row0 = u.pm * BM + (HM ? u.hf * HALF : 0) + wr * 64 + fr, col0 = u.pn * HALF + wc * 32 + 8 * fq;
        __amdgpu_buffer_rsrc_t rsrc = __builtin_amdgcn_make_buffer_rsrc((void*)O, 0, WT ? obytes : 0, 0x00020000);
#pragma unroll
        for (int ai = 0; ai < (HM ? 1 : 2); ++ai)
#pragma unroll
            for (int m = 0; m < 4; ++m) { const int row = row0 + ai * HALF + m * 16; bf16_t* rowp = O + (size_t)row * ldc + col0; float r[8]; float rs = 1.f; if constexpr (USE_RS) rs = RS[u.ord * 256 + wr * 64 + fr + ai * HALF + m * 16];
#pragma unroll
                for (int n = 0; n < 2; ++n)
#pragma unroll
                    for (int j = 0; j < 4; ++j) { const float g = acc[ai][0][m][n][j] * rs, up = acc[ai][1][m][n][j] * rs; r[4 * n + j] = g * __builtin_amdgcn_rcpf(1.f + __expf(-g)) * up; }
                u32x4 w; w.x = cvt_pk_bf16(r[0], r[1]); w.y = cvt_pk_bf16(r[2], r[3]); w.z = cvt_pk_bf16(r[4], r[5]); w.w = cvt_pk_bf16(r[6], r[7]);
                if constexpr (WT) __builtin_amdgcn_raw_buffer_store_b128(w, rsrc, (int)(((size_t)row * ldc + col0) * 2), 0, 16); else *(u32x4*)rowp = w; }
    }
};
typedef EpiSwigluT<false> EpiSwiglu;

template <class Epi, class Sched, bool ALIGN_EPI = false, bool SP2 = false, bool HALFM = false>
__device__ __forceinline__ void gemm_phase(PG8_LAS unsigned char* lds, const Gemm g, const Sched& S, const Epi& E) {
    int tid_o = threadIdx.x; asm volatile("" : "+v"(tid_o));
    const int tid = tid_o, wid = __builtin_amdgcn_readfirstlane(tid >> 6), lane = tid & 63, wr = wid >> 2, wc = wid & 3, fr = lane & 15, fq = lane >> 4;
    if (g.stag > 0) { const int sg = (int)((blockIdx.x >> 3) & 3u); for (int i = 0; i < sg * g.stag; ++i) __builtin_amdgcn_s_sleep(63); }
    const int K = g.ld, nt = g.K / BK;
    unsigned voffA[2], voffB[2];
#pragma unroll
    for (int i = 0; i < 2; ++i) { int R, C; stage_rc(tid * 16 + i * 8192, R, C); const int Rb = Epi::PERM ? ((R & ~31) + perm32(R & 31)) : R;
        voffA[i] = (unsigned)(R * K + C) * 2u; voffB[i] = (unsigned)(Rb * K + C) * 2u; }
    const size_t kstep = (size_t)(BK * 2);
    const size_t hstep = (size_t)HALF * K * 2;
    const size_t tstep = 2 * hstep;
    const size_t hstepA = HALFM ? (size_t)0 : hstep;
    const unsigned ldsw = (unsigned)wid * 1024u;
    const int aoff = lds_byte(wr * 64 + fr, fq * 8), boff = lds_byte(wc * 32 + fr, fq * 8);
#define PG8_SA(b, h) (((b) * 2 + (h)) * HTB)
#define PG8_SB(b, h) ((4 + (b) * 2 + (h)) * HTB)
#define PG8_STAGE(bufoff, gbase, voff) do { _Pragma("unroll") for (int _i = 0; _i < 2; ++_i) \
        __builtin_amdgcn_global_load_lds((const unsigned*)((const char*)(gbase) + (voff)[_i]), (PG8_LAS unsigned*)(lds + (bufoff) + ldsw + _i * 8192), 16, 0, 0); } while (0)
#define PG8_LDA(dst, b, h) do { _Pragma("unroll") for (int m = 0; m < 4; ++m) _Pragma("unroll") for (int k = 0; k < 2; ++k) dst[m][k] = *(const PG8_LAS bf16x8*)(lds + PG8_SA(b, h) + aoff + m * 2048 + k * 1024); } while (0)
#define PG8_LDB(dst, b, h) do { _Pragma("unroll") for (int n = 0; n < 2; ++n) _Pragma("unroll") for (int k = 0; k < 2; ++k) dst[n][k] = *(const PG8_LAS bf16x8*)(lds + PG8_SB(b, h) + boff + n * 2048 + k * 1024); } while (0)
#define PG8_MMA(ai, bj, At, Bt) do { __builtin_amdgcn_s_setprio(1); _Pragma("unroll") for (int m = 0; m < 4; ++m) _Pragma("unroll") for (int n = 0; n < 2; ++n) _Pragma("unroll") for (int k = 0; k < 2; ++k) \
        acc[ai][bj][m][n] = __builtin_amdgcn_mfma_f32_16x16x32_bf16(Bt[n][k], At[m][k], acc[ai][bj][m][n], 0, 0, 0); __builtin_amdgcn_s_setprio(0); } while (0)
#define PG8_WAIT_V(n) asm volatile("s_waitcnt vmcnt(" #n ")" ::: "memory")
#define PG8_WAIT_L(n) asm volatile("s_waitcnt lgkmcnt(" #n ")" ::: "memory")
#define PG8_BAR __builtin_amdgcn_s_barrier()
#define PG8_SCHED __builtin_amdgcn_sched_barrier(0)
    Unit cur, nxt; int ui = 0;
    if (!S.next(0, cur)) return;
    f32x4 acc[2][2][4][2];
#pragma unroll
    for (int a = 0; a < 2; ++a)
#pragma unroll
        for (int b = 0; b < 2; ++b)
#pragma unroll
            for (int m = 0; m < 4; ++m)
#pragma unroll
                for (int n = 0; n < 2; ++n) acc[a][b][m][n] = (f32x4){0.f, 0.f, 0.f, 0.f};
    bf16x8 At[4][2], B0[2][2], B1[2][2];
    const size_t kzb = (size_t)g.K * 2;
    const char* cA = (const char*)g.A + (size_t)cur.pm * tstep + cur.kz * kzb + (HALFM ? cur.hf * hstep : (size_t)0); const char* cB = (const char*)g.Bt + (size_t)cur.pb * tstep + cur.kz * kzb;
    S.a_ready(cur);
    if constexpr (SP2) {
        PG8_STAGE(PG8_SB(0, 0), cB, voffB); PG8_STAGE(PG8_SB(0, 1), cB + hstep, voffB); PG8_STAGE(PG8_SA(0, 0), cA, voffA); PG8_STAGE(PG8_SA(0, 1), cA + hstepA, voffA);
        if (wr == 1) PG8_BAR;
        PG8_WAIT_V(2); PG8_BAR;
        PG8_STAGE(PG8_SB(1, 0), cB + kstep, voffB); PG8_STAGE(PG8_SA(1, 0), cA + kstep, voffA); PG8_STAGE(PG8_SB(1, 1), cB + hstep + kstep, voffB);
        PG8_WAIT_V(6); PG8_BAR;
    } else {
        PG8_STAGE(PG8_SB(0, 0), cB, voffB); PG8_STAGE(PG8_SA(0, 0), cA, voffA); PG8_STAGE(PG8_SB(0, 1), cB + hstep, voffB); PG8_STAGE(PG8_SA(0, 1), cA + hstepA, voffA);
        if (wr == 1) PG8_BAR;
        PG8_WAIT_V(4); PG8_BAR;
        PG8_STAGE(PG8_SB(1, 0), cB + kstep, voffB); PG8_STAGE(PG8_SA(1, 0), cA + kstep, voffA); PG8_STAGE(PG8_SB(1, 1), cB + hstep + kstep, voffB);
        PG8_WAIT_V(6); PG8_BAR;
    }
    for (;;) {
        const bool has_next = S.next(ui + 1, nxt);
        const char* nA = has_next ? (const char*)g.A + (size_t)nxt.pm * tstep + nxt.kz * kzb + (HALFM ? nxt.hf * hstep : (size_t)0) : cA; const char* nB = has_next ? (const char*)g.Bt + (size_t)nxt.pb * tstep + nxt.kz * kzb : cB;
        for (int t = 0; t < nt; t += 2) {
            const bool last = (t == nt - 2);
            const char* a1 = cA + (size_t)(t + 1) * kstep;
            const char* a2 = last ? nA : cA + (size_t)(t + 2) * kstep; const char* b2 = last ? nB : cB + (size_t)(t + 2) * kstep;
            const char* a3 = a2 + kstep; const char* b3 = b2 + kstep;
            if (last && has_next) S.a_ready(nxt);
            if constexpr (SP2) {
            PG8_LDB(B0, 0, 0); PG8_LDB(B1, 0, 1); PG8_SCHED; PG8_LDA(At, 0, 0); PG8_STAGE(PG8_SA(1, 1), a1 + hstepA, voffA);
            PG8_WAIT_V(8); PG8_WAIT_L(0); PG8_BAR; PG8_MMA(0, 0, At, B0); PG8_MMA(0, 1, At, B1); PG8_BAR; PG8_SCHED;
            PG8_LDA(At, 0, 1); PG8_STAGE(PG8_SB(0, 0), b2, voffB); PG8_STAGE(PG8_SB(0, 1), b2 + hstep, voffB); PG8_STAGE(PG8_SA(0, 0), a2, voffA);
            PG8_WAIT_V(8); PG8_WAIT_L(0); PG8_BAR; if constexpr (!HALFM) { PG8_MMA(1, 0, At, B0); PG8_MMA(1, 1, At, B1); } PG8_BAR; PG8_SCHED;
            PG8_LDB(B0, 1, 0); PG8_LDB(B1, 1, 1); PG8_SCHED; PG8_LDA(At, 1, 0); PG8_STAGE(PG8_SA(0, 1), a2 + hstepA, voffA);
            PG8_WAIT_V(8); PG8_WAIT_L(0); PG8_BAR; PG8_MMA(0, 0, At, B0); PG8_MMA(0, 1, At, B1); PG8_BAR; PG8_SCHED;
            PG8_LDA(At, 1, 1); PG8_STAGE(PG8_SB(1, 0), b3, voffB); PG8_STAGE(PG8_SB(1, 1), b3 + hstep, voffB); PG8_STAGE(PG8_SA(1, 0), a3, voffA);
            PG8_WAIT_V(8); PG8_WAIT_L(0); PG8_BAR; if constexpr (!HALFM) { PG8_MMA(1, 0, At, B0); PG8_MMA(1, 1, At, B1); } PG8_BAR; PG8_SCHED;
            } else {
            PG8_LDB(B0, 0, 0); PG8_SCHED; PG8_LDA(At, 0, 0); PG8_STAGE(PG8_SA(1, 1), a1 + hstepA, voffA);
            PG8_WAIT_L(8); PG8_BAR; PG8_WAIT_L(0); PG8_MMA(0, 0, At, B0); PG8_BAR; PG8_SCHED;
            PG8_LDB(B1, 0, 1); PG8_STAGE(PG8_SB(0, 0), b2, voffB);
            PG8_BAR; PG8_WAIT_L(0); PG8_MMA(0, 1, At, B1); PG8_BAR;
            PG8_LDA(At, 0, 1); PG8_STAGE(PG8_SA(0, 0), a2, voffA);
            PG8_BAR; PG8_WAIT_L(0); if constexpr (!HALFM) PG8_MMA(1, 0, At, B0); PG8_BAR; PG8_SCHED;
            PG8_STAGE(PG8_SB(0, 1), b2 + hstep, voffB);
            PG8_WAIT_V(6); PG8_BAR; if constexpr (!HALFM) PG8_MMA(1, 1, At, B1); PG8_BAR;
            PG8_LDB(B0, 1, 0); PG8_SCHED; PG8_LDA(At, 1, 0); PG8_STAGE(PG8_SA(0, 1), a2 + hstepA, voffA);
            PG8_WAIT_L(8); PG8_BAR; PG8_WAIT_L(0); PG8_MMA(0, 0, At, B0); PG8_BAR; PG8_SCHED;
            PG8_LDB(B1, 1, 1); PG8_STAGE(PG8_SB(1, 0), b3, voffB);
            PG8_BAR; PG8_WAIT_L(0); PG8_MMA(0, 1, At, B1); PG8_BAR;
            PG8_LDA(At, 1, 1); PG8_STAGE(PG8_SA(1, 0), a3, voffA);
            PG8_BAR; PG8_WAIT_L(0); if constexpr (!HALFM) PG8_MMA(1, 0, At, B0); PG8_BAR; PG8_SCHED;
            PG8_STAGE(PG8_SB(1, 1), b3 + hstep, voffB);
            PG8_WAIT_V(6); PG8_BAR; if constexpr (!HALFM) PG8_MMA(1, 1, At, B1); PG8_BAR;
            }
        }
        if constexpr (ALIGN_EPI) { if (wr == 0) PG8_BAR; }
        if constexpr (!Epi::AFTER_DRAIN) { E(acc, cur, wr, wc, fr, fq); S.done(cur); }
        if (!has_next) break;
#pragma unroll
        for (int a = 0; a < 2; ++a)
#pragma unroll
            for (int b = 0; b < 2; ++b)
#pragma unroll
                for (int m = 0; m < 4; ++m)
#pragma unroll
                    for (int n = 0; n < 2; ++n) acc[a][b][m][n] = (f32x4){0.f, 0.f, 0.f, 0.f};
        cur = nxt; cA = nA; cB = nB; ++ui;
        if constexpr (ALIGN_EPI) { if (wr == 1) PG8_BAR; }
    }
    PG8_WAIT_V(0);
    if constexpr (!ALIGN_EPI) { if (wr == 0) PG8_BAR; }
    PG8_BAR;
    if constexpr (Epi::AFTER_DRAIN) { E.fused(acc, cur, wr, wc, fr, fq, lds, wid, lane); S.done(cur); }
#undef PG8_SA
#undef PG8_SB
#undef PG8_STAGE
#undef PG8_LDA
#undef PG8_LDB
#undef PG8_MMA
#undef PG8_WAIT_V
#undef PG8_WAIT_L
#undef PG8_BAR
#undef PG8_SCHED
}
}

constexpr size_t MiB = 1u << 20;
constexpr size_t WS_CTL = 0;
constexpr int CW_BAR = 4096;
constexpr int CW_MOECNT = 32768;
constexpr int CW_BGCUR = 64;
constexpr size_t WS_IFP = 1 * MiB;
constexpr size_t WS_EIDX = WS_IFP + 512 * 1024;
constexpr size_t WS_EW = WS_EIDX + 128 * 1024;
constexpr size_t WS_POS = WS_EW + 128 * 1024;
constexpr size_t WS_BLKCNT = WS_POS + 128 * 1024;
constexpr size_t WS_META = WS_BLKCNT + 16 * 1024;
constexpr size_t WS_SMALL = 2 * MiB;
constexpr size_t WS_SSQ = 6 * MiB;
constexpr size_t WS_WRG = 4 * MiB;
constexpr size_t WS_WIN = 8 * MiB;
constexpr size_t WS_WOUT = 32 * MiB;
constexpr size_t WS_WGU = 40 * MiB;
constexpr size_t WS_WD = 62 * MiB;
constexpr size_t WS_MWGU = 74 * MiB;
constexpr size_t WS_MWD = 298 * MiB;
constexpr size_t WS_H = 410 * MiB;
constexpr size_t WS_XN = 474 * MiB;
constexpr size_t WS_R = 506 * MiB;
constexpr size_t WS_Z = WS_R;
constexpr size_t WS_Y = WS_R + 96 * MiB;
constexpr size_t WS_CTL_LOC = WS_R + 128 * MiB;
constexpr size_t WS_CTP = WS_R + 160 * MiB;
constexpr size_t WS_RA = WS_R + 176 * MiB;
constexpr size_t WS_RU = WS_R + 208 * MiB;
constexpr size_t WS_HID = WS_R;
constexpr size_t WS_XG = WS_R;
constexpr size_t WS_MHID = WS_R + 68 * MiB;
constexpr size_t WS_Y1 = 812 * MiB;
constexpr size_t WS_SCR = WS_R + 128 * MiB;
constexpr size_t WS_END = 880 * MiB;
constexpr int MOE_KS = 1;
constexpr int MOE_FULL = 128, MOE_TS = 7;
constexpr int MOE_KS_UNUSED = 1;

constexpr int LDS_BYTES = 163840;
constexpr int MISC_OFF = LDS_BYTES - 256;

struct Ctx { const float* in[23]; float* out; unsigned char* ws; int s_lo, s_hi; };

#define XB_TMO      128
#define XB_XCNT(j)  (256  + 64 * (j))
#define XB_XSUB(j)  (1280 + 64 * (j))
#define XB_XGEN(j)  (2304 + 64 * (j))
#define XB_TOP      3328
#define XB_TOPGEN   3392
#define XCD_BAR_WORDS 3456
#define XB_SPIN_CAP (1u << 18)

__device__ __forceinline__ unsigned xb_ld(unsigned* p)              { return __hip_atomic_load(p, __ATOMIC_RELAXED, __HIP_MEMORY_SCOPE_AGENT); }
__device__ __forceinline__ unsigned xb_add(unsigned* p, unsigned v) { return __hip_atomic_fetch_add(p, v, __ATOMIC_RELAXED, __HIP_MEMORY_SCOPE_AGENT); }
__device__ __forceinline__ unsigned xb_xcc_id() { return (unsigned)__builtin_amdgcn_s_getreg((3 << 11) | 20) & 0xFu; }
#define XB_SPIN(cond, bar) do { unsigned _sp = 0; while (cond) { __builtin_amdgcn_s_sleep(1); \
    if ((++_sp & 255u) == 0u) { if (xb_ld(&(bar)[XB_TMO])) break; if (_sp > XB_SPIN_CAP) { atomicAdd(&(bar)[XB_TMO], 1u); break; } } } } while (0)

struct XcdBarrier {
    unsigned* bar; unsigned x;
    volatile LAS unsigned* st;
};

__device__ __forceinline__ XcdBarrier xcd_barrier_post(unsigned* bar, volatile LAS unsigned* st) {
    XcdBarrier b; b.bar = bar; b.x = xb_xcc_id(); b.st = st;
    if (threadIdx.x == 0) (void)xb_add(&bar[XB_XCNT(b.x)], 1u);
    return b;
}
__device__ __forceinline__ void xcd_barrier_complete(unsigned* bar, unsigned x, unsigned& nloc, unsigned& nx) {
    const unsigned G = gridDim.x * gridDim.y * gridDim.z;
    unsigned sum, cnt, mine, sp = 0u;
    for (;;) {
        sum = 0u; cnt = 0u; mine = 0u;
#pragma unroll
        for (unsigned j = 0; j < 16; ++j) { const unsigned c = xb_ld(&bar[XB_XCNT(j)]); sum += c; cnt += (c > 0u) ? 1u : 0u; mine = (j == x) ? c : mine; }
        if (sum == G) break;
        __builtin_amdgcn_s_sleep(1);
        if ((++sp & 255u) == 0u) { if (xb_ld(&bar[XB_TMO])) break; if (sp > XB_SPIN_CAP) { atomicAdd(&bar[XB_TMO], 1u); break; } }
    }
    nloc = mine > 0u ? mine : 1u; nx = cnt > 0u ? cnt : 1u;
}

__device__ __forceinline__ void xcd_barrier(const XcdBarrier& b) {
    asm volatile("s_waitcnt vmcnt(0)" ::: "memory");
    __syncthreads();
    if (threadIdx.x == 0) {
        unsigned* bar = b.bar;
        __builtin_amdgcn_s_waitcnt(0);
        unsigned nloc = b.st[0], nx = b.st[1];
        if (nloc == 0u) { xcd_barrier_complete(bar, b.x, nloc, nx); b.st[0] = nloc; b.st[1] = nx; }
        const unsigned old = xb_add(&bar[XB_XSUB(b.x)], 1u);
        const unsigned gen = old / nloc;
        if (old + 1u == (gen + 1u) * nloc) {
            __builtin_amdgcn_fence(__ATOMIC_RELEASE, "agent");
            asm volatile("s_waitcnt vmcnt(0)" ::: "memory");
            const unsigned og = xb_add(&bar[XB_TOP], 1u);
            const unsigned tg = og / nx;
            if (og + 1u == (tg + 1u) * nx) xb_add(&bar[XB_TOPGEN], 1u);
            else XB_SPIN(xb_ld(&bar[XB_TOPGEN]) == tg, bar);
            __builtin_amdgcn_fence(__ATOMIC_ACQUIRE, "agent");
            xb_add(&bar[XB_XGEN(b.x)], 1u);
            asm volatile("s_waitcnt vmcnt(0)" ::: "memory");
        } else {
            XB_SPIN(xb_ld(&bar[XB_XGEN(b.x)]) == gen, bar);
            __builtin_amdgcn_fence(__ATOMIC_ACQUIRE, "agent");
            asm volatile("s_waitcnt vmcnt(0)" ::: "memory");
        }
    }
    __syncthreads();
}

#ifndef MIX_FAST
#define MIX_FAST 1
#endif
#ifndef NV_ML
#define NV_ML 0
#endif
#ifndef NV_RG
#define NV_RG 0
#endif
#ifndef CVT_KFAST
#define CVT_KFAST 0
#endif
#ifndef DOTREP
#define DOTREP 1
#endif
#ifndef BG_ON
#define BG_ON 0
#endif
__device__ __forceinline__ int opaque_bid() { int b = blockIdx.x; asm volatile("" : "+s"(b)); return b; }
#define IN_X 0
#define IN_NORM_MIX_G 1
#define IN_W_IN 2
#define IN_ML_B_IF 3
#define IN_ML_NORM_G 4
#define IN_CONV_W 5
#define IN_CONV_B 6
#define IN_RG_W_A 7
#define IN_RG_B_A 8
#define IN_RG_W_X 9
#define IN_RG_B_X 10
#define IN_RG_LAM 11
#define IN_RG_NORM_G 12
#define IN_W_OUT 13
#define IN_NORM_FFN_G 14
#define IN_FFN_WG 15
#define IN_FFN_WU 16
#define IN_FFN_WD 17
#define IN_MOE_WR 18
#define IN_MOE_WG 19
#define IN_MOE_WU 20
#define IN_MOE_WD 21
#define IN_NORM_FINAL_G 22

__device__ __forceinline__ void cvt_tile(const float* __restrict__ src, int ld, bf16* __restrict__ dst, int K, LAS float* scr, int lane) {
#pragma unroll 4
    for (int i = 0; i < 16; ++i) { const int kk = 4 * i + (lane >> 4); const f32x4 v = __builtin_nontemporal_load((const f32x4*)(src + (size_t)kk * ld + (lane & 15) * 4));
        LAS float* s = scr + kk * 65 + (lane & 15) * 4; s[0] = v[0]; s[1] = v[1]; s[2] = v[2]; s[3] = v[3]; }
    asm volatile("s_waitcnt lgkmcnt(0)" ::: "memory");
    const int c = lane & 7;
#pragma unroll
    for (int j = 0; j < 8; ++j) { const int n = (lane >> 3) + 8 * j; const LAS float* s = scr + (8 * c) * 65 + n;
        u32x4 o; o.x = cvt_pk_bf16(s[0], s[65]); o.y = cvt_pk_bf16(s[130], s[195]); o.z = cvt_pk_bf16(s[260], s[325]); o.w = cvt_pk_bf16(s[390], s[455]);
        *(u32x4*)(dst + (size_t)n * K + 8 * c) = o; }
    asm volatile("s_waitcnt lgkmcnt(0)" ::: "memory");
}
constexpr int CV_IN = 4 * 768, CV_OUT = 4 * 256, CV_GU = 2 * 1408, CV_D = 2 * 704, CV_MGU = 16 * 1792, CV_MD = 16 * 896, CV_RG = 64;
constexpr int CV_TOTAL = CV_IN + CV_OUT + CV_GU + CV_D + CV_MGU + CV_MD + CV_RG;
__device__ __forceinline__ void cvt_job(const Ctx& c, int it, LAS float* scr, int lane) {
    const float* src; int ld, K; bf16* dst;
    if (it < CV_IN) { const int l = it / 768, r = it % 768, nt = CVT_KFAST ? ((r >> 3) % 48) : (r % 48), kt = CVT_KFAST ? (((r >> 3) / 48) * 8 + (r & 7)) : (r / 48), n0 = 64 * nt, k0 = 64 * kt, sc = n0 < 2048 ? n0 : n0 + 8;
        src = c.in[IN_W_IN] + (size_t)l * D * DIN + (size_t)k0 * DIN + sc; ld = DIN; K = D; dst = (bf16*)(c.ws + WS_WIN) + (size_t)l * NZ * D + (size_t)n0 * D + k0; }
    else if ((it -= CV_IN) < CV_OUT) { const int l = it / 256, r = it % 256, nt = CVT_KFAST ? ((r >> 3) % 16) : (r % 16), kt = CVT_KFAST ? (((r >> 3) / 16) * 8 + (r & 7)) : (r / 16), n0 = 64 * nt, k0 = 64 * kt;
        src = c.in[IN_W_OUT] + (size_t)l * D * D + (size_t)k0 * D + n0; ld = D; K = D; dst = (bf16*)(c.ws + WS_WOUT) + (size_t)l * D * D + (size_t)n0 * D + k0; }
    else if ((it -= CV_OUT) < CV_GU) { const int j = it / 1408, r = it % 1408, nt = CVT_KFAST ? ((r >> 3) % 88) : (r % 88), kt = CVT_KFAST ? (((r >> 3) / 88) * 8 + (r & 7)) : (r / 88), n0 = 64 * nt, k0 = 64 * kt, jj = n0 >> 8, cc = n0 & 255;
        src = (cc < 128 ? c.in[IN_FFN_WG] : c.in[IN_FFN_WU]) + (size_t)j * D * FFD + (size_t)k0 * FFD + jj * 128 + (cc & 127); ld = FFD; K = D;
        dst = (bf16*)(c.ws + WS_WGU) + (size_t)j * 2 * FFD * D + (size_t)n0 * D + k0; }
    else if ((it -= CV_GU) < CV_D) { const int j = it / 704, r = it % 704, nt = r % 16, kt = r / 16, n0 = 64 * nt, k0 = 64 * kt;
        src = c.in[IN_FFN_WD] + (size_t)j * FFD * D + (size_t)k0 * D + n0; ld = D; K = FFD; dst = (bf16*)(c.ws + WS_WD) + (size_t)j * D * FFD + (size_t)n0 * FFD + k0; }
    else if ((it -= CV_D) < CV_MGU) { const int je = it / 1792, r = it % 1792, nt = CVT_KFAST ? ((r >> 3) % 112) : (r % 112), kt = CVT_KFAST ? (((r >> 3) / 112) * 8 + (r & 7)) : (r / 112), n0 = 64 * nt, k0 = 64 * kt, jj = n0 >> 8, cc = n0 & 255;
        src = (cc < 128 ? c.in[IN_MOE_WG] : c.in[IN_MOE_WU]) + (size_t)je * D * FFE + (size_t)k0 * FFE + jj * 128 + (cc & 127); ld = FFE; K = D;
        dst = (bf16*)(c.ws + WS_MWGU) + (size_t)je * 2 * FFE * D + (size_t)n0 * D + k0; }
    else if ((it -= CV_MGU) < CV_MD) { const int je = it / 896, r = it % 896, nt = CVT_KFAST ? ((r >> 3) % 16) : (r % 16), kt = CVT_KFAST ? (((r >> 3) / 16) * 8 + (r & 7)) : (r / 16), n0 = 64 * nt, k0 = 64 * kt;
        src = c.in[IN_MOE_WD] + (size_t)je * FFE * D + (size_t)k0 * D + n0; ld = D; K = FFE; dst = (bf16*)(c.ws + WS_MWD) + (size_t)je * D * FFE + (size_t)n0 * FFE + k0; }
    else { it -= CV_MD; const int l = it >> 4, which = (it >> 3) & 1, g = it & 7;
        src = c.in[which ? IN_RG_W_X : IN_RG_W_A] + (size_t)(l * RGB + g) * RGD * RGD; ld = RGD; K = RGD; dst = (bf16*)(c.ws + WS_WRG) + (size_t)((l * 2 + which) * RGB + g) * RGD * RGD; }
    cvt_tile(src, ld, dst, K, scr, lane);
}
constexpr int CV_MGU0 = CV_IN + CV_OUT + CV_GU + CV_D, CV_MD0 = CV_MGU0 + CV_MGU;
constexpr int BG_MGU = 8 * 1792, BG_MD = 8 * 896, BG_TOTAL = BG_ON ? (BG_MGU + BG_MD) : 0;
__device__ __forceinline__ bool cvt_is_bg(int it) { return BG_ON && ((it >= CV_MGU0 + BG_MGU && it < CV_MD0) || (it >= CV_MD0 + BG_MD && it < CV_MD0 + CV_MD)); }
__device__ __forceinline__ void cvt_phase(const Ctx& c, LAS unsigned char* lds) {
    int tid_o = threadIdx.x; asm volatile("" : "+v"(tid_o));
    const int tid = tid_o, lane = tid & 63, wave = __builtin_amdgcn_readfirstlane(tid >> 6);
    LAS float* scr = (LAS float*)(lds + wave * 16640);
    const int gw = opaque_bid() * NWAVES + wave, NGW = gridDim.x * NWAVES;
    const int NFG = CV_TOTAL - BG_TOTAL;
    for (int f = gw; f < NFG; f += NGW) {
        int it = f;
        if (BG_ON) { if (it >= CV_MGU0 + BG_MGU) it += BG_MGU; if (it >= CV_MD0 + BG_MD) it += BG_MD; }
        cvt_job(c, it, scr, lane);
    }
}
__device__ __forceinline__ void bg_cvt(const Ctx& c, LAS unsigned char* lds, unsigned long long t_end) {
    if (!BG_ON) return;
    int tid_o = threadIdx.x; asm volatile("" : "+v"(tid_o));
    const int tid = tid_o, lane = tid & 63, wave = __builtin_amdgcn_readfirstlane(tid >> 6);
    LAS float* scr = (LAS float*)(lds + wave * 16640); unsigned* cur = (unsigned*)(c.ws + WS_CTL) + CW_BGCUR;
    for (;;) {
        if (__builtin_amdgcn_s_memrealtime() >= t_end) break;
        unsigned j = 0; if (lane == 0) j = __hip_atomic_fetch_add(cur, 1u, __ATOMIC_RELAXED, __HIP_MEMORY_SCOPE_AGENT);
        j = (unsigned)__builtin_amdgcn_readfirstlane((int)j);
        if (j >= (unsigned)BG_TOTAL) break;
        const int it = (int)j < BG_MGU ? CV_MGU0 + BG_MGU + (int)j : CV_MD0 + BG_MD + ((int)j - BG_MGU);
        cvt_job(c, it, scr, lane);
    }
}

__device__ __forceinline__ u32x4 sum_partials(const bf16* p) {
    float s[8] = {0.f, 0.f, 0.f, 0.f, 0.f, 0.f, 0.f, 0.f};
#pragma unroll
    for (int k = 0; k < MOE_TS; ++k) { const u32x4 q = *(const u32x4*)(p + (size_t)k * 8 * 256 * D);
        s[0] += bflo(q.x); s[1] += bfhi(q.x); s[2] += bflo(q.y); s[3] += bfhi(q.y); s[4] += bflo(q.z); s[5] += bfhi(q.z); s[6] += bflo(q.w); s[7] += bfhi(q.w); }
    u32x4 o; o.x = cvt_pk_bf16(s[0], s[1]); o.y = cvt_pk_bf16(s[2], s[3]); o.z = cvt_pk_bf16(s[4], s[5]); o.w = cvt_pk_bf16(s[6], s[7]); return o;
}
constexpr int W8S = 1028;
template <int MODE>
__device__ __forceinline__ void norm_phase(const Ctx& c, int l, bool combine, LAS unsigned char* lds) {
    int tid_o = threadIdx.x; asm volatile("" : "+v"(tid_o));
    const int tid = tid_o, lane = tid & 63, wave = __builtin_amdgcn_readfirstlane(tid >> 6);
    LAS float* w8 = (LAS float*)lds; LAS int* cnt = (LAS int*)(lds + 8 * W8S * 4);
    _Float16* h = (_Float16*)(c.ws + WS_H); bf16* xn = (bf16*)(c.ws + WS_XN); const bool from_x = (MODE == 1 && l == 0);
    const float* gain = MODE == 1 ? c.in[IN_NORM_MIX_G] + l * D : (MODE == 3 ? c.in[IN_NORM_FINAL_G] : c.in[IN_NORM_FFN_G] + l * D);
    if (MODE == 1 || MODE == 2) {
        const float* wsrc = MODE == 1 ? c.in[IN_W_IN] + (size_t)l * D * DIN + 2048 : c.in[IN_MOE_WR] + (size_t)(l >> 1) * D * NE; const int ldw = MODE == 1 ? DIN : NE;
        for (int i = tid; i < 8 * D; i += NTHR) { const int k = i >> 3, j = i & 7; w8[j * W8S + k] = wsrc[(size_t)k * ldw + j]; }
    }
    f32x8 gg[2];
#pragma unroll
    for (int j = 0; j < 2; ++j) gg[j] = *(const f32x8*)(gain + 8 * (lane + 64 * j));
    const int* pos = (const int*)(c.ws + WS_POS); const float* ew = (const float*)(c.ws + WS_EW); const bf16* Y = (const bf16*)(c.ws + WS_XG); const bf16* Y1 = (const bf16*)(c.ws + WS_Y1);
    for (int tb = opaque_bid(); tb < T / 64; tb += gridDim.x) {
        if (MODE == 2) { if (tid < 8) cnt[tid] = 0; }
        __syncthreads();
        for (int ib = 0; ib < 8; ib += 4) {
          f32x8 vb[4][2]; int pp0[4], pp1[4]; float ww0[4], ww1[4];
          if (from_x) {
#pragma unroll
              for (int r = 0; r < 4; ++r)
#pragma unroll
                  for (int j = 0; j < 2; ++j) vb[r][j] = *(const f32x8*)(c.in[IN_X] + (size_t)(tb * 64 + wave * 8 + ib + r) * D + 8 * (lane + 64 * j));
          } else { h16x8 hb[4][2];
#pragma unroll
              for (int r = 0; r < 4; ++r)
#pragma unroll
                  for (int j = 0; j < 2; ++j) hb[r][j] = *(const h16x8*)(h + (size_t)(tb * 64 + wave * 8 + ib + r) * D + 8 * (lane + 64 * j));
#pragma unroll
              for (int r = 0; r < 4; ++r)
#pragma unroll
                  for (int j = 0; j < 2; ++j) vb[r][j] = __builtin_convertvector(hb[r][j], f32x8);
          }
          if (combine) {
#pragma unroll
              for (int r = 0; r < 4; ++r) { const int t = tb * 64 + wave * 8 + ib + r; pp0[r] = pos[2 * t]; pp1[r] = pos[2 * t + 1]; ww0[r] = ew[2 * t]; ww1[r] = ew[2 * t + 1]; }
          }
#pragma unroll
          for (int r = 0; r < 4; ++r) {
            const int t = tb * 64 + wave * 8 + ib + r; f32x8 v[2]; v[0] = vb[r][0]; v[1] = vb[r][1];
            if (combine) {
                const int p0 = pp0[r], p1 = pp1[r]; const float w0 = ww0[r], w1 = ww1[r];
#pragma unroll
                for (int j = 0; j < 2; ++j) { const size_t o0 = (size_t)p0 * D + 8 * (lane + 64 * j), o1 = (size_t)p1 * D + 8 * (lane + 64 * j);
                    u32x4 a, b;
                    if (p0 < MOE_FULL * 256) a = *(const u32x4*)(Y + o0); else a = sum_partials(Y1 + o0 - (size_t)MOE_FULL * 256 * D);
                    if (p1 < MOE_FULL * 256) b = *(const u32x4*)(Y + o1); else b = sum_partials(Y1 + o1 - (size_t)MOE_FULL * 256 * D);
                    if (MOE_KS == 2) { const u32x4 a2 = *(const u32x4*)(Y1 + o0), b2 = *(const u32x4*)(Y1 + o1);
#pragma unroll
                        for (int q = 0; q < 4; ++q) { v[j][2 * q] += w0 * (bflo(a[q]) + bflo(a2[q])) + w1 * (bflo(b[q]) + bflo(b2[q])); v[j][2 * q + 1] += w0 * (bfhi(a[q]) + bfhi(a2[q])) + w1 * (bfhi(b[q]) + bfhi(b2[q])); }
                    } else {
#pragma unroll
                        for (int q = 0; q < 4; ++q) { v[j][2 * q] += w0 * bflo(a[q]) + w1 * bflo(b[q]); v[j][2 * q + 1] += w0 * bfhi(a[q]) + w1 * bfhi(b[q]); } } }
                if (MODE != 3) {
#pragma unroll
                    for (int j = 0; j < 2; ++j) *(h16x8*)(h + (size_t)t * D + 8 * (lane + 64 * j)) = __builtin_convertvector(v[j], h16x8); }
            }
            float s = 0.f;
#pragma unroll
            for (int j = 0; j < 2; ++j)
#pragma unroll
                for (int q = 0; q < 8; ++q) s += v[j][q] * v[j][q];
            const float rn = rsqrtf(wave_sum(s) * (1.f / D) + EPS);
#pragma unroll
            for (int j = 0; j < 2; ++j) v[j] = v[j] * rn * gg[j];
            if (MODE == 3) {
#pragma unroll
                for (int j = 0; j < 2; ++j) *(f32x8*)(c.out + (size_t)t * D + 8 * (lane + 64 * j)) = v[j];
            } else {
#pragma unroll
                for (int j = 0; j < 2; ++j) { u32x4 o; o.x = cvt_pk_bf16(v[j][0], v[j][1]); o.y = cvt_pk_bf16(v[j][2], v[j][3]); o.z = cvt_pk_bf16(v[j][4], v[j][5]); o.w = cvt_pk_bf16(v[j][6], v[j][7]);
                    *(u32x4*)(xn + (size_t)t * D + 8 * (lane + 64 * j)) = o; }
            }
            if (MODE == 1 || MODE == 2) {
                float d8[8];
#pragma unroll
                for (int g = 0; g < 8; ++g) { float a = 0.f;
#pragma unroll
                    for (int rp = 0; rp < DOTREP; ++rp) {
                    { f32x2 a2 = {0.f, 0.f};
#pragma unroll
                    for (int j = 0; j < 2; ++j) { const f32x4 wa = *(const LAS f32x4*)(w8 + g * W8S + 8 * (lane + 64 * j)), wb = *(const LAS f32x4*)(w8 + g * W8S + 8 * (lane + 64 * j) + 4);
                        a2 += (f32x2){v[j][0], v[j][1]} * (f32x2){wa[0], wa[1]}; a2 += (f32x2){v[j][2], v[j][3]} * (f32x2){wa[2], wa[3]};
                        a2 += (f32x2){v[j][4], v[j][5]} * (f32x2){wb[0], wb[1]}; a2 += (f32x2){v[j][6], v[j][7]} * (f32x2){wb[2], wb[3]}; }
                    a += a2[0] + a2[1]; }
                    if (DOTREP > 1) asm volatile("" : "+v"(a) :: "memory"); }
                    a *= (1.0f / DOTREP);
                    d8[g] = (MODE == 2) ? wave_sum(a) : a; }
                if (MODE == 1) {
                    float e4[4], e2[2];
#pragma unroll
                    for (int q = 0; q < 4; ++q) { const bool hi = (lane & 4) != 0; const float keep = hi ? d8[4 + q] : d8[q], send = hi ? d8[q] : d8[4 + q]; e4[q] = keep + __shfl_xor(send, 4); }
#pragma unroll
                    for (int q = 0; q < 2; ++q) { const bool hi = (lane & 2) != 0; const float keep = hi ? e4[2 + q] : e4[q], send = hi ? e4[q] : e4[2 + q]; e2[q] = keep + __shfl_xor(send, 2); }
                    float sel; { const bool hi = (lane & 1) != 0; const float keep = hi ? e2[1] : e2[0], send = hi ? e2[0] : e2[1]; sel = keep + __shfl_xor(send, 1); }
                    sel += __shfl_xor(sel, 8); sel += __shfl_xor(sel, 16); sel += __shfl_xor(sel, 32);
                    if (lane < 8) ((float*)(c.ws + WS_IFP))[(size_t)t * 8 + lane] = sel + c.in[IN_ML_B_IF][l * 8 + lane];
                } else {
                    int i0 = 0; float v0 = d8[0];
#pragma unroll
                    for (int e = 1; e < NE; ++e) if (d8[e] > v0) { v0 = d8[e]; i0 = e; }
                    int i1 = -1; float v1 = -3.4e38f;
#pragma unroll
                    for (int e = 0; e < NE; ++e) if (e != i0 && d8[e] > v1) { v1 = d8[e]; i1 = e; }
                    if (lane == 0) { int* eidx = (int*)(c.ws + WS_EIDX); float* eww = (float*)(c.ws + WS_EW); eidx[2 * t] = i0; eidx[2 * t + 1] = i1;
                        const float w0 = 1.f / (1.f + __expf(v1 - v0)); eww[2 * t] = w0; eww[2 * t + 1] = 1.f - w0;
                        __hip_atomic_fetch_add(&cnt[i0], 1, __ATOMIC_RELAXED, __HIP_MEMORY_SCOPE_WORKGROUP); __hip_atomic_fetch_add(&cnt[i1], 1, __ATOMIC_RELAXED, __HIP_MEMORY_SCOPE_WORKGROUP); }
                }
            }
        }
        }
        if (MODE == 2) { __syncthreads(); if (tid < 8) ((int*)(c.ws + WS_BLKCNT))[tb * 8 + tid] = cnt[tid]; }
    }
}

constexpr int RS_OFF = 131072, RS_MAXU = 24;
template <class Sched>
__device__ __forceinline__ void prep_rstd(const Sched& S, const float* SSQ, LAS unsigned char* lds) {
    int tid_o = threadIdx.x; asm volatile("" : "+v"(tid_o));
    const int tid = tid_o, r = tid >> 1, hf = tid & 1; LAS float* RS = (LAS float*)(lds + RS_OFF); pg8::Unit u;
    for (int i = 0; i < RS_MAXU && S.next(i, u); ++i) {
        const float* p = SSQ + (size_t)(u.pm * 256 + r) * 16 + 8 * hf; const f32x4 a = *(const f32x4*)p, b = *(const f32x4*)(p + 4);
        float s = ((a[0] + a[1]) + (a[2] + a[3])) + ((b[0] + b[1]) + (b[2] + b[3])); s += __shfl_xor(s, 1);
        if (hf == 0) RS[i * 256 + r] = rsqrtf(s * (1.f / D) + EPS);
    }
    __syncthreads();
}
__device__ __forceinline__ void gate_job(const Ctx& c, int l, LAS unsigned char* lds) {
    int tid_o = threadIdx.x; asm volatile("" : "+v"(tid_o));
    const int tid = tid_o, lane = tid & 63, wave = __builtin_amdgcn_readfirstlane(tid >> 6);
    LAS float* w8 = (LAS float*)lds; const bf16* xa = (const bf16*)(c.ws + WS_XN); const float* SSQ = (const float*)(c.ws + WS_SSQ);
    { const float* wsrc = c.in[IN_W_IN] + (size_t)l * D * DIN + 2048;
      for (int i = tid; i < 8 * D; i += NTHR) { const int k = i >> 3, j = i & 7; w8[j * W8S + k] = wsrc[(size_t)k * DIN + j]; } }
    for (int tb = opaque_bid(); tb < T / 64; tb += gridDim.x) {
        __syncthreads();
        for (int i = 0; i < 8; ++i) {
            const int t = tb * 64 + wave * 8 + i; f32x8 v[2];
#pragma unroll
            for (int j = 0; j < 2; ++j) { const u32x4 q = *(const u32x4*)(xa + (size_t)t * D + 8 * (lane + 64 * j));
                v[j][0] = bflo(q.x); v[j][1] = bfhi(q.x); v[j][2] = bflo(q.y); v[j][3] = bfhi(q.y); v[j][4] = bflo(q.z); v[j][5] = bfhi(q.z); v[j][6] = bflo(q.w); v[j][7] = bfhi(q.w); }
            const float sp = lane < 16 ? SSQ[(size_t)t * 16 + lane] : 0.f; const float r = rsqrtf(wave_sum(sp) * (1.f / D) + EPS);
            float d8[8];
#pragma unroll
            for (int g = 0; g < 8; ++g) { float a = 0.f;
#pragma unroll
                for (int j = 0; j < 2; ++j) { const f32x4 wa = *(const LAS f32x4*)(w8 + g * W8S + 8 * (lane + 64 * j)), wb = *(const LAS f32x4*)(w8 + g * W8S + 8 * (lane + 64 * j) + 4);
                    a += (v[j][0] * wa[0] + v[j][1] * wa[1]) + (v[j][2] * wa[2] + v[j][3] * wa[3]) + (v[j][4] * wb[0] + v[j][5] * wb[1]) + (v[j][6] * wb[2] + v[j][7] * wb[3]); }
                d8[g] = wave_sum(a); }
            float sel = d8[0];
#pragma unroll
            for (int g = 1; g < 8; ++g) sel = (lane == g) ? d8[g] : sel;
            if (lane < 8) ((float*)(c.ws + WS_IFP))[(size_t)t * 8 + lane] = sel * r + c.in[IN_ML_B_IF][l * 8 + lane];
        }
    }
}

__device__ __forceinline__ void moe_gather_phase(const Ctx& c, LAS unsigned char* lds) {
    int tid_o = threadIdx.x; asm volatile("" : "+v"(tid_o));
    const int tid = tid_o, lane = tid & 63, wave = __builtin_amdgcn_readfirstlane(tid >> 6);
    LAS int* tot = (LAS int*)lds; LAS int* bef = tot + 8; LAS int* off = tot + 16; LAS int* lpos = tot + 32;
    const int* blkcnt = (const int*)(c.ws + WS_BLKCNT); const int* eidx = (const int*)(c.ws + WS_EIDX); int* pos = (int*)(c.ws + WS_POS); int* meta = (int*)(c.ws + WS_META);
    const bf16* xn = (const bf16*)(c.ws + WS_XN); bf16* Xg = (bf16*)(c.ws + WS_XG);
    for (int tb = opaque_bid(); tb < T / 64; tb += gridDim.x) {
        __syncthreads();
        if (tid < 16) tot[tid] = 0;
        __syncthreads();
        { const int e = tid & 7, part = tid >> 3; int st = 0, sb = 0;
#pragma unroll
          for (int q = 0; q < 4; ++q) { const int b = part * 4 + q; const int v = blkcnt[b * 8 + e]; st += v; sb += (b < tb) ? v : 0; }
          __hip_atomic_fetch_add(&tot[e], st, __ATOMIC_RELAXED, __HIP_MEMORY_SCOPE_WORKGROUP); __hip_atomic_fetch_add(&bef[e], sb, __ATOMIC_RELAXED, __HIP_MEMORY_SCOPE_WORKGROUP); }
        __syncthreads();
        if (tid == 0) { int o = 0; for (int e = 0; e < NE; ++e) { off[e] = o; o += (tot[e] + 255) & ~255; } off[NE] = o; }
        __syncthreads();
        if (wave == 0) {
            const int t = tb * 64 + lane; const int e0 = eidx[2 * t], e1 = eidx[2 * t + 1]; int r0 = 0, r1 = 0; const unsigned long long lt = (1ull << lane) - 1ull;
#pragma unroll
            for (int e = 0; e < NE; ++e) { const unsigned long long m0 = __ballot(e0 == e), m1 = __ballot(e1 == e);
                if (e0 == e) r0 = __popcll(m0 & lt); if (e1 == e) r1 = __popcll(m0) + __popcll(m1 & lt); }
            const int p0 = off[e0] + bef[e0] + r0, p1 = off[e1] + bef[e1] + r1;
            pos[2 * t] = p0; pos[2 * t + 1] = p1; lpos[2 * lane] = p0; lpos[2 * lane + 1] = p1;
        }
        __syncthreads();
        for (int q0 = wave; q0 < 128; q0 += 4 * NWAVES) { u32x4 ra[4], rb[4]; int pq[4];
#pragma unroll
            for (int r = 0; r < 4; ++r) { const int q = q0 + r * NWAVES; const u32x4* s = (const u32x4*)(xn + (size_t)(tb * 64 + (q >> 1)) * D); ra[r] = s[lane]; rb[r] = s[lane + 64]; pq[r] = lpos[q]; }
#pragma unroll
            for (int r = 0; r < 4; ++r) { u32x4* d = (u32x4*)(Xg + (size_t)pq[r] * D); d[lane] = ra[r]; d[lane + 64] = rb[r]; } }
        if (tb < NE) { const int r0 = off[tb] + tot[tb], r1 = off[tb + 1]; const u32x4 zz = {0u, 0u, 0u, 0u};
            for (int r = r0 + wave; r < r1; r += NWAVES) { u32x4* d = (u32x4*)(Xg + (size_t)r * D); d[lane] = zz; d[lane + 64] = zz; } }
        if (tb == 0) { if (tid < 9) meta[tid] = off[tid]; if (tid == 0) meta[16] = off[NE] >> 8;
            for (int tl = tid; tl < MAXT256; tl += NTHR) { const int r = tl * 256; int e = 0;
#pragma unroll
                for (int q = 0; q < NE; ++q) if (r >= off[q]) e = q;
                meta[32 + tl] = e; } }
    }
}


typedef short s16x4 __attribute__((ext_vector_type(4)));
#ifndef REP_MASK
#define REP_MASK 0
#endif
constexpr size_t SM_CG = WS_SMALL, SM_CM = WS_SMALL + 4096, SM_MP = WS_SMALL + 8192;
constexpr size_t SM_NL = WS_SMALL + 65536, SM_NP = WS_SMALL + 327680;
constexpr size_t SM_RGA = WS_SMALL + 589824, SM_RGH = WS_SMALL + 1114112;
constexpr size_t SM_RGC = 5 * MiB;
constexpr int TROW = 272;
constexpr int TILE_B = 128 * TROW;
constexpr float KSC = 0.08838834764831845f;

__device__ __forceinline__ float wscan_add(float v, int lane) {
#pragma unroll
    for (int o = 1; o < 64; o <<= 1) { const float t = __shfl_up(v, o); v = (lane >= o) ? v + t : v; }
    return v;
}
__device__ __forceinline__ float wscan_max(float v, int lane) {
#pragma unroll
    for (int o = 1; o < 64; o <<= 1) { const float t = __shfl_up(v, o); v = (lane >= o) ? fmaxf(v, t) : v; }
    return v;
}
__device__ __forceinline__ float wave_max(float v) {
#pragma unroll
    for (int o = 1; o < 64; o <<= 1) v = fmaxf(v, __shfl_xor(v, o));
    return v;
}
__device__ __forceinline__ float logsigmoidf_(float x) { return -log1pf(__expf(-x)); }
__device__ __forceinline__ void stage_tile(const bf16* __restrict__ g, int ldg, LAS unsigned char* tile, int tid) {
#pragma unroll
    for (int i = 0; i < 4; ++i) { const int ch = tid + NTHR * i, r = ch >> 4, c16 = ch & 15; const u32x4 v = *(const u32x4*)(g + (size_t)r * ldg + c16 * 8); *(LAS u32x4*)(tile + r * TROW + c16 * 16) = v; }
}
__device__ __forceinline__ bf16x8 frag_row(const LAS unsigned char* tile, int row, int ks, int fq) { return *(const LAS bf16x8*)(tile + row * TROW + (32 * ks + 8 * fq) * 2); }
__device__ __forceinline__ bf16x8 frag_tr(const LAS unsigned char* tile, int n0, int ks, int lane) {
    const int i16 = lane & 15, q = i16 >> 2, p = i16 & 3, fq = lane >> 4;
    const LAS unsigned char* a = tile + (32 * ks + 8 * fq + q) * TROW + n0 * 2 + 8 * p;
    const s16x4 lo = __builtin_amdgcn_ds_read_tr16_b64_v4i16((LAS s16x4*)a), hi = __builtin_amdgcn_ds_read_tr16_b64_v4i16((LAS s16x4*)(a + 4 * TROW));
    return __builtin_shufflevector(lo, hi, 0, 1, 2, 3, 4, 5, 6, 7);
}
#define MFMA16(a, b, c) __builtin_amdgcn_mfma_f32_16x16x32_bf16((a), (b), (c), 0, 0, 0)

constexpr int CGRP_B = 73728;
__device__ __forceinline__ void mix_c_mlstm(const Ctx& c, int u, LAS unsigned char* lds, int tid, int lane, int wave) {
    const int bh = u >> 5, ck = u & 31, b = bh >> 2, h = bh & 3; const size_t t0 = (size_t)b * SEQ + (size_t)ck * 128;
    LAS unsigned char* TKW = lds; LAS unsigned char* TV = lds + TILE_B; LAS float* fw = (LAS float*)(lds + 2 * TILE_B); LAS float* np = fw + 128;
    const float* ifp = (const float*)(c.ws + WS_IFP); const bf16* z = (const bf16*)(c.ws + WS_Z);
    u32x4 kv[8], vv[8];
#pragma unroll
    for (int i = 0; i < 8; ++i) { const int ch = tid + 256 * i, r = ch >> 4, c16 = ch & 15; const bf16* row = z + (t0 + r) * NZ + h * DH + c16 * 8; kv[i] = *(const u32x4*)(row + ZK); vv[i] = *(const u32x4*)(row + ZV); }
    if (wave == 0) {
        const float x0 = ifp[(t0 + 2 * lane) * 8 + 4 + h], x1 = ifp[(t0 + 2 * lane + 1) * 8 + 4 + h];
        const float li0 = ifp[(t0 + 2 * lane) * 8 + h], li1 = ifp[(t0 + 2 * lane + 1) * 8 + h];
        const float lf0 = logsigmoidf_(x0), lf1 = logsigmoidf_(x1), s = lf0 + lf1, inc = wscan_add(s, lane), ex = inc - s, b0 = ex + lf0, b1 = b0 + lf1;
        const float g = __shfl(inc, 63);
        const float a0 = g - b0 + li0, a1 = g - b1 + li1, m = wave_max(fmaxf(a0, a1));
        fw[2 * lane] = __expf(a0 - m) * KSC; fw[2 * lane + 1] = __expf(a1 - m) * KSC;
        if (lane == 0) { ((float*)(c.ws + SM_CG))[bh * 32 + ck] = g; ((float*)(c.ws + SM_CM))[bh * 32 + ck] = m; }
    }
    __syncthreads();
#pragma unroll
    for (int i = 0; i < 8; ++i) { const int ch = tid + 256 * i, r = ch >> 4, c16 = ch & 15; const float sc = fw[r]; u32x4 ko;
        ko.x = cvt_pk_bf16(bflo(kv[i].x) * sc, bfhi(kv[i].x) * sc); ko.y = cvt_pk_bf16(bflo(kv[i].y) * sc, bfhi(kv[i].y) * sc); ko.z = cvt_pk_bf16(bflo(kv[i].z) * sc, bfhi(kv[i].z) * sc); ko.w = cvt_pk_bf16(bflo(kv[i].w) * sc, bfhi(kv[i].w) * sc);
        *(LAS u32x4*)(TKW + r * TROW + c16 * 16) = ko; *(LAS u32x4*)(TV + r * TROW + c16 * 16) = vv[i]; }
    __syncthreads();
    { const int d = tid & 127, q = tid >> 7; float s = 0.f;
#pragma unroll 16
      for (int l = 64 * q; l < 64 * q + 64; ++l) s += bf2f(*(const LAS bf16*)(TKW + l * TROW + d * 2));
      np[q * 128 + d] = s; }
    const int wr = wave >> 1, wc = wave & 1, fr = lane & 15, fq = lane >> 4;
    f32x4 acc[4][4];
#pragma unroll
    for (int i = 0; i < 4; ++i)
#pragma unroll
        for (int j = 0; j < 4; ++j) acc[i][j] = (f32x4){0.f, 0.f, 0.f, 0.f};
#pragma unroll
    for (int ks = 0; ks < 4; ++ks) { bf16x8 A[4], B[4];
#pragma unroll
        for (int dt = 0; dt < 4; ++dt) A[dt] = frag_tr(TKW, 64 * wr + 16 * dt, ks, lane);
#pragma unroll
        for (int et = 0; et < 4; ++et) B[et] = frag_tr(TV, 64 * wc + 16 * et, ks, lane);
#pragma unroll
        for (int dt = 0; dt < 4; ++dt)
#pragma unroll
            for (int et = 0; et < 4; ++et) acc[dt][et] = MFMA16(A[dt], B[et], acc[dt][et]); }
    bf16* CTL = (bf16*)(c.ws + WS_CTL_LOC) + ((size_t)(bh * 32 + ck) << 14);
#pragma unroll
    for (int dt = 0; dt < 4; ++dt)
#pragma unroll
        for (int et = 0; et < 4; ++et) { u32x2 o; o.x = cvt_pk_bf16_c(acc[dt][et][0], acc[dt][et][1]); o.y = cvt_pk_bf16_c(acc[dt][et][2], acc[dt][et][3]);
            *(u32x2*)(CTL + (size_t)(64 * wc + 16 * et + fr) * 128 + 64 * wr + 16 * dt + 4 * fq) = o; }
    __syncthreads();
    if (tid < 128) ((float*)(c.ws + SM_NL))[(size_t)(bh * 32 + ck) * 128 + tid] = np[tid] + np[128 + tid];
    __syncthreads();
}

__device__ __forceinline__ float fsig(float x) { return __builtin_amdgcn_rcpf(1.f + __expf(-x)); }
__device__ __forceinline__ void mix_c_rg(const Ctx& c, int l, int u, LAS unsigned char* lds, int lane, int wave) {
    const int b = u >> 6, ck = u & 63, g = wave; const size_t t0 = (size_t)b * SEQ + (size_t)ck * 64;
    LAS unsigned char* XC = lds + wave * 9216;
    const bf16* z = (const bf16*)(c.ws + WS_Z); const int l15 = lane & 15, fq = lane >> 4;
    {
        const int c4 = 64 * g + 4 * l15; const float* cw = c.in[IN_CONV_W] + l * 4 * RGW + c4; const f32x4 w0 = *(const f32x4*)cw, w1 = *(const f32x4*)(cw + RGW), w2 = *(const f32x4*)(cw + 2 * RGW), w3 = *(const f32x4*)(cw + 3 * RGW), cb = *(const f32x4*)(c.in[IN_CONV_B] + l * RGW + c4);
        u32x2 xr[19];
#pragma unroll
        for (int j = 0; j < 19; ++j) { const int tt = 16 * fq - 3 + j; const bool okk = (ck * 64 + tt >= 0); const u32x2 v = *(const u32x2*)(z + (size_t)((long)t0 + (okk ? tt : 0)) * NZ + ZRX + c4); xr[j].x = okk ? v.x : 0u; xr[j].y = okk ? v.y : 0u; }
#pragma unroll
        for (int j = 0; j < 16; ++j) { f32x4 xc;
            xc[0] = cb[0] + w0[0] * bflo(xr[j].x) + w1[0] * bflo(xr[j + 1].x) + w2[0] * bflo(xr[j + 2].x) + w3[0] * bflo(xr[j + 3].x);
            xc[1] = cb[1] + w0[1] * bfhi(xr[j].x) + w1[1] * bfhi(xr[j + 1].x) + w2[1] * bfhi(xr[j + 2].x) + w3[1] * bfhi(xr[j + 3].x);
            xc[2] = cb[2] + w0[2] * bflo(xr[j].y) + w1[2] * bflo(xr[j + 1].y) + w2[2] * bflo(xr[j + 2].y) + w3[2] * bflo(xr[j + 3].y);
            xc[3] = cb[3] + w0[3] * bfhi(xr[j].y) + w1[3] * bfhi(xr[j + 1].y) + w2[3] * bfhi(xr[j + 2].y) + w3[3] * bfhi(xr[j + 3].y);
            u32x2 o; o.x = cvt_pk_bf16(xc[0], xc[1]); o.y = cvt_pk_bf16(xc[2], xc[3]); *(LAS u32x2*)(XC + (16 * fq + j) * 144 + l15 * 8) = o; }
    }
    bf16x8 Af[4][2];
#pragma unroll
    for (int m = 0; m < 4; ++m)
#pragma unroll
        for (int ks = 0; ks < 2; ++ks) Af[m][ks] = *(const LAS bf16x8*)(XC + (16 * m + l15) * 144 + (32 * ks + 8 * fq) * 2);
    const bf16* WTa = (const bf16*)(c.ws + WS_WRG) + (size_t)((l * 2 + 0) * RGB + g) * RGD * RGD; const bf16* WTx = (const bf16*)(c.ws + WS_WRG) + (size_t)((l * 2 + 1) * RGB + g) * RGD * RGD;
    unsigned* RP = (unsigned*)(c.ws + WS_RA);
#pragma unroll
    for (int n = 0; n < 4; ++n) {
        const int jo = 16 * n + l15, cc = 64 * g + jo;
        f32x4 aa[4], ax[4];
#pragma unroll
        for (int m = 0; m < 4; ++m) { aa[m] = (f32x4){0.f, 0.f, 0.f, 0.f}; ax[m] = (f32x4){0.f, 0.f, 0.f, 0.f}; }
#pragma unroll
        for (int ks = 0; ks < 2; ++ks) { const bf16x8 Ba = *(const bf16x8*)(WTa + jo * RGD + 32 * ks + 8 * fq), Bx = *(const bf16x8*)(WTx + jo * RGD + 32 * ks + 8 * fq);
#pragma unroll
            for (int m = 0; m < 4; ++m) { aa[m] = MFMA16(Af[m][ks], Ba, aa[m]); ax[m] = MFMA16(Af[m][ks], Bx, ax[m]); } }
        const float ba = c.in[IN_RG_B_A][l * RGW + cc], bx = c.in[IN_RG_B_X][l * RGW + cc], sp8 = -8.f * __logf(1.f + __expf(-c.in[IN_RG_LAM][l * RGW + cc]));
        float cA[4][4], hL[4][4], SA[4], SH[4];
#pragma unroll
        for (int m = 0; m < 4; ++m) { float Ar = 1.f, Hr = 0.f;
#pragma unroll
            for (int r = 0; r < 4; ++r) { const int t = 16 * m + 4 * fq + r;
                const float la = sp8 * fsig(aa[m][r] + ba), a = __expf(la), ig = fsig(ax[m][r] + bx), xcv = bf2f(*(const LAS bf16*)(XC + t * 144 + jo * 2));
                const float tt = -2.f * la, ser = tt * (1.f - tt * (0.5f - tt * (0.16666667f - tt * (0.041666668f - tt * 0.0083333333f)))), om = tt < 0.25f ? ser : 1.f - a * a;
                const float uu = __builtin_amdgcn_sqrtf(om) * (ig * xcv);
                Hr = a * Hr + uu; Ar *= a; cA[m][r] = Ar; hL[m][r] = Hr; }
            SA[m] = Ar; SH[m] = Hr; }
        float CA = 1.f, CH = 0.f; unsigned* rp = RP + (t0 + 4 * fq) * RGW + cc;
#pragma unroll
        for (int m = 0; m < 4; ++m) {
            float IA = SA[m], IH = SH[m];
            { const float Ap = __shfl_up(IA, 16), Hp = __shfl_up(IH, 16); if (fq >= 1) { IH = IA * Hp + IH; IA = IA * Ap; } }
            { const float Ap = __shfl_up(IA, 32), Hp = __shfl_up(IH, 32); if (fq >= 2) { IH = IA * Hp + IH; IA = IA * Ap; } }
            float EA = __shfl_up(IA, 16), EH = __shfl_up(IH, 16); if (fq == 0) { EA = 1.f; EH = 0.f; }
            const float TA = __shfl(IA, l15 + 48), TH = __shfl(IH, l15 + 48);
            const float PA = CA * EA, PH = EA * CH + EH;
#pragma unroll
            for (int r = 0; r < 4; ++r) rp[(size_t)(16 * m + r) * RGW] = cvt_pk_bf16(PA * cA[m][r], hL[m][r] + cA[m][r] * PH);
            CH = TA * CH + TH; CA = CA * TA;
        }
        if (fq == 0) { ((float*)(c.ws + SM_RGA))[(size_t)(b * 64 + ck) * RGW + cc] = CA; ((float*)(c.ws + SM_RGH))[(size_t)(b * 64 + ck) * RGW + cc] = CH; }
    }
}

__device__ __forceinline__ void mix_d(const Ctx& c, LAS unsigned char* lds, int tid, int lane, int wave) {
    for (int w = opaque_bid(); w < 256; w += gridDim.x) {
        const int bh = w >> 4, sl = w & 15; LAS float* sg = (LAS float*)lds; LAS float* sm = sg + 32;
        __syncthreads();
        if (tid < 32) { sg[tid] = ((const float*)(c.ws + SM_CG))[bh * 32 + tid]; sm[tid] = ((const float*)(c.ws + SM_CM))[bh * 32 + tid]; }
        __syncthreads();
        const int idx = tid * 2, el = idx >> 7, d = idx & 127; const size_t off = (size_t)(8 * sl + el) * 128 + d;
        const bf16* CTL = (const bf16*)(c.ws + WS_CTL_LOC) + ((size_t)(bh * 32) << 14) + off; bf16* CTP = (bf16*)(c.ws + WS_CTP) + ((size_t)(bh * 32) << 14) + off;
        const bool nown = (sl == 0 && tid < 128);
        const float* NL = (const float*)(c.ws + SM_NL) + (size_t)(bh * 32) * 128 + (tid & 127); float* NP = (float*)(c.ws + SM_NP) + (size_t)(bh * 32) * 128 + (tid & 127);
        unsigned ldw[32]; float nl[32];
#pragma unroll
        for (int ck = 0; ck < 32; ++ck) { ldw[ck] = *(const unsigned*)(CTL + ((size_t)ck << 14)); nl[ck] = nown ? NL[ck * 128] : 0.f; }
        f32x2 st = {0.f, 0.f}; float nst = 0.f, m = 0.f;
#pragma unroll
        for (int ck = 0; ck < 32; ++ck) {
            *(unsigned*)(CTP + ((size_t)ck << 14)) = cvt_pk_bf16(st.x, st.y);
            if (nown) NP[ck * 128] = nst;
            if (sl == 0 && tid == 0) ((float*)(c.ws + SM_MP))[bh * 32 + ck] = m;
            const float g = sg[ck], ml = sm[ck], mn = fmaxf(g + m, ml), so = __expf(g + m - mn), sc = __expf(ml - mn);
            st.x = st.x * so + bflo(ldw[ck]) * sc; st.y = st.y * so + bfhi(ldw[ck]) * sc; nst = nst * so + nl[ck] * sc; m = mn;
        }
    }
    for (int gw = opaque_bid() * NWAVES + wave; gw < BATCH * RGW; gw += gridDim.x * NWAVES) {
        const int b = gw >> 9, ch = gw & 511; const size_t o = (size_t)(b * 64 + lane) * RGW + ch;
        float A = ((const float*)(c.ws + SM_RGA))[o], H = ((const float*)(c.ws + SM_RGH))[o];
#pragma unroll
        for (int s = 1; s < 64; s <<= 1) { const float Ap = __shfl_up(A, s), Hp = __shfl_up(H, s); if (lane >= s) { H = A * Hp + H; A = A * Ap; } }
        float cin = __shfl_up(H, 1); if (lane == 0) cin = 0.f;
        ((float*)(c.ws + SM_RGC))[o] = cin;
    }
}

__device__ __forceinline__ void mix_e_mlstm(const Ctx& c, int l, int u, LAS unsigned char* lds, int tid, int lane, int wave) {
    const int bh = u >> 5, ck = u & 31, b = bh >> 2, h = bh & 3; const size_t t0 = (size_t)b * SEQ + (size_t)ck * 128;
    LAS unsigned char* TQ = lds; LAS unsigned char* TK = lds + TILE_B; LAS unsigned char* TV = lds + 2 * TILE_B; LAS unsigned char* TC = lds + 3 * TILE_B; LAS unsigned char* TS = TK;
    LAS float* fb = (LAS float*)(lds + 4 * TILE_B); LAS float* fcs = fb + 128; LAS float* fpm = fb + 256; LAS float* fisc = fb + 384; LAS float* fqn = fb + 512; LAS float* fnp = fb + 640;
    LAS float* pden = fb + 768; LAS float* pss = fb + 1280;
    const float* ifp = (const float*)(c.ws + WS_IFP); const bf16* z = (const bf16*)(c.ws + WS_Z);
    u32x4 sq[4], sk[4], sv[4], scp[4];
    { const bf16* cp = (const bf16*)(c.ws + WS_CTP) + ((size_t)(bh * 32 + ck) << 14);
#pragma unroll
      for (int i = 0; i < 4; ++i) { const int ch = tid + NTHR * i, r = ch >> 4, c16 = ch & 15; const bf16* row = z + (t0 + r) * NZ + h * DH + c16 * 8;
          sq[i] = *(const u32x4*)(row + ZQ); sk[i] = *(const u32x4*)(row + ZK); sv[i] = *(const u32x4*)(row + ZV); scp[i] = *(const u32x4*)(cp + (size_t)r * 128 + c16 * 8); } }
    const float npv = (tid < 128) ? ((const float*)(c.ws + SM_NP))[(size_t)(bh * 32 + ck) * 128 + tid] : 0.f;
    if (wave == 0) {
        const float x0 = ifp[(t0 + 2 * lane) * 8 + 4 + h], x1 = ifp[(t0 + 2 * lane + 1) * 8 + 4 + h];
        const float lf0 = logsigmoidf_(x0), lf1 = logsigmoidf_(x1), s = lf0 + lf1, inc = wscan_add(s, lane), ex = inc - s, b0 = ex + lf0, b1 = b0 + lf1;
        const float li0 = ifp[(t0 + 2 * lane) * 8 + h], li1 = ifp[(t0 + 2 * lane + 1) * 8 + h];
        const float cs0 = li0 - b0, cs1 = li1 - b1, p1 = fmaxf(cs0, cs1), incm = wscan_max(p1, lane);
        float exm = __shfl_up(incm, 1); if (lane == 0) exm = -3.0e38f;
        const float mp = ((const float*)(c.ws + SM_MP))[bh * 32 + ck];
        const float pm0 = fmaxf(fmaxf(exm, cs0), mp), pm1 = fmaxf(fmaxf(exm, p1), mp);
        fb[2 * lane] = b0; fb[2 * lane + 1] = b1; fcs[2 * lane] = cs0; fcs[2 * lane + 1] = cs1; fpm[2 * lane] = pm0; fpm[2 * lane + 1] = pm1;
        fisc[2 * lane] = __expf(mp - pm0); fisc[2 * lane + 1] = __expf(mp - pm1);
    }
#pragma unroll
    for (int i = 0; i < 4; ++i) { const int ch = tid + NTHR * i, r = ch >> 4, c16 = ch & 15; const int o = r * TROW + c16 * 16;
        *(LAS u32x4*)(TQ + o) = sq[i]; *(LAS u32x4*)(TK + o) = sk[i]; *(LAS u32x4*)(TV + o) = sv[i]; *(LAS u32x4*)(TC + o) = scp[i]; }
    if (tid < 128) fnp[tid] = npv;
    __syncthreads();
    { const int row = tid >> 2, qt = tid & 3; float s = 0.f;
#pragma unroll
      for (int i = 0; i < 4; ++i) { const u32x4 qv = *(const LAS u32x4*)(TQ + row * TROW + (32 * qt + 8 * i) * 2); const LAS float* nn = fnp + 32 * qt + 8 * i;
          s += bflo(qv.x) * nn[0] + bfhi(qv.x) * nn[1] + bflo(qv.y) * nn[2] + bfhi(qv.y) * nn[3] + bflo(qv.z) * nn[4] + bfhi(qv.z) * nn[5] + bflo(qv.w) * nn[6] + bfhi(qv.w) * nn[7]; }
      s += __shfl_xor(s, 1); s += __shfl_xor(s, 2); if (qt == 0) fqn[row] = s; }
    const int wr = wave >> 2, wc = wave & 3, fr = lane & 15, fq = lane >> 4;
    f32x4 aS[4][2];
#pragma unroll
    for (int i = 0; i < 4; ++i)
#pragma unroll
        for (int j = 0; j < 2; ++j) aS[i][j] = (f32x4){0.f, 0.f, 0.f, 0.f};
#pragma unroll
    for (int ks = 0; ks < 4; ++ks) { bf16x8 A[4], B[2];
#pragma unroll
        for (int m = 0; m < 4; ++m) A[m] = frag_row(TQ, 64 * wr + 16 * m + fr, ks, fq);
#pragma unroll
        for (int n = 0; n < 2; ++n) B[n] = frag_row(TK, 32 * wc + 16 * n + fr, ks, fq);
#pragma unroll
        for (int m = 0; m < 4; ++m)
#pragma unroll
            for (int n = 0; n < 2; ++n) aS[m][n] = MFMA16(B[n], A[m], aS[m][n]); }
    __syncthreads();
#pragma unroll
    for (int m = 0; m < 4; ++m) { const int lr = 64 * wr + 16 * m + fr; const float pm = fpm[lr]; float ds = 0.f;
#pragma unroll
        for (int n = 0; n < 2; ++n) { const int s0 = 32 * wc + 16 * n + 4 * fq; float v[4];
#pragma unroll
            for (int j = 0; j < 4; ++j) { const int s = s0 + j; const float wgt = (s <= lr) ? __expf(fcs[s] - pm) : 0.f; v[j] = aS[m][n][j] * wgt * KSC; ds += v[j]; }
            u32x2 o; o.x = cvt_pk_bf16(v[0], v[1]); o.y = cvt_pk_bf16(v[2], v[3]); *(LAS u32x2*)(TS + lr * TROW + s0 * 2) = o; }
        ds += __shfl_xor(ds, 16); ds += __shfl_xor(ds, 32); if (fq == 0) pden[lr * 4 + wc] = ds; }
    __syncthreads();
    f32x4 a1[4][2], a2[4][2];
#pragma unroll
    for (int i = 0; i < 4; ++i)
#pragma unroll
        for (int j = 0; j < 2; ++j) { a1[i][j] = (f32x4){0.f, 0.f, 0.f, 0.f}; a2[i][j] = (f32x4){0.f, 0.f, 0.f, 0.f}; }
#pragma unroll
    for (int ks = 0; ks < 4; ++ks) { bf16x8 A[4], B[2];
#pragma unroll
        for (int m = 0; m < 4; ++m) A[m] = frag_row(TS, 64 * wr + 16 * m + fr, ks, fq);
#pragma unroll
        for (int n = 0; n < 2; ++n) B[n] = frag_tr(TV, 32 * wc + 16 * n, ks, lane);
#pragma unroll
        for (int m = 0; m < 4; ++m)
#pragma unroll
            for (int n = 0; n < 2; ++n) a1[m][n] = MFMA16(B[n], A[m], a1[m][n]); }
#pragma unroll
    for (int ks = 0; ks < 4; ++ks) { bf16x8 A[4], B[2];
#pragma unroll
        for (int m = 0; m < 4; ++m) A[m] = frag_row(TQ, 64 * wr + 16 * m + fr, ks, fq);
#pragma unroll
        for (int n = 0; n < 2; ++n) B[n] = frag_row(TC, 32 * wc + 16 * n + fr, ks, fq);
#pragma unroll
        for (int m = 0; m < 4; ++m)
#pragma unroll
            for (int n = 0; n < 2; ++n) a2[m][n] = MFMA16(B[n], A[m], a2[m][n]); }
#pragma unroll
    for (int m = 0; m < 4; ++m) { const int lr = 64 * wr + 16 * m + fr; const float isc = fisc[lr];
        const float den = (pden[lr * 4] + pden[lr * 4 + 1]) + (pden[lr * 4 + 2] + pden[lr * 4 + 3]) + isc * fqn[lr];
        const float inv = 1.f / fmaxf(fabsf(den), __expf(-(fb[lr] + fpm[lr]))); float ss = 0.f;
#pragma unroll
        for (int n = 0; n < 2; ++n) { a1[m][n] = (a1[m][n] + a2[m][n] * isc) * inv; ss += (a1[m][n][0] * a1[m][n][0] + a1[m][n][1] * a1[m][n][1]) + (a1[m][n][2] * a1[m][n][2] + a1[m][n][3] * a1[m][n][3]); }
        ss += __shfl_xor(ss, 16); ss += __shfl_xor(ss, 32); if (fq == 0) pss[lr * 4 + wc] = ss; }
    __syncthreads();
    const float* gn = c.in[IN_ML_NORM_G] + l * MLW + h * DH; bf16* Y = (bf16*)(c.ws + WS_Y);
#pragma unroll
    for (int m = 0; m < 4; ++m) { const int lr = 64 * wr + 16 * m + fr; const float rstd = rsqrtf(((pss[lr * 4] + pss[lr * 4 + 1]) + (pss[lr * 4 + 2] + pss[lr * 4 + 3])) * (1.f / DH) + EPS);
#pragma unroll
        for (int n = 0; n < 2; ++n) { const int e0 = 32 * wc + 16 * n + 4 * fq; const u32x2 ov = *(const u32x2*)(z + (t0 + lr) * NZ + ZO + h * DH + e0); const f32x4 gv = *(const f32x4*)(gn + e0);
            const float y0 = sigmoidf_(bflo(ov.x)) * a1[m][n][0] * rstd * gv[0], y1 = sigmoidf_(bfhi(ov.x)) * a1[m][n][1] * rstd * gv[1];
            const float y2 = sigmoidf_(bflo(ov.y)) * a1[m][n][2] * rstd * gv[2], y3 = sigmoidf_(bfhi(ov.y)) * a1[m][n][3] * rstd * gv[3];
            u32x2 o; o.x = cvt_pk_bf16(y0, y1); o.y = cvt_pk_bf16(y2, y3); *(u32x2*)(Y + (t0 + lr) * D + h * DH + e0) = o; } }
    __syncthreads();
}

__device__ __forceinline__ void mix_e_rg(const Ctx& c, int l, int u, int lane, int wave) {
    const int b = u >> 6, ck = u & 63; const size_t t0 = (size_t)b * SEQ + (size_t)ck * 64;
    const unsigned* RP = (const unsigned*)(c.ws + WS_RA); const bf16* z = (const bf16*)(c.ws + WS_Z); bf16* Y = (bf16*)(c.ws + WS_Y);
    const float* cinp = (const float*)(c.ws + SM_RGC) + (size_t)(b * 64 + ck) * RGW + 8 * lane; const float* gp = c.in[IN_RG_NORM_G] + l * RGW + 8 * lane;
    const f32x4 ci0 = *(const f32x4*)cinp, ci1 = *(const f32x4*)(cinp + 4), g0 = *(const f32x4*)gp, g1 = *(const f32x4*)(gp + 4);
    u32x4 pa[8], pb[8], rgv[8];
#pragma unroll
    for (int i = 0; i < 8; ++i) { const size_t t = t0 + wave * 8 + i; pa[i] = *(const u32x4*)(RP + t * RGW + 8 * lane); pb[i] = *(const u32x4*)(RP + t * RGW + 8 * lane + 4); rgv[i] = *(const u32x4*)(z + t * NZ + ZRG + 8 * lane); }
#pragma unroll
    for (int i = 0; i < 8; ++i) { const size_t t = t0 + wave * 8 + i;
        const u32x4 p0 = pa[i], p1 = pb[i], rg = rgv[i];
        const f32x4 h0 = {bfhi(p0.x), bfhi(p0.y), bfhi(p0.z), bfhi(p0.w)}, h1 = {bfhi(p1.x), bfhi(p1.y), bfhi(p1.z), bfhi(p1.w)}, c0 = {bflo(p0.x), bflo(p0.y), bflo(p0.z), bflo(p0.w)}, c1 = {bflo(p1.x), bflo(p1.y), bflo(p1.z), bflo(p1.w)};
        const float gt[8] = {bflo(rg.x), bfhi(rg.x), bflo(rg.y), bfhi(rg.y), bflo(rg.z), bfhi(rg.z), bflo(rg.w), bfhi(rg.w)};
        const f32x4 hh0 = h0 + c0 * ci0, hh1 = h1 + c1 * ci1; float v[8]; float s = 0.f;
#pragma unroll
        for (int j = 0; j < 8; ++j) { const float x = gt[j], uu = 1.5957691216057308f * (x + 0.044715f * x * x * x), ge = x * __builtin_amdgcn_rcpf(1.f + __expf(-uu)); v[j] = (j < 4 ? hh0[j] : hh1[j - 4]) * ge; s += v[j] * v[j]; }
        const float r = rsqrtf(wave_sum(s) * (1.f / RGW) + EPS);
        u32x4 o; o.x = cvt_pk_bf16(v[0] * r * g0[0], v[1] * r * g0[1]); o.y = cvt_pk_bf16(v[2] * r * g0[2], v[3] * r * g0[3]); o.z = cvt_pk_bf16(v[4] * r * g1[0], v[5] * r * g1[1]); o.w = cvt_pk_bf16(v[6] * r * g1[2], v[7] * r * g1[3]);
        *(u32x4*)(Y + t * D + MLW + 8 * lane) = o; }
}
__device__ __forceinline__ void mix_c_phase(const Ctx& c, int l, LAS unsigned char* lds) {
    int tid_o = threadIdx.x; asm volatile("" : "+v"(tid_o)); const int tid = tid_o, lane = tid & 63, wave = __builtin_amdgcn_readfirstlane(tid >> 6);
    for (int rq = 0; rq < (((REP_MASK) >> 16) & 1 ? 2 : 1); ++rq) for (int w = opaque_bid(); w < 256; w += gridDim.x) mix_c_mlstm(c, 2 * w + (wave >> 2), lds + (wave >> 2) * CGRP_B, tid & 255, lane, wave & 3);
    for (int rq = 0; rq < (((REP_MASK) >> 17) & 1 ? 2 : 1); ++rq) for (int u = opaque_bid(); u < 256; u += gridDim.x) { mix_c_rg(c, l, u, lds, lane, wave); __syncthreads(); }
}
__device__ __forceinline__ void mix_d_phase(const Ctx& c, LAS unsigned char* lds) {
    int tid_o = threadIdx.x; asm volatile("" : "+v"(tid_o)); const int tid = tid_o, lane = tid & 63, wave = __builtin_amdgcn_readfirstlane(tid >> 6);
    mix_d(c, lds, tid, lane, wave);
}
__device__ __forceinline__ void mix_e_phase(const Ctx& c, int l, LAS unsigned char* lds) {
    int tid_o = threadIdx.x; asm volatile("" : "+v"(tid_o)); const int tid = tid_o, lane = tid & 63, wave = __builtin_amdgcn_readfirstlane(tid >> 6);
    for (int rq = 0; rq < (((REP_MASK) >> 18) & 1 ? 2 : 1); ++rq) for (int u = opaque_bid(); u < 512; u += gridDim.x) mix_e_mlstm(c, l, u, lds, tid, lane, wave);
    for (int rq = 0; rq < (((REP_MASK) >> 19) & 1 ? 2 : 1); ++rq) for (int u = opaque_bid(); u < 256; u += gridDim.x) mix_e_rg(c, l, u, lane, wave);
}
#ifndef TAILH
#define TAILH 1
#endif
#ifndef MOE_MERGE
#define MOE_MERGE 0
#endif
#ifndef FOLD
#define FOLD 0
#endif
#ifndef SP2_E
#define SP2_E true
#endif
#ifndef ALIGN_E
#define ALIGN_E true
#endif
#ifndef STAG
#define STAG 0
#endif
#ifndef NULL_EPI
#define NULL_EPI 0
#endif
#ifndef REP_MASK
#define REP_MASK 0
#endif
#ifndef ONE_LAUNCH
#define ONE_LAUNCH 1
#endif
__device__ __forceinline__ void load_texp_lds(const int* meta, LAS unsigned char* lds) {
    int t = threadIdx.x; asm volatile("" : "+v"(t));
    LAS int* tl = (LAS int*)(lds + RS_OFF); if (t < MAXT256) tl[t] = meta[32 + t]; __syncthreads();
}
__global__ void __launch_bounds__(NTHR, 2) mega(Ctx c) {
    extern __shared__ __attribute__((aligned(16))) unsigned char lds_raw[];
    LAS unsigned char* lds = (LAS unsigned char*)lds_raw;
    const int tid = threadIdx.x;
    if (tid < 64) ((LAS unsigned*)(lds + MISC_OFF))[tid] = 0u;
    __syncthreads();
    XcdBarrier bar; bar.bar = (unsigned*)(c.ws + WS_CTL) + CW_BAR; bar.x = 0; bar.st = (volatile LAS unsigned*)(lds + MISC_OFF + 32);
    if (c.s_hi - c.s_lo > 1) bar = xcd_barrier_post((unsigned*)(c.ws + WS_CTL) + CW_BAR, (volatile LAS unsigned*)(lds + MISC_OFF + 32));
#define BG_TAIL(S, unit_us) do { if (BG_ON) { const int nmax_ = (S.nwg + S.G - 1) / S.G, nc_ = S.c < S.nwg ? (S.nwg - S.c + S.G - 1) / S.G : 0; \
        if (nc_ < nmax_) bg_cvt(c, lds, t_ph + (unsigned long long)((nmax_ * (unit_us) * 92) - 300)); } } while (0)
#define STEP_ON(s) (c.s_lo <= (s) && (s) < c.s_hi)
#define REPN(id) ((((REP_MASK) >> (id)) & 1) ? 2 : 1)
#define RP(id) for (int rr = 0; rr < REPN(id); ++rr)
#define SEAM(s) do { if ((s) + 1 < c.s_hi) { RP(15) xcd_barrier(bar); } } while (0)
    if (STEP_ON(0)) { RP(0) cvt_phase(c, lds); SEAM(0); }
    for (int l = 0; l < DEPTH; ++l) {
        const int s0 = 1 + 10 * l; const bool moe = (l & 1) != 0; const int jl = l >> 1;
        if (s0 + 9 < c.s_lo || s0 >= c.s_hi) continue;
        const bool fold_in = FOLD && moe;
        if (!fold_in && STEP_ON(s0 + 0)) { RP(1) norm_phase<1>(c, l, l == 2 && rr == 0, lds); SEAM(s0 + 0); }
        if (STEP_ON(s0 + 1)) {
            pg8::Gemm g{(const bf16*)(c.ws + WS_XN), (const bf16*)(c.ws + WS_WIN) + (size_t)l * NZ * D, T, NZ, D, D, STAG}; pg8::StaticOrder S; S.init(T, NZ, gridDim.x, opaque_bid());
            if (fold_in) prep_rstd(S, (const float*)(c.ws + WS_SSQ), lds);
            RP(2) { if (fold_in) { pg8::EpiBf16T<true> E{(bf16*)(c.ws + WS_Z), NZ, 0, (const LAS float*)(lds + RS_OFF)}; pg8::gemm_phase<pg8::EpiBf16T<true>, pg8::StaticOrder, ALIGN_E, SP2_E>(lds, g, S, E); }
                    else { pg8::EpiBf16 E{(bf16*)(c.ws + WS_Z), NZ, 0, nullptr}; pg8::gemm_phase<pg8::EpiBf16, pg8::StaticOrder, ALIGN_E, SP2_E>(lds, g, S, E); } }
            if (fold_in) { RP(1) gate_job(c, l, lds); } SEAM(s0 + 1); }
        if (STEP_ON(s0 + 2)) { RP(3) mix_c_phase(c, l, lds); SEAM(s0 + 2); }
        if (STEP_ON(s0 + 3)) { RP(4) mix_d_phase(c, lds); SEAM(s0 + 3); }
        if (STEP_ON(s0 + 4)) { RP(5) mix_e_phase(c, l, lds); SEAM(s0 + 4); }
        if (STEP_ON(s0 + 5)) {
            pg8::Gemm g{(const bf16*)(c.ws + WS_Y), (const bf16*)(c.ws + WS_WOUT) + (size_t)l * D * D, T, D, D, D, 0}; pg8::StaticOrder S; S.init(T, D, gridDim.x, opaque_bid());
            RP(6) { const bool fo = FOLD && !moe && !rr;
            if (FOLD && fo) { pg8::EpiResF16T<FOLD != 0> E{(l == 0 && !rr) ? c.in[IN_X] : nullptr, (_Float16*)(c.ws + WS_H), D, (bf16*)(c.ws + WS_XN), c.in[IN_NORM_FFN_G] + l * D, (float*)(c.ws + WS_SSQ)}; pg8::gemm_phase<pg8::EpiResF16T<FOLD != 0>, pg8::StaticOrder, ALIGN_E, SP2_E>(lds, g, S, E); }
            else { pg8::EpiResF16 E{(l == 0 && !rr) ? c.in[IN_X] : nullptr, rr ? (_Float16*)(c.ws + WS_SCR) : (_Float16*)(c.ws + WS_H), D, nullptr, nullptr, nullptr}; pg8::gemm_phase<pg8::EpiResF16, pg8::StaticOrder, ALIGN_E, SP2_E>(lds, g, S, E); } } SEAM(s0 + 5); }
        if (!moe) {
            if (!FOLD && STEP_ON(s0 + 6)) { RP(7) norm_phase<0>(c, l, false, lds); SEAM(s0 + 6); }
            if (STEP_ON(s0 + 7)) {
                pg8::Gemm g{(const bf16*)(c.ws + WS_XN), (const bf16*)(c.ws + WS_WGU) + (size_t)jl * 2 * FFD * D, T, 2 * FFD, D, D, STAG}; pg8::StaticOrder S; S.init(T, 2 * FFD, gridDim.x, opaque_bid());
                if (FOLD) prep_rstd(S, (const float*)(c.ws + WS_SSQ), lds);
                pg8::EpiSwigluT<FOLD != 0> E{(bf16*)(c.ws + WS_HID), FFD, (const LAS float*)(lds + RS_OFF)};
                const int Lw = TAILH ? (S.nwg / S.G) * S.G : S.nwg; S.L1 = Lw;
                RP(8) pg8::gemm_phase<pg8::EpiSwigluT<FOLD != 0>, pg8::StaticOrder, ALIGN_E, SP2_E>(lds, g, S, E);
                if (TAILH && Lw < S.nwg) { pg8::StaticOrder S2 = S; S2.L0 = Lw; S2.L1 = S.nwg; S2.halves = 1;
                    pg8::EpiSwigluT<false, false, true> E2{(bf16*)(c.ws + WS_HID), FFD, nullptr, 0};
                    pg8::gemm_phase<pg8::EpiSwigluT<false, false, true>, pg8::StaticOrder, ALIGN_E, SP2_E, true>(lds, g, S2, E2); }
                SEAM(s0 + 7); }
            if (STEP_ON(s0 + 8)) {
                pg8::Gemm g{(const bf16*)(c.ws + WS_HID), (const bf16*)(c.ws + WS_WD) + (size_t)jl * D * FFD, T, D, FFD, FFD, 0}; pg8::StaticOrder S; S.init(T, D, gridDim.x, opaque_bid());
                RP(9) { const bool fo = FOLD && !rr;
                if (FOLD && fo) { pg8::EpiResF16T<FOLD != 0> E{nullptr, (_Float16*)(c.ws + WS_H), D, (bf16*)(c.ws + WS_XN), c.in[IN_NORM_MIX_G] + (l + 1) * D, (float*)(c.ws + WS_SSQ)}; pg8::gemm_phase<pg8::EpiResF16T<FOLD != 0>, pg8::StaticOrder, ALIGN_E, SP2_E>(lds, g, S, E); }
                else { pg8::EpiResF16 E{nullptr, rr ? (_Float16*)(c.ws + WS_SCR) : (_Float16*)(c.ws + WS_H), D, nullptr, nullptr, nullptr}; pg8::gemm_phase<pg8::EpiResF16, pg8::StaticOrder, ALIGN_E, SP2_E>(lds, g, S, E); } } SEAM(s0 + 8); }
        } else {
            if (STEP_ON(s0 + 6)) { RP(7) norm_phase<2>(c, l, false, lds); SEAM(s0 + 6); }
            if (STEP_ON(s0 + 7)) { RP(10) moe_gather_phase(c, lds); if (l == 3) { __syncthreads(); bg_cvt(c, lds, ~0ull); } SEAM(s0 + 7); }
#if MOE_MERGE
            if (STEP_ON(s0 + 8)) {
                const int* meta = (const int*)(c.ws + WS_META); const int nM = __builtin_amdgcn_readfirstlane(meta[16]);
                unsigned* ctl = (unsigned*)(c.ws + WS_CTL); unsigned* pcnt = ctl + CW_MOECNT + jl * MAXT256 * 64;
                load_texp_lds(meta, lds);
                const int G = gridDim.x, cb = opaque_bid();
                { pg8::Gemm g{(const bf16*)(c.ws + WS_XG), (const bf16*)(c.ws + WS_MWGU) + (size_t)jl * NE * 2 * FFE * D, nM * 256, 2 * FFE, D, D, 0};
                  pg8::MoeOrderPub S; S.init(nM, 2 * FFE, 1, G, cb, (const LAS int*)(lds + RS_OFF)); S.cnt = pcnt; S.prev_pm = -1;
                  pg8::EpiSwigluT<false, true> E{(bf16*)(c.ws + WS_MHID), FFE, nullptr, (int)((size_t)MAXROWS * FFE * 2)};
                  pg8::gemm_phase<pg8::EpiSwigluT<false, true>, pg8::MoeOrderPub, ALIGN_E, SP2_E>(lds, g, S, E); S.flush(); }
                { const int nwg_gu = nM * (2 * FFE / 256), ex = nwg_gu % G, exr = (ex + 7) & ~7; const int c2 = (cb - exr + 2 * G) % G;
                  pg8::Gemm g{(const bf16*)(c.ws + WS_MHID), (const bf16*)(c.ws + WS_MWD) + (size_t)jl * NE * D * FFE, nM * 256, D, FFE / MOE_KS, FFE, 0};
                  pg8::MoeOrderWait S; S.init(nM, D, MOE_KS, G, c2, (const LAS int*)(lds + RS_OFF)); S.cnt = pcnt; S.need = (unsigned)(2 * FFE / 256) * 8u; S.tmo = ctl;
                  pg8::EpiBf16 E{(bf16*)(c.ws + WS_XG), D, (size_t)(WS_Y1 - WS_XG) / 2, nullptr};
                  pg8::gemm_phase<pg8::EpiBf16, pg8::MoeOrderWait, ALIGN_E, SP2_E>(lds, g, S, E); }
                SEAM(s0 + 9); }
#else
            if (STEP_ON(s0 + 8)) {
                const int* meta = (const int*)(c.ws + WS_META); const int nM = __builtin_amdgcn_readfirstlane(meta[16]);
                load_texp_lds(meta, lds);
                pg8::Gemm g{(const bf16*)(c.ws + WS_XG), (const bf16*)(c.ws + WS_MWGU) + (size_t)jl * NE * 2 * FFE * D, nM * 256, 2 * FFE, D, D, 0}; pg8::MoeOrder S; S.init(nM, 2 * FFE, 1, gridDim.x, opaque_bid(), (const LAS int*)(lds + RS_OFF));
                pg8::EpiSwiglu E{(bf16*)(c.ws + WS_MHID), FFE, nullptr, 0};
                const int Lw = TAILH ? (S.nwg / S.G) * S.G : S.nwg; S.L1 = Lw;
                RP(11) pg8::gemm_phase<pg8::EpiSwiglu, pg8::MoeOrder, ALIGN_E, SP2_E>(lds, g, S, E);
                if (TAILH && Lw < S.nwg) { pg8::MoeOrder S2 = S; S2.L0 = Lw; S2.L1 = S.nwg; S2.halves = 1;
                    pg8::EpiSwigluT<false, false, true> E2{(bf16*)(c.ws + WS_MHID), FFE, nullptr, 0};
                    pg8::gemm_phase<pg8::EpiSwigluT<false, false, true>, pg8::MoeOrder, ALIGN_E, SP2_E, true>(lds, g, S2, E2); }
                SEAM(s0 + 8); }
            if (STEP_ON(s0 + 9)) {
                const int* meta = (const int*)(c.ws + WS_META); const int nM = __builtin_amdgcn_readfirstlane(meta[16]);
                load_texp_lds(meta, lds);
                const int nFull = nM < MOE_FULL ? nM : MOE_FULL;
                {
                    pg8::Gemm g{(const bf16*)(c.ws + WS_MHID), (const bf16*)(c.ws + WS_MWD) + (size_t)jl * NE * D * FFE, nFull * 256, D, FFE, FFE, 0}; pg8::MoeOrder S; S.init(nFull, D, 1, gridDim.x, opaque_bid(), (const LAS int*)(lds + RS_OFF));
                    pg8::EpiBf16 E{(bf16*)(c.ws + WS_XG), D, 0, nullptr};
                    RP(12) pg8::gemm_phase<pg8::EpiBf16, pg8::MoeOrder, ALIGN_E, SP2_E>(lds, g, S, E); }
                if (nM > MOE_FULL) {
                    pg8::Gemm g{(const bf16*)(c.ws + WS_MHID), (const bf16*)(c.ws + WS_MWD) + (size_t)jl * NE * D * FFE, (nM - MOE_FULL) * 256, D, FFE / MOE_TS, FFE, 0}; pg8::MoeOrder S; S.init(nM - MOE_FULL, D, MOE_TS, gridDim.x, opaque_bid(), (const LAS int*)(lds + RS_OFF)); S.pm0 = MOE_FULL;
                    pg8::EpiBf16 E{(bf16*)(c.ws + WS_Y1) - (size_t)MOE_FULL * 256 * D, D, (size_t)8 * 256 * D, nullptr};
                    pg8::gemm_phase<pg8::EpiBf16, pg8::MoeOrder, ALIGN_E, SP2_E>(lds, g, S, E); }
                SEAM(s0 + 9); }
#endif
        }
    }
    if (STEP_ON(41)) { RP(13) norm_phase<3>(c, 0, true, lds); }
}

namespace nv {
__global__ __launch_bounds__(256) void mlstm_rec(const bf16* __restrict__ z, const float* __restrict__ ifp, float* __restrict__ ht) {
    const int wave = (blockIdx.x * 256 + threadIdx.x) >> 6, lane = threadIdx.x & 63;
    const int bh = wave >> 5, es = wave & 31, b = bh >> 2, h = bh & 3, e0 = es * 4;
    float C[2][4] = {}, n[2] = {0.f, 0.f};
    const float ksc = 0.08838834764831845f;
    for (int t0 = 0; t0 < SEQ; t0 += 8) {
        float kk[8][2], qq[8][2], vv[8][4], ii[8], ff[8];
#pragma unroll
        for (int j = 0; j < 8; ++j) { const size_t t = (size_t)(b * SEQ + t0 + j); const bf16* row = z + t * NZ;
            kk[j][0] = bf2f(row[ZK + h * DH + lane]) * ksc; kk[j][1] = bf2f(row[ZK + h * DH + lane + 64]) * ksc; qq[j][0] = bf2f(row[ZQ + h * DH + lane]); qq[j][1] = bf2f(row[ZQ + h * DH + lane + 64]);
#pragma unroll
            for (int e = 0; e < 4; ++e) vv[j][e] = bf2f(row[ZV + h * DH + e0 + e]);
            ii[j] = __expf(ifp[t * 8 + h]); ff[j] = sigmoidf_(ifp[t * 8 + 4 + h]); }
#pragma unroll
        for (int j = 0; j < 8; ++j) { float s[5] = {0.f, 0.f, 0.f, 0.f, 0.f};
#pragma unroll
            for (int d = 0; d < 2; ++d) { n[d] = ff[j] * n[d] + ii[j] * kk[j][d]; s[4] += n[d] * qq[j][d];
#pragma unroll
                for (int e = 0; e < 4; ++e) { C[d][e] = ff[j] * C[d][e] + ii[j] * kk[j][d] * vv[j][e]; s[e] += C[d][e] * qq[j][d]; } }
#pragma unroll
            for (int e = 0; e < 5; ++e) s[e] = wave_sum(s[e]);
            const float den = fmaxf(fabsf(s[4]), 1.f);
            if (lane == 0) { float* o = ht + (size_t)(b * SEQ + t0 + j) * MLW + h * DH + e0; o[0] = s[0] / den; o[1] = s[1] / den; o[2] = s[2] / den; o[3] = s[3] / den; } }
    }
}
__global__ __launch_bounds__(256) void ml_out(const bf16* __restrict__ z, const float* __restrict__ ht, const float* __restrict__ g, bf16* __restrict__ y) {
    const int w = (blockIdx.x * 256 + threadIdx.x) >> 6, lane = threadIdx.x & 63, t = w >> 2, h = w & 3;
    const float a = ht[(size_t)t * MLW + h * DH + lane], b = ht[(size_t)t * MLW + h * DH + lane + 64];
    const float r = rsqrtf(wave_sum(a * a + b * b) * (1.f / DH) + EPS);
    const float oa = bf2f(z[(size_t)t * NZ + ZO + h * DH + lane]), ob = bf2f(z[(size_t)t * NZ + ZO + h * DH + lane + 64]);
    y[(size_t)t * D + h * DH + lane] = f2bf(sigmoidf_(oa) * a * r * g[h * DH + lane]); y[(size_t)t * D + h * DH + lane + 64] = f2bf(sigmoidf_(ob) * b * r * g[h * DH + lane + 64]);
}
__global__ __launch_bounds__(512) void rg_gates(const bf16* __restrict__ z, const float* __restrict__ cw, const float* __restrict__ cb, const float* __restrict__ wa, const float* __restrict__ ba,
                                                const float* __restrict__ wx, const float* __restrict__ bx, const float* __restrict__ lam, float* __restrict__ av, float* __restrict__ uv) {
    __shared__ float xs[RGW]; const int t = blockIdx.x, c = threadIdx.x, tl = t % SEQ;
    float xc = cb[c];
#pragma unroll
    for (int j = 0; j < 4; ++j) { const int tt = tl - 3 + j; if (tt >= 0) xc += cw[j * RGW + c] * bf2f(z[(size_t)(t - 3 + j) * NZ + ZRX + c]); }
    xs[c] = xc; __syncthreads();
    const int g = c >> 6, jj = c & 63; float ra = ba[c], rx = bx[c];
    for (int i = 0; i < RGD; ++i) { const float xv = xs[g * RGD + i]; ra += xv * wa[(g * RGD + i) * RGD + jj]; rx += xv * wx[(g * RGD + i) * RGD + jj]; }
    const float r = sigmoidf_(ra), ig = sigmoidf_(rx);
    const float sp = log1pf(__expf(-lam[c])); const float la = -8.f * r * sp;
    av[(size_t)t * RGW + c] = __expf(la); uv[(size_t)t * RGW + c] = sqrtf(-expm1f(2.f * la)) * (ig * xc);
}
__global__ __launch_bounds__(256) void rg_scan(const float* __restrict__ av, float* __restrict__ uv) {
    const int id = blockIdx.x * 256 + threadIdx.x, b = id / RGW, c = id % RGW; float h = 0.f;
    for (int t0 = 0; t0 < SEQ; t0 += 8) { float a[8], u[8];
#pragma unroll
        for (int j = 0; j < 8; ++j) { a[j] = av[(size_t)(b * SEQ + t0 + j) * RGW + c]; u[j] = uv[(size_t)(b * SEQ + t0 + j) * RGW + c]; }
#pragma unroll
        for (int j = 0; j < 8; ++j) { h = a[j] * h + u[j]; uv[(size_t)(b * SEQ + t0 + j) * RGW + c] = h; } }
}
__global__ __launch_bounds__(256) void rg_out(const bf16* __restrict__ z, const float* __restrict__ hr, const float* __restrict__ g, bf16* __restrict__ y) {
    const int t = (blockIdx.x * 256 + threadIdx.x) >> 6, lane = threadIdx.x & 63; float v[8]; float s = 0.f;
#pragma unroll
    for (int j = 0; j < 8; ++j) { const int c = lane + 64 * j; v[j] = hr[(size_t)t * RGW + c] * gelu_tanh(bf2f(z[(size_t)t * NZ + ZRG + c])); s += v[j] * v[j]; }
    const float r = rsqrtf(wave_sum(s) * (1.f / RGW) + EPS);
#pragma unroll
    for (int j = 0; j < 8; ++j) { const int c = lane + 64 * j; y[(size_t)t * D + MLW + c] = f2bf(v[j] * r * g[c]); }
}
}

extern "C" void kernel_launch(void* const* d_in, const int* in_sizes, int n_in, void* d_out, int out_size, void* d_ws, size_t ws_size, hipStream_t stream) {
    static int ok = 0; static int grid_g = 256;
    if (ok == 0) {
        if (n_in != 23 || ws_size < WS_END || out_size != T * D) { fprintf(stderr, "kernel_launch: unexpected shapes (n_in %d, ws %zu, out %d)\n", n_in, ws_size, out_size); ok = -1; return; }
        if (hipFuncSetAttribute((const void*)mega, hipFuncAttributeMaxDynamicSharedMemorySize, LDS_BYTES) != hipSuccess) { fprintf(stderr, "kernel_launch: hipFuncSetAttribute failed\n"); ok = -1; return; }
        int dev = 0, cus = 0, per_cu = 0; (void)hipGetDevice(&dev); (void)hipDeviceGetAttribute(&cus, hipDeviceAttributeMultiprocessorCount, dev);
        if (hipOccupancyMaxActiveBlocksPerMultiprocessor(&per_cu, (const void*)mega, NTHR, LDS_BYTES) != hipSuccess || per_cu < 1) { fprintf(stderr, "kernel_launch: occupancy query says %d blocks per CU\n", per_cu); (void)hipGetLastError(); }
        grid_g = cus > 0 ? cus : 256;
        ok = 1;
    }
    if (ok < 0) return;
    unsigned char* ws = (unsigned char*)d_ws;
    (void)hipMemsetAsync(ws + WS_CTL, 0, MOE_MERGE ? (size_t)(1 * MiB) : (size_t)(CW_BAR + XCD_BAR_WORDS) * 4, stream);
    Ctx base{}; for (int i = 0; i < 23; ++i) base.in[i] = (const float*)d_in[i]; base.out = (float*)d_out; base.ws = ws;
    auto run = [&](int lo, int hi) { Ctx a = base; a.s_lo = lo; a.s_hi = hi; hipLaunchKernelGGL(mega, dim3(grid_g), dim3(NTHR), LDS_BYTES, stream, a); };
    const bf16* z = (const bf16*)(ws + WS_Z); bf16* y = (bf16*)(ws + WS_Y); const float* ifp = (const float*)(ws + WS_IFP);
    float* ht = (float*)(ws + WS_CTL_LOC); float* ra = (float*)(ws + WS_RA); float* ru = (float*)(ws + WS_RU);
#if ONE_LAUNCH
    run(0, 42);
#else
    run(0, 1);
    for (int l = 0; l < DEPTH; ++l) {
        const int s0 = 1 + 10 * l;
        run(s0, s0 + 1); run(s0 + 1, s0 + 2);
#if MIX_FAST
        run(s0 + 2, s0 + 3); run(s0 + 3, s0 + 4); run(s0 + 4, s0 + 5);
#endif
#if !MIX_FAST || NV_ML
        nv::mlstm_rec<<<128, 256, 0, stream>>>(z, ifp, ht);
        nv::ml_out<<<T, 256, 0, stream>>>(z, ht, (const float*)d_in[IN_ML_NORM_G] + l * MLW, y);
#endif
#if !MIX_FAST || NV_RG
        nv::rg_gates<<<T, 512, 0, stream>>>(z, (const float*)d_in[IN_CONV_W] + l * 4 * RGW, (const float*)d_in[IN_CONV_B] + l * RGW, (const float*)d_in[IN_RG_W_A] + (size_t)l * RGB * RGD * RGD,
                                            (const float*)d_in[IN_RG_B_A] + l * RGW, (const float*)d_in[IN_RG_W_X] + (size_t)l * RGB * RGD * RGD, (const float*)d_in[IN_RG_B_X] + l * RGW, (const float*)d_in[IN_RG_LAM] + l * RGW, ra, ru);
        nv::rg_scan<<<BATCH * RGW / 256, 256, 0, stream>>>(ra, ru);
        nv::rg_out<<<T / 4, 256, 0, stream>>>(z, ru, (const float*)d_in[IN_RG_NORM_G] + l * RGW, y);
#endif
        run(s0 + 5, s0 + 6); run(s0 + 6, s0 + 7); run(s0 + 7, s0 + 8); run(s0 + 8, s0 + 9);
        if (l & 1) run(s0 + 9, s0 + 10);
    }
    run(41, 42);
#endif
}
```

```cpp
#include <hip/hip_runtime.h>
#include <cstdio>
#include <cstdint>

constexpr int D = 1024, BATCH = 4, SEQ = 4096, T = BATCH * SEQ, DEPTH = 4;
constexpr int MLW = 512, MLH = 4, DH = 128, RGW = 512, RGB = 8, RGD = 64;
constexpr int DIN = 3080, FFD = 2816, NE = 8, FFE = 3584;
constexpr int NZ = 3072;
constexpr int ZQ = 0, ZK = 512, ZV = 1024, ZO = 1536, ZRX = 2048, ZRG = 2560;
constexpr float EPS = 1e-6f;
constexpr int MAXROWS = 2 * T + NE * 256;
constexpr int MAXT256 = MAXROWS / 256;
constexpr int NWAVES = 8, NTHR = 512;

#define LAS __attribute__((address_space(3)))
#define GAS __attribute__((address_space(1)))
typedef unsigned short bf16;
typedef float f32x4 __attribute__((ext_vector_type(4)));
typedef float f32x2 __attribute__((ext_vector_type(2)));
typedef unsigned u32x4 __attribute__((ext_vector_type(4)));
typedef unsigned u32x2 __attribute__((ext_vector_type(2)));
typedef short bf16x8 __attribute__((ext_vector_type(8)));
typedef _Float16 h16x8 __attribute__((ext_vector_type(8)));
typedef float f32x8 __attribute__((ext_vector_type(8)));

__device__ __forceinline__ float wave_sum(float v) {
#pragma unroll
    for (int o = 1; o < 64; o <<= 1) v += __shfl_xor(v, o);
    return v;
}
__device__ __forceinline__ float sigmoidf_(float x) { return 1.f / (1.f + __expf(-x)); }
__device__ __forceinline__ float gelu_tanh(float x) { const float u = 0.7978845608028654f * (x + 0.044715f * x * x * x); return 0.5f * x * (1.f + tanhf(u)); }
__device__ __forceinline__ unsigned cvt_pk_bf16(float lo, float hi) { unsigned r; asm volatile("v_cvt_pk_bf16_f32 %0, %1, %2" : "=v"(r) : "v"(lo), "v"(hi)); return r; }
typedef __bf16 bf16x2_t __attribute__((ext_vector_type(2)));
__device__ __forceinline__ unsigned cvt_pk_bf16_c(float lo, float hi) { const bf16x2_t r = __builtin_convertvector((f32x2){lo, hi}, bf16x2_t); return __builtin_bit_cast(unsigned, r); }
__device__ __forceinline__ float bf2f(unsigned short b) { return __uint_as_float(((unsigned)b) << 16); }
__device__ __forceinline__ float bflo(unsigned w) { return __uint_as_float(w << 16); }
__device__ __forceinline__ float bfhi(unsigned w) { return __uint_as_float(w & 0xffff0000u); }
__device__ __forceinline__ bf16 f2bf(float f) { return (bf16)(cvt_pk_bf16(f, 0.f) & 0xffffu); }

#ifndef WGM_E
#define WGM_E 8
#endif
namespace pg8 {
#define PG8_LAS __attribute__((address_space(3)))
typedef unsigned short bf16_t;
constexpr int BM = 256, BK = 64, HALF = 128, HTB = HALF * BK * 2  , STAGE_BYTES = 8 * HTB, NXCD = 8, WGM = WGM_E;
__host__ __device__ __forceinline__ int lds_byte(int r, int c) { const int st = (r >> 4) * 2 + (c >> 5), rr = r & 15, cc = c & 31, ob = rr * 64 + cc * 2; return st * 1024 + (ob ^ (((ob >> 9) & 1) << 5)); }
__host__ __device__ __forceinline__ void stage_rc(int b, int& R, int& C) { const int st = b / 1024, sb = b % 1024, swz = sb ^ (((sb >> 9) & 1) << 5); R = (st >> 1) * 16 + swz / 64; C = (st & 1) * 32 + (swz % 64) / 2; }
__host__ __device__ __forceinline__ int perm32(int rho) { const int n = rho >> 4, i = rho & 15; return 8 * (i >> 2) + 4 * n + (i & 3); }

struct Unit { int pm, pn, pb, kz, ord, hf; };
struct Gemm { const bf16_t* A; const bf16_t* Bt; int M, N, K, ld, stag; };

struct StaticOrder {
    int nM, nN, nwg, G, c;
    __host__ __device__ void init(int M, int N, int G_, int c_) { nM = M / BM; nN = N / BM; nwg = nM * nN; G = G_; c = c_; }
    int L0 = 0, L1 = 0x7fffffff, halves = 0;
    __host__ __device__ bool next(int i, Unit& u) const {
        long L = (long)i * G + c; int hf = 0; if (halves) { hf = (int)(L & 1); L >>= 1; } L += L0; if (L >= nwg || L >= L1) return false; u.hf = hf;
        int wgid = (int)L; { const int q = nwg / NXCD, r = nwg % NXCD, xcd = wgid % NXCD, off = wgid / NXCD; wgid = (xcd < r ? xcd * (q + 1) : r * (q + 1) + (xcd - r) * q) + off; }
        const int nig = WGM * nN, gid = wgid / nig, fm = gid * WGM, gsz = (nM - fm) < WGM ? (nM - fm) : WGM;
        u.pm = fm + ((wgid % nig) % gsz); u.pn = (wgid % nig) / gsz; u.pb = u.pn; u.kz = 0; u.ord = i; return true;
    }
    __device__ __forceinline__ void a_ready(const Unit&) const {}
    __device__ __forceinline__ void done(const Unit&) const {}
};
struct MoeOrder {
    int nM, nN, nNo, KS, nwg, G, c, pm0; const PG8_LAS int* texp;
    __device__ void init(int nM_, int N, int KS_, int G_, int c_, const PG8_LAS int* texp_) { nM = nM_; nNo = N / BM; KS = KS_; nN = nNo * KS; nwg = nM * nN; G = G_; c = c_; texp = texp_; pm0 = 0; }
    int L0 = 0, L1 = 0x7fffffff, halves = 0;
    __device__ bool next(int i, Unit& u) const {
        long L = (long)i * G + c; int hf = 0; if (halves) { hf = (int)(L & 1); L >>= 1; } L += L0; if (L >= nwg || L >= L1) return false; u.hf = hf;
        int wgid = (int)L; { const int q = nwg / NXCD, r = nwg % NXCD, xcd = wgid % NXCD, off = wgid / NXCD; wgid = (xcd < r ? xcd * (q + 1) : r * (q + 1) + (xcd - r) * q) + off; }
        const int nig = WGM * nN, gid = wgid / nig, fm = gid * WGM, gsz = (nM - fm) < WGM ? (nM - fm) : WGM;
        u.pm = pm0 + fm + ((wgid % nig) % gsz); const int q = (wgid % nig) / gsz; u.pn = q / KS; u.kz = q % KS; u.pb = __builtin_amdgcn_readfirstlane(texp[u.pm]) * nNo + u.pn; u.ord = i; return true;
    }
    __device__ __forceinline__ void a_ready(const Unit&) const {}
    __device__ __forceinline__ void done(const Unit&) const {}
};

struct MoeOrderPub : MoeOrder {
    unsigned* cnt; mutable int prev_pm;
    __device__ __forceinline__ void done(const Unit& u) const {
        if (prev_pm >= 0 && (threadIdx.x & 63) == 0) __hip_atomic_fetch_add(cnt + 64 * prev_pm, 1u, __ATOMIC_RELAXED, __HIP_MEMORY_SCOPE_AGENT);
        prev_pm = u.pm; }
    __device__ __forceinline__ void flush() const { if (prev_pm >= 0 && (threadIdx.x & 63) == 0) __hip_atomic_fetch_add(cnt + 64 * prev_pm, 1u, __ATOMIC_RELAXED, __HIP_MEMORY_SCOPE_AGENT); prev_pm = -1; }
};
struct MoeOrderWait : MoeOrder {
    const unsigned* cnt; unsigned need; unsigned* tmo;
    __device__ __forceinline__ void a_ready(const Unit& u) const {
        if (threadIdx.x < 64) {
            const unsigned long long t0 = __builtin_amdgcn_s_memrealtime(); unsigned polls = 0;
            while ((unsigned)__builtin_amdgcn_readfirstlane(__hip_atomic_load(cnt + 64 * u.pm, __ATOMIC_RELAXED, __HIP_MEMORY_SCOPE_AGENT)) < need) {
                if ((++polls & 255u) == 0u && __builtin_amdgcn_readfirstlane(__hip_atomic_load(tmo, __ATOMIC_RELAXED, __HIP_MEMORY_SCOPE_AGENT)) != 0u) break;
                if (__builtin_amdgcn_s_memrealtime() - t0 > 2000000ull) { if (threadIdx.x == 0) __hip_atomic_store(tmo, 1u, __ATOMIC_RELAXED, __HIP_MEMORY_SCOPE_AGENT); break; }
                __builtin_amdgcn_s_sleep(2); }
            __builtin_amdgcn_fence(__ATOMIC_ACQUIRE, "agent");
            asm volatile("s_waitcnt vmcnt(0)" ::: "memory");
        }
        asm volatile("" ::: "memory"); __builtin_amdgcn_s_barrier(); asm volatile("" ::: "memory");
    }
};

__device__ __forceinline__ float row_rstd(const float* SSQ, int row, int fq) {
    const f32x4 p = *(const f32x4*)(SSQ + (size_t)row * 16 + 4 * fq); float s = (p[0] + p[1]) + (p[2] + p[3]);
    s += __shfl_xor(s, 16); s += __shfl_xor(s, 32); return rsqrtf(s * (1.0f / 1024.0f) + 1e-6f);
}
__device__ __forceinline__ void row_rstd8(const float* SSQ, int row0, int fq, float (&rs)[2][4]) {
    f32x4 p[2][4];
#pragma unroll
    for (int ai = 0; ai < 2; ++ai)
#pragma unroll
        for (int m = 0; m < 4; ++m) p[ai][m] = *(const f32x4*)(SSQ + (size_t)(row0 + ai * 128 + m * 16) * 16 + 4 * fq);
#pragma unroll
    for (int ai = 0; ai < 2; ++ai)
#pragma unroll
        for (int m = 0; m < 4; ++m) { float s = (p[ai][m][0] + p[ai][m][1]) + (p[ai][m][2] + p[ai][m][3]); s += __shfl_xor(s, 16); s += __shfl_xor(s, 32); rs[ai][m] = rsqrtf(s * (1.0f / 1024.0f) + 1e-6f); }
}
template <bool USE_RS> struct EpiBf16T {
    static constexpr bool PERM = true, AFTER_DRAIN = false;
    bf16_t* O; int ldc; size_t zstride; const PG8_LAS float* RS;
    __device__ __forceinline__ void operator()(const f32x4 (&acc)[2][2][4][2], const Unit& u, int wr, int wc, int fr, int fq) const {
        const int row0 = u.pm * BM + wr * 64 + fr, col0 = u.pn * BM + wc * 32 + 8 * fq;
#pragma unroll
        for (int ai = 0; ai < 2; ++ai)
#pragma unroll
            for (int m = 0; m < 4; ++m) { const int row = row0 + ai * HALF + m * 16; bf16_t* rowp = O + (size_t)u.kz * zstride + (size_t)row * ldc + col0; float rs = 1.f; if constexpr (USE_RS) rs = RS[u.ord * 256 + wr * 64 + fr + ai * HALF + m * 16];
#pragma unroll
                for (int bj = 0; bj < 2; ++bj) { const f32x4 v0 = acc[ai][bj][m][0] * rs, v1 = acc[ai][bj][m][1] * rs;
                    u32x4 w; w.x = cvt_pk_bf16_c(v0[0], v0[1]); w.y = cvt_pk_bf16_c(v0[2], v0[3]); w.z = cvt_pk_bf16_c(v1[0], v1[1]); w.w = cvt_pk_bf16_c(v1[2], v1[3]);
                    *(u32x4*)(rowp + bj * HALF) = w; } }
    }
};
typedef EpiBf16T<false> EpiBf16;
struct EpiNull {
    static constexpr bool PERM = true, AFTER_DRAIN = false;
    __device__ __forceinline__ void operator()(const f32x4 (&acc)[2][2][4][2], const Unit& u, int wr, int wc, int fr, int fq) const {
#pragma unroll
        for (int ai = 0; ai < 2; ++ai)
#pragma unroll
            for (int bj = 0; bj < 2; ++bj)
#pragma unroll
                for (int m = 0; m < 4; ++m)
#pragma unroll
                    for (int n = 0; n < 2; ++n) asm volatile("" :: "v"(acc[ai][bj][m][n]));
    }
};
template <bool WITH_XO> struct EpiResF16T {
    static constexpr bool PERM = true, AFTER_DRAIN = false;
    const float* X; _Float16* H; int ldc; bf16_t* XO; const float* gain; float* SSQ;
    __device__ __forceinline__ void operator()(const f32x4 (&acc)[2][2][4][2], const Unit& u, int wr, int wc, int fr, int fq) const {
        const int row0 = u.pm * BM + wr * 64 + fr, col0 = u.pn * BM + wc * 32 + 8 * fq;
        f32x8 gv[2];
        if constexpr (WITH_XO) { gv[0] = *(const f32x8*)(gain + col0); gv[1] = *(const f32x8*)(gain + col0 + HALF); }
#pragma unroll
        for (int ai = 0; ai < 2; ++ai)
#pragma unroll
            for (int m = 0; m < 4; ++m) { const int row = row0 + ai * HALF + m * 16; const size_t ro = (size_t)row * ldc + col0; f32x8 b[2];
                if (X) { b[0] = *(const f32x8*)(X + ro); b[1] = *(const f32x8*)(X + ro + HALF); }
                else { b[0] = __builtin_convertvector(*(const h16x8*)(H + ro), f32x8); b[1] = __builtin_convertvector(*(const h16x8*)(H + ro + HALF), f32x8); }
#pragma unroll
                for (int bj = 0; bj < 2; ++bj) {
#pragma unroll
                    for (int j = 0; j < 4; ++j) { b[bj][j] += acc[ai][bj][m][0][j]; b[bj][4 + j] += acc[ai][bj][m][1][j]; }
                    *(h16x8*)(H + ro + bj * HALF) = __builtin_convertvector(b[bj], h16x8); }
                if constexpr (WITH_XO) { float ss = 0.f;
#pragma unroll
                    for (int bj = 0; bj < 2; ++bj) {
#pragma unroll
                        for (int j = 0; j < 8; ++j) ss += b[bj][j] * b[bj][j];
                        const f32x8 o = b[bj] * gv[bj]; u32x4 w; w.x = cvt_pk_bf16(o[0], o[1]); w.y = cvt_pk_bf16(o[2], o[3]); w.z = cvt_pk_bf16(o[4], o[5]); w.w = cvt_pk_bf16(o[6], o[7]);
                        *(u32x4*)(XO + ro + bj * HALF) = w; }
                    ss += __shfl_xor(ss, 16); ss += __shfl_xor(ss, 32);
                    if (fq == 0) SSQ[(size_t)row * 16 + 4 * u.pn + wc] = ss; } }
    }
};
typedef EpiResF16T<false> EpiResF16;
template <bool USE_RS, bool WT = false, bool HM = false> struct EpiSwigluT {
    static constexpr bool PERM = true, AFTER_DRAIN = false;
    bf16_t* O; int ldc; const PG8_LAS float* RS; int obytes;
    __device__ __forceinline__ void operator()(const f32x4 (&acc)[2][2][4][2], const Unit& u, int wr, int wc, int fr, int fq) const {
        const int row0 = u.pm * BM + (HM ? u.hf * HALF : 0) + wr * 64 + fr, col0 = u.pn * HALF + wc * 32 + 8 * fq;
        __amdgpu_buffer_rsrc_t rsrc = __builtin_amdgcn_make_buffer_rsrc((void*)O, 0, WT ? obytes : 0, 0x00020000);
#pragma unroll
        for (int ai = 0; ai < (HM ? 1 : 2); ++ai)
#pragma unroll
            for (int m = 0; m < 4; ++m) { const int row = row0 + ai * HALF + m * 16; bf16_t* rowp = O + (size_t)row * ldc + col0; float r[8]; float rs = 1.f; if constexpr (USE_RS) rs = RS[u.ord * 256 + wr * 64 + fr + ai * HALF + m * 16];
#pragma unroll
                for (int n = 0; n < 2; ++n)
#pragma unroll
                    for (int j = 0; j < 4; ++j) { const float g = acc[ai][0][m][n][j] * rs, up = acc[ai][1][m][n][j] * rs; r[4 * n + j] = g * __builtin_amdgcn_rcpf(1.f + __expf(-g)) * up; }
                u32x4 w; w.x = cvt_pk_bf16(r[0], r[1]); w.y = cvt_pk_bf16(r[2], r[3]); w.z = cvt_pk_bf16(r[4], r[5]); w.w = cvt_pk_bf16(r[6], r[7]);
                if constexpr (WT) __builtin_amdgcn_raw_buffer_store_b128(w, rsrc, (int)(((size_t)row * ldc + col0) * 2), 0, 16); else *(u32x4*)rowp = w; }
    }
};
typedef EpiSwigluT<false> EpiSwiglu;

template <class Epi, class Sched, bool ALIGN_EPI = false, bool SP2 = false, bool HALFM = false>
__device__ __forceinline__ void gemm_phase(PG8_LAS unsigned char* lds, const Gemm g, const Sched& S, const Epi& E) {
    int tid_o = threadIdx.x; asm volatile("" : "+v"(tid_o));
    const int tid = tid_o, wid = __builtin_amdgcn_readfirstlane(tid >> 6), lane = tid & 63, wr = wid >> 2, wc = wid & 3, fr = lane & 15, fq = lane >> 4;
    if (g.stag > 0) { const int sg = (int)((blockIdx.x >> 3) & 3u); for (int i = 0; i < sg * g.stag; ++i) __builtin_amdgcn_s_sleep(63); }
    const int K = g.ld, nt = g.K / BK;
    unsigned voffA[2], voffB[2];
#pragma unroll
    for (int i = 0; i < 2; ++i) { int R, C; stage_rc(tid * 16 + i * 8192, R, C); const int Rb = Epi::PERM ? ((R & ~31) + perm32(R & 31)) : R;
        voffA[i] = (unsigned)(R * K + C) * 2u; voffB[i] = (unsigned)(Rb * K + C) * 2u; }
    const size_t kstep = (size_t)(BK * 2);
    const size_t hstep = (size_t)HALF * K * 2;
    const size_t tstep = 2 * hstep;
    const size_t hstepA = HALFM ? (size_t)0 : hstep;
    const unsigned ldsw = (unsigned)wid * 1024u;
    const int aoff = lds_byte(wr * 64 + fr, fq * 8), boff = lds_byte(wc * 32 + fr, fq * 8);
#define PG8_SA(b, h) (((b) * 2 + (h)) * HTB)
#define PG8_SB(b, h) ((4 + (b) * 2 + (h)) * HTB)
#define PG8_STAGE(bufoff, gbase, voff) do { _Pragma("unroll") for (int _i = 0; _i < 2; ++_i) \
        __builtin_amdgcn_global_load_lds((const unsigned*)((const char*)(gbase) + (voff)[_i]), (PG8_LAS unsigned*)(lds + (bufoff) + ldsw + _i * 8192), 16, 0, 0); } while (0)
#define PG8_LDA(dst, b, h) do { _Pragma("unroll") for (int m = 0; m < 4; ++m) _Pragma("unroll") for (int k = 0; k < 2; ++k) dst[m][k] = *(const PG8_LAS bf16x8*)(lds + PG8_SA(b, h) + aoff + m * 2048 + k * 1024); } while (0)
#define PG8_LDB(dst, b, h) do { _Pragma("unroll") for (int n = 0; n < 2; ++n) _Pragma("unroll") for (int k = 0; k < 2; ++k) dst[n][k] = *(const PG8_LAS bf16x8*)(lds + PG8_SB(b, h) + boff + n * 2048 + k * 1024); } while (0)
#define PG8_MMA(ai, bj, At, Bt) do { __builtin_amdgcn_s_setprio(1); _Pragma("unroll") for (int m = 0; m < 4; ++m) _Pragma("unroll") for (int n = 0; n < 2; ++n) _Pragma("unroll") for (int k = 0; k < 2; ++k) \
        acc[ai][bj][m][n] = __builtin_amdgcn_mfma_f32_16x16x32_bf16(Bt[n][k], At[m][k], acc[ai][bj][m][n], 0, 0, 0); __builtin_amdgcn_s_setprio(0); } while (0)
#define PG8_WAIT_V(n) asm volatile("s_waitcnt vmcnt(" #n ")" ::: "memory")
#define PG8_WAIT_L(n) asm volatile("s_waitcnt lgkmcnt(" #n ")" ::: "memory")
#define PG8_BAR __builtin_amdgcn_s_barrier()
#define PG8_SCHED __builtin_amdgcn_sched_barrier(0)
    Unit cur, nxt; int ui = 0;
    if (!S.next(0, cur)) return;
    f32x4 acc[2][2][4][2];
#pragma unroll
    for (int a = 0; a < 2; ++a)
#pragma unroll
        for (int b = 0; b < 2; ++b)
#pragma unroll
            for (int m = 0; m < 4; ++m)
#pragma unroll
                for (int n = 0; n < 2; ++n) acc[a][b][m][n] = (f32x4){0.f, 0.f, 0.f, 0.f};
    bf16x8 At[4][2], B0[2][2], B1[2][2];
    const size_t kzb = (size_t)g.K * 2;
    const char* cA = (const char*)g.A + (size_t)cur.pm * tstep + cur.kz * kzb + (HALFM ? cur.hf * hstep : (size_t)0); const char* cB = (const char*)g.Bt + (size_t)cur.pb * tstep + cur.kz * kzb;
    S.a_ready(cur);
    if constexpr (SP2) {
        PG8_STAGE(PG8_SB(0, 0), cB, voffB); PG8_STAGE(PG8_SB(0, 1), cB + hstep, voffB); PG8_STAGE(PG8_SA(0, 0), cA, voffA); PG8_STAGE(PG8_SA(0, 1), cA + hstepA, voffA);
        if (wr == 1) PG8_BAR;
        PG8_WAIT_V(2); PG8_BAR;
        PG8_STAGE(PG8_SB(1, 0), cB + kstep, voffB); PG8_STAGE(PG8_SA(1, 0), cA + kstep, voffA); PG8_STAGE(PG8_SB(1, 1), cB + hstep + kstep, voffB);
        PG8_WAIT_V(6); PG8_BAR;
    } else {
        PG8_STAGE(PG8_SB(0, 0), cB, voffB); PG8_STAGE(PG8_SA(0, 0), cA, voffA); PG8_STAGE(PG8_SB(0, 1), cB + hstep, voffB); PG8_STAGE(PG8_SA(0, 1), cA + hstepA, voffA);
        if (wr == 1) PG8_BAR;
        PG8_WAIT_V(4); PG8_BAR;
        PG8_STAGE(PG8_SB(1, 0), cB + kstep, voffB); PG8_STAGE(PG8_SA(1, 0), cA + kstep, voffA); PG8_STAGE(PG8_SB(1, 1), cB + hstep + kstep, voffB);
        PG8_WAIT_V(6); PG8_BAR;
    }
    for (;;) {
        const bool has_next = S.next(ui + 1, nxt);
        const char* nA = has_next ? (const char*)g.A + (size_t)nxt.pm * tstep + nxt.kz * kzb + (HALFM ? nxt.hf * hstep : (size_t)0) : cA; const char* nB = has_next ? (const char*)g.Bt + (size_t)nxt.pb * tstep + nxt.kz * kzb : cB;
        for (int t = 0; t < nt; t += 2) {
            const bool last = (t == nt - 2);
            const char* a1 = cA + (size_t)(t + 1) * kstep;
            const char* a2 = last ? nA : cA + (size_t)(t + 2) * kstep; const char* b2 = last ? nB : cB + (size_t)(t + 2) * kstep;
            const char* a3 = a2 + kstep; const char* b3 = b2 + kstep;
            if (last && has_next) S.a_ready(nxt);
            if constexpr (SP2) {
            PG8_LDB(B0, 0, 0); PG8_LDB(B1, 0, 1); PG8_SCHED; PG8_LDA(At, 0, 0); PG8_STAGE(PG8_SA(1, 1), a1 + hstepA, voffA);
            PG8_WAIT_V(8); PG8_WAIT_L(0); PG8_BAR; PG8_MMA(0, 0, At, B0); PG8_MMA(0, 1, At, B1); PG8_BAR; PG8_SCHED;
            PG8_LDA(At, 0, 1); PG8_STAGE(PG8_SB(0, 0), b2, voffB); PG8_STAGE(PG8_SB(0, 1), b2 + hstep, voffB); PG8_STAGE(PG8_SA(0, 0), a2, voffA);
            PG8_WAIT_V(8); PG8_WAIT_L(0); PG8_BAR; if constexpr (!HALFM) { PG8_MMA(1, 0, At, B0); PG8_MMA(1, 1, At, B1); } PG8_BAR; PG8_SCHED;
            PG8_LDB(B0, 1, 0); PG8_LDB(B1, 1, 1); PG8_SCHED; PG8_LDA(At, 1, 0); PG8_STAGE(PG8_SA(0, 1), a2 + hstepA, voffA);
            PG8_WAIT_V(8); PG8_WAIT_L(0); PG8_BAR; PG8_MMA(0, 0, At, B0); PG8_MMA(0, 1, At, B1); PG8_BAR; PG8_SCHED;
            PG8_LDA(At, 1, 1); PG8_STAGE(PG8_SB(1, 0), b3, voffB); PG8_STAGE(PG8_SB(1, 1), b3 + hstep, voffB); PG8_STAGE(PG8_SA(1, 0), a3, voffA);
            PG8_WAIT_V(8); PG8_WAIT_L(0); PG8_BAR; if constexpr (!HALFM) { PG8_MMA(1, 0, At, B0); PG8_MMA(1, 1, At, B1); } PG8_BAR; PG8_SCHED;
            } else {
            PG8_LDB(B0, 0, 0); PG8_SCHED; PG8_LDA(At, 0, 0); PG8_STAGE(PG8_SA(1, 1), a1 + hstepA, voffA);
            PG8_WAIT_L(8); PG8_BAR; PG8_WAIT_L(0); PG8_MMA(0, 0, At, B0); PG8_BAR; PG8_SCHED;
            PG8_LDB(B1, 0, 1); PG8_STAGE(PG8_SB(0, 0), b2, voffB);
            PG8_BAR; PG8_WAIT_L(0); PG8_MMA(0, 1, At, B1); PG8_BAR;
            PG8_LDA(At, 0, 1); PG8_STAGE(PG8_SA(0, 0), a2, voffA);
            PG8_BAR; PG8_WAIT_L(0); if constexpr (!HALFM) PG8_MMA(1, 0, At, B0); PG8_BAR; PG8_SCHED;
            PG8_STAGE(PG8_SB(0, 1), b2 + hstep, voffB);
            PG8_WAIT_V(6); PG8_BAR; if constexpr (!HALFM) PG8_MMA(1, 1, At, B1); PG8_BAR;
            PG8_LDB(B0, 1, 0); PG8_SCHED; PG8_LDA(At, 1, 0); PG8_STAGE(PG8_SA(0, 1), a2 + hstepA, voffA);
            PG8_WAIT_L(8); PG8_BAR; PG8_WAIT_L(0); PG8_MMA(0, 0, At, B0); PG8_BAR; PG8_SCHED;
            PG8_LDB(B1, 1, 1); PG8_STAGE(PG8_SB(1, 0), b3, voffB);
            PG8_BAR; PG8_WAIT_L(0); PG8_MMA(0, 1, At, B1); PG8_BAR;
            PG8_LDA(At, 1, 1); PG8_STAGE(PG8_SA(1, 0), a3, voffA);
            PG8_BAR; PG8_WAIT_L(0); if constexpr (!HALFM) PG8_MMA(1, 0, At, B0); PG8_BAR; PG8_SCHED;
            PG8_STAGE(PG8_SB(1, 1), b3 + hstep, voffB);
            PG8_WAIT_V(6); PG8_BAR; if constexpr (!HALFM) PG8_MMA(1, 1, At, B1); PG8_BAR;
            }
        }
        if constexpr (ALIGN_EPI) { if (wr == 0) PG8_BAR; }
        if constexpr (!Epi::AFTER_DRAIN) { E(acc, cur, wr, wc, fr, fq); S.done(cur); }
        if (!has_next) break;
#pragma unroll
        for (int a = 0; a < 2; ++a)
#pragma unroll
            for (int b = 0; b < 2; ++b)
#pragma unroll
                for (int m = 0; m < 4; ++m)
#pragma unroll
                    for (int n = 0; n < 2; ++n) acc[a][b][m][n] = (f32x4){0.f, 0.f, 0.f, 0.f};
        cur = nxt; cA = nA; cB = nB; ++ui;
        if constexpr (ALIGN_EPI) { if (wr == 1) PG8_BAR; }
    }
    PG8_WAIT_V(0);
    if constexpr (!ALIGN_EPI) { if (wr == 0) PG8_BAR; }
    PG8_BAR;
    if constexpr (Epi::AFTER_DRAIN) { E.fused(acc, cur, wr, wc, fr, fq, lds, wid, lane); S.done(cur); }
#undef PG8_SA
#undef PG8_SB
#undef PG8_STAGE
#undef PG8_LDA
#undef PG8_LDB
#undef PG8_MMA
#undef PG8_WAIT_V
#undef PG8_WAIT_L
#undef PG8_BAR
#undef PG8_SCHED
}
}

constexpr size_t MiB = 1u << 20;
constexpr size_t WS_CTL = 0;
constexpr int CW_BAR = 4096;
constexpr int CW_MOECNT = 32768;
constexpr int CW_BGCUR = 64;
constexpr size_t WS_IFP = 1 * MiB;
constexpr size_t WS_EIDX = WS_IFP + 512 * 1024;
constexpr size_t WS_EW = WS_EIDX + 128 * 1024;
constexpr size_t WS_POS = WS_EW + 128 * 1024;
constexpr size_t WS_BLKCNT = WS_POS + 128 * 1024;
constexpr size_t WS_META = WS_BLKCNT + 16 * 1024;
constexpr size_t WS_SMALL = 2 * MiB;
constexpr size_t WS_SSQ = 6 * MiB;
constexpr size_t WS_WRG = 4 * MiB;
constexpr size_t WS_WIN = 8 * MiB;
constexpr size_t WS_WOUT = 32 * MiB;
constexpr size_t WS_WGU = 40 * MiB;
constexpr size_t WS_WD = 62 * MiB;
constexpr size_t WS_MWGU = 74 * MiB;
constexpr size_t WS_MWD = 298 * MiB;
constexpr size_t WS_H = 410 * MiB;
constexpr size_t WS_XN = 474 * MiB;
constexpr size_t WS_R = 506 * MiB;
constexpr size_t WS_Z = WS_R;
constexpr size_t WS_Y = WS_R + 96 * MiB;
constexpr size_t WS_CTL_LOC = WS_R + 128 * MiB;
constexpr size_t WS_CTP = WS_R + 160 * MiB;
constexpr size_t WS_RA = WS_R + 176 * MiB;
constexpr size_t WS_RU = WS_R + 208 * MiB;
constexpr size_t WS_HID = WS_R;
constexpr size_t WS_XG = WS_R;
constexpr size_t WS_MHID = WS_R + 68 * MiB;
constexpr size_t WS_Y1 = 812 * MiB;
constexpr size_t WS_SCR = WS_R + 128 * MiB;
constexpr size_t WS_END = 880 * MiB;
constexpr int MOE_KS = 1;
constexpr int MOE_FULL = 128, MOE_TS = 7;
constexpr int MOE_KS_UNUSED = 1;

constexpr int LDS_BYTES = 163840;
constexpr int MISC_OFF = LDS_BYTES - 256;

struct Ctx { const float* in[23]; float* out; unsigned char* ws; int s_lo, s_hi; };

#define XB_TMO      128
#define XB_XCNT(j)  (256  + 64 * (j))
#define XB_XSUB(j)  (1280 + 64 * (j))
#define XB_XGEN(j)  (2304 + 64 * (j))
#define XB_TOP      3328
#define XB_TOPGEN   3392
#define XCD_BAR_WORDS 3456
#define XB_SPIN_CAP (1u << 18)

__device__ __forceinline__ unsigned xb_ld(unsigned* p)              { return __hip_atomic_load(p, __ATOMIC_RELAXED, __HIP_MEMORY_SCOPE_AGENT); }
__device__ __forceinline__ unsigned xb_add(unsigned* p, unsigned v) { return __hip_atomic_fetch_add(p, v, __ATOMIC_RELAXED, __HIP_MEMORY_SCOPE_AGENT); }
__device__ __forceinline__ unsigned xb_xcc_id() { return (unsigned)__builtin_amdgcn_s_getreg((3 << 11) | 20) & 0xFu; }
#define XB_SPIN(cond, bar) do { unsigned _sp = 0; while (cond) { __builtin_amdgcn_s_sleep(1); \
    if ((++_sp & 255u) == 0u) { if (xb_ld(&(bar)[XB_TMO])) break; if (_sp > XB_SPIN_CAP) { atomicAdd(&(bar)[XB_TMO], 1u); break; } } } } while (0)

struct XcdBarrier {
    unsigned* bar; unsigned x;
    volatile LAS unsigned* st;
};

__device__ __forceinline__ XcdBarrier xcd_barrier_post(unsigned* bar, volatile LAS unsigned* st) {
    XcdBarrier b; b.bar = bar; b.x = xb_xcc_id(); b.st = st;
    if (threadIdx.x == 0) (void)xb_add(&bar[XB_XCNT(b.x)], 1u);
    return b;
}
__device__ __forceinline__ void xcd_barrier_complete(unsigned* bar, unsigned x, unsigned& nloc, unsigned& nx) {
    const unsigned G = gridDim.x * gridDim.y * gridDim.z;
    unsigned sum, cnt, mine, sp = 0u;
    for (;;) {
        sum = 0u; cnt = 0u; mine = 0u;
#pragma unroll
        for (unsigned j = 0; j < 16; ++j) { const unsigned c = xb_ld(&bar[XB_XCNT(j)]); sum += c; cnt += (c > 0u) ? 1u : 0u; mine = (j == x) ? c : mine; }
        if (sum == G) break;
        __builtin_amdgcn_s_sleep(1);
        if ((++sp & 255u) == 0u) { if (xb_ld(&bar[XB_TMO])) break; if (sp > XB_SPIN_CAP) { atomicAdd(&bar[XB_TMO], 1u); break; } }
    }
    nloc = mine > 0u ? mine : 1u; nx = cnt > 0u ? cnt : 1u;
}

__device__ __forceinline__ void xcd_barrier(const XcdBarrier& b) {
    asm volatile("s_waitcnt vmcnt(0)" ::: "memory");
    __syncthreads();
    if (threadIdx.x == 0) {
        unsigned* bar = b.bar;
        __builtin_amdgcn_s_waitcnt(0);
        unsigned nloc = b.st[0], nx = b.st[1];
        if (nloc == 0u) { xcd_barrier_complete(bar, b.x, nloc, nx); b.st[0] = nloc; b.st[1] = nx; }
        const unsigned old = xb_add(&bar[XB_XSUB(b.x)], 1u);
        const unsigned gen = old / nloc;
        if (old + 1u == (gen + 1u) * nloc) {
            __builtin_amdgcn_fence(__ATOMIC_RELEASE, "agent");
            asm volatile("s_waitcnt vmcnt(0)" ::: "memory");
            const unsigned og = xb_add(&bar[XB_TOP], 1u);
            const unsigned tg = og / nx;
            if (og + 1u == (tg + 1u) * nx) xb_add(&bar[XB_TOPGEN], 1u);
            else XB_SPIN(xb_ld(&bar[XB_TOPGEN]) == tg, bar);
            __builtin_amdgcn_fence(__ATOMIC_ACQUIRE, "agent");
            xb_add(&bar[XB_XGEN(b.x)], 1u);
            asm volatile("s_waitcnt vmcnt(0)" ::: "memory");
        } else {
            XB_SPIN(xb_ld(&bar[XB_XGEN(b.x)]) == gen, bar);
            __builtin_amdgcn_fence(__ATOMIC_ACQUIRE, "agent");
            asm volatile("s_waitcnt vmcnt(0)" ::: "memory");
        }
    }
    __syncthreads();
}

#ifndef MIX_FAST
#define MIX_FAST 1
#endif
#ifndef NV_ML
#define NV_ML 0
#endif
#ifndef NV_RG
#define NV_RG 0
#endif
#ifndef CVT_KFAST
#define CVT_KFAST 0
#endif
#ifndef DOTREP
#define DOTREP 1
#endif
#ifndef BG_ON
#define BG_ON 0
#endif
__device__ __forceinline__ int opaque_bid() { int b = blockIdx.x; asm volatile("" : "+s"(b)); return b; }
#define IN_X 0
#define IN_NORM_MIX_G 1
#define IN_W_IN 2
#define IN_ML_B_IF 3
#define IN_ML_NORM_G 4
#define IN_CONV_W 5
#define IN_CONV_B 6
#define IN_RG_W_A 7
#define IN_RG_B_A 8
#define IN_RG_W_X 9
#define IN_RG_B_X 10
#define IN_RG_LAM 11
#define IN_RG_NORM_G 12
#define IN_W_OUT 13
#define IN_NORM_FFN_G 14
#define IN_FFN_WG 15
#define IN_FFN_WU 16
#define IN_FFN_WD 17
#define IN_MOE_WR 18
#define IN_MOE_WG 19
#define IN_MOE_WU 20
#define IN_MOE_WD 21
#define IN_NORM_FINAL_G 22

__device__ __forceinline__ void cvt_tile(const float* __restrict__ src, int ld, bf16* __restrict__ dst, int K, LAS float* scr, int lane) {
#pragma unroll 4
    for (int i = 0; i < 16; ++i) { const int kk = 4 * i + (lane >> 4); const f32x4 v = __builtin_nontemporal_load((const f32x4*)(src + (size_t)kk * ld + (lane & 15) * 4));
        LAS float* s = scr + kk * 65 + (lane & 15) * 4; s[0] = v[0]; s[1] = v[1]; s[2] = v[2]; s[3] = v[3]; }
    asm volatile("s_waitcnt lgkmcnt(0)" ::: "memory");
    const int c = lane & 7;
#pragma unroll
    for (int j = 0; j < 8; ++j) { const int n = (lane >> 3) + 8 * j; const LAS float* s = scr + (8 * c) * 65 + n;
        u32x4 o; o.x = cvt_pk_bf16(s[0], s[65]); o.y = cvt_pk_bf16(s[130], s[195]); o.z = cvt_pk_bf16(s[260], s[325]); o.w = cvt_pk_bf16(s[390], s[455]);
        *(u32x4*)(dst + (size_t)n * K + 8 * c) = o; }
    asm volatile("s_waitcnt lgkmcnt(0)" ::: "memory");
}
constexpr int CV_IN = 4 * 768, CV_OUT = 4 * 256, CV_GU = 2 * 1408, CV_D = 2 * 704, CV_MGU = 16 * 1792, CV_MD = 16 * 896, CV_RG = 64;
constexpr int CV_TOTAL = CV_IN + CV_OUT + CV_GU + CV_D + CV_MGU + CV_MD + CV_RG;
__device__ __forceinline__ void cvt_job(const Ctx& c, int it, LAS float* scr, int lane) {
    const float* src; int ld, K; bf16* dst;
    if (it < CV_IN) { const int l = it / 768, r = it % 768, nt = CVT_KFAST ? ((r >> 3) % 48) : (r % 48), kt = CVT_KFAST ? (((r >> 3) / 48) * 8 + (r & 7)) : (r / 48), n0 = 64 * nt, k0 = 64 * kt, sc = n0 < 2048 ? n0 : n0 + 8;
        src = c.in[IN_W_IN] + (size_t)l * D * DIN + (size_t)k0 * DIN + sc; ld = DIN; K = D; dst = (bf16*)(c.ws + WS_WIN) + (size_t)l * NZ * D + (size_t)n0 * D + k0; }
    else if ((it -= CV_IN) < CV_OUT) { const int l = it / 256, r = it % 256, nt = CVT_KFAST ? ((r >> 3) % 16) : (r % 16), kt = CVT_KFAST ? (((r >> 3) / 16) * 8 + (r & 7)) : (r / 16), n0 = 64 * nt, k0 = 64 * kt;
        src = c.in[IN_W_OUT] + (size_t)l * D * D + (size_t)k0 * D + n0; ld = D; K = D; dst = (bf16*)(c.ws + WS_WOUT) + (size_t)l * D * D + (size_t)n0 * D + k0; }
    else if ((it -= CV_OUT) < CV_GU) { const int j = it / 1408, r = it % 1408, nt = CVT_KFAST ? ((r >> 3) % 88) : (r % 88), kt = CVT_KFAST ? (((r >> 3) / 88) * 8 + (r & 7)) : (r / 88), n0 = 64 * nt, k0 = 64 * kt, jj = n0 >> 8, cc = n0 & 255;
        src = (cc < 128 ? c.in[IN_FFN_WG] : c.in[IN_FFN_WU]) + (size_t)j * D * FFD + (size_t)k0 * FFD + jj * 128 + (cc & 127); ld = FFD; K = D;
        dst = (bf16*)(c.ws + WS_WGU) + (size_t)j * 2 * FFD * D + (size_t)n0 * D + k0; }
    else if ((it -= CV_GU) < CV_D) { const int j = it / 704, r = it % 704, nt = r % 16, kt = r / 16, n0 = 64 * nt, k0 = 64 * kt;
        src = c.in[IN_FFN_WD] + (size_t)j * FFD * D + (size_t)k0 * D + n0; ld = D; K = FFD; dst = (bf16*)(c.ws + WS_WD) + (size_t)j * D * FFD + (size_t)n0 * FFD + k0; }
    else if ((it -= CV_D) < CV_MGU) { const int je = it / 1792, r = it % 1792, nt = CVT_KFAST ? ((r >> 3) % 112) : (r % 112), kt = CVT_KFAST ? (((r >> 3) / 112) * 8 + (r & 7)) : (r / 112), n0 = 64 * nt, k0 = 64 * kt, jj = n0 >> 8, cc = n0 & 255;
        src = (cc < 128 ? c.in[IN_MOE_WG] : c.in[IN_MOE_WU]) + (size_t)je * D * FFE + (size_t)k0 * FFE + jj * 128 + (cc & 127); ld = FFE; K = D;
        dst = (bf16*)(c.ws + WS_MWGU) + (size_t)je * 2 * FFE * D + (size_t)n0 * D + k0; }
    else if ((it -= CV_MGU) < CV_MD) { const int je = it / 896, r = it % 896, nt = CVT_KFAST ? ((r >> 3) % 16) : (r % 16), kt = CVT_KFAST ? (((r >> 3) / 16) * 8 + (r & 7)) : (r / 16), n0 = 64 * nt, k0 = 64 * kt;
        src = c.in[IN_MOE_WD] + (size_t)je * FFE * D + (size_t)k0 * D + n0; ld = D; K = FFE; dst = (bf16*)(c.ws + WS_MWD) + (size_t)je * D * FFE + (size_t)n0 * FFE + k0; }
    else { it -= CV_MD; const int l = it >> 4, which = (it >> 3) & 1, g = it & 7;
        src = c.in[which ? IN_RG_W_X : IN_RG_W_A] + (size_t)(l * RGB + g) * RGD * RGD; ld = RGD; K = RGD; dst = (bf16*)(c.ws + WS_WRG) + (size_t)((l * 2 + which) * RGB + g) * RGD * RGD; }
    cvt_tile(src, ld, dst, K, scr, lane);
}
constexpr int CV_MGU0 = CV_IN + CV_OUT + CV_GU + CV_D, CV_MD0 = CV_MGU0 + CV_MGU;
constexpr int BG_MGU = 8 * 1792, BG_MD = 8 * 896, BG_TOTAL = BG_ON ? (BG_MGU + BG_MD) : 0;
__device__ __forceinline__ bool cvt_is_bg(int it) { return BG_ON && ((it >= CV_MGU0 + BG_MGU && it < CV_MD0) || (it >= CV_MD0 + BG_MD && it < CV_MD0 + CV_MD)); }
__device__ __forceinline__ void cvt_phase(const Ctx& c, LAS unsigned char* lds) {
    int tid_o = threadIdx.x; asm volatile("" : "+v"(tid_o));
    const int tid = tid_o, lane = tid & 63, wave = __builtin_amdgcn_readfirstlane(tid >> 6);
    LAS float* scr = (LAS float*)(lds + wave * 16640);
    const int gw = opaque_bid() * NWAVES + wave, NGW = gridDim.x * NWAVES;
    const int NFG = CV_TOTAL - BG_TOTAL;
    for (int f = gw; f < NFG; f += NGW) {
        int it = f;
        if (BG_ON) { if (it >= CV_MGU0 + BG_MGU) it += BG_MGU; if (it >= CV_MD0 + BG_MD) it += BG_MD; }
        cvt_job(c, it, scr, lane);
    }
}
__device__ __forceinline__ void bg_cvt(const Ctx& c, LAS unsigned char* lds, unsigned long long t_end) {
    if (!BG_ON) return;
    int tid_o = threadIdx.x; asm volatile("" : "+v"(tid_o));
    const int tid = tid_o, lane = tid & 63, wave = __builtin_amdgcn_readfirstlane(tid >> 6);
    LAS float* scr = (LAS float*)(lds + wave * 16640); unsigned* cur = (unsigned*)(c.ws + WS_CTL) + CW_BGCUR;
    for (;;) {
        if (__builtin_amdgcn_s_memrealtime() >= t_end) break;
        unsigned j = 0; if (lane == 0) j = __hip_atomic_fetch_add(cur, 1u, __ATOMIC_RELAXED, __HIP_MEMORY_SCOPE_AGENT);
        j = (unsigned)__builtin_amdgcn_readfirstlane((int)j);
        if (j >= (unsigned)BG_TOTAL) break;
        const int it = (int)j < BG_MGU ? CV_MGU0 + BG_MGU + (int)j : CV_MD0 + BG_MD + ((int)j - BG_MGU);
        cvt_job(c, it, scr, lane);
    }
}

__device__ __forceinline__ u32x4 sum_partials(const bf16* p) {
    float s[8] = {0.f, 0.f, 0.f, 0.f, 0.f, 0.f, 0.f, 0.f};
#pragma unroll
    for (int k = 0; k < MOE_TS; ++k) { const u32x4 q = *(const u32x4*)(p + (size_t)k * 8 * 256 * D);
        s[0] += bflo(q.x); s[1] += bfhi(q.x); s[2] += bflo(q.y); s[3] += bfhi(q.y); s[4] += bflo(q.z); s[5] += bfhi(q.z); s[6] += bflo(q.w); s[7] += bfhi(q.w); }
    u32x4 o; o.x = cvt_pk_bf16(s[0], s[1]); o.y = cvt_pk_bf16(s[2], s[3]); o.z = cvt_pk_bf16(s[4], s[5]); o.w = cvt_pk_bf16(s[6], s[7]); return o;
}
constexpr int W8S = 1028;
template <int MODE>
__device__ __forceinline__ void norm_phase(const Ctx& c, int l, bool combine, LAS unsigned char* lds) {
    int tid_o = threadIdx.x; asm volatile("" : "+v"(tid_o));
    const int tid = tid_o, lane = tid & 63, wave = __builtin_amdgcn_readfirstlane(tid >> 6);
    LAS float* w8 = (LAS float*)lds; LAS int* cnt = (LAS int*)(lds + 8 * W8S * 4);
    _Float16* h = (_Float16*)(c.ws + WS_H); bf16* xn = (bf16*)(c.ws + WS_XN); const bool from_x = (MODE == 1 && l == 0);
    const float* gain = MODE == 1 ? c.in[IN_NORM_MIX_G] + l * D : (MODE == 3 ? c.in[IN_NORM_FINAL_G] : c.in[IN_NORM_FFN_G] + l * D);
    if (MODE == 1 || MODE == 2) {
        const float* wsrc = MODE == 1 ? c.in[IN_W_IN] + (size_t)l * D * DIN + 2048 : c.in[IN_MOE_WR] + (size_t)(l >> 1) * D * NE; const int ldw = MODE == 1 ? DIN : NE;
        for (int i = tid; i < 8 * D; i += NTHR) { const int k = i >> 3, j = i & 7; w8[j * W8S + k] = wsrc[(size_t)k * ldw + j]; }
    }
    f32x8 gg[2];
#pragma unroll
    for (int j = 0; j < 2; ++j) gg[j] = *(const f32x8*)(gain + 8 * (lane + 64 * j));
    const int* pos = (const int*)(c.ws + WS_POS); const float* ew = (const float*)(c.ws + WS_EW); const bf16* Y = (const bf16*)(c.ws + WS_XG); const bf16* Y1 = (const bf16*)(c.ws + WS_Y1);
    for (int tb = opaque_bid(); tb < T / 64; tb += gridDim.x) {
        if (MODE == 2) { if (tid < 8) cnt[tid] = 0; }
        __syncthreads();
        for (int ib = 0; ib < 8; ib += 4) {
          f32x8 vb[4][2]; int pp0[4], pp1[4]; float ww0[4], ww1[4];
          if (from_x) {
#pragma unroll
              for (int r = 0; r < 4; ++r)
#pragma unroll
                  for (int j = 0; j < 2; ++j) vb[r][j] = *(const f32x8*)(c.in[IN_X] + (size_t)(tb * 64 + wave * 8 + ib + r) * D + 8 * (lane + 64 * j));
          } else { h16x8 hb[4][2];
#pragma unroll
              for (int r = 0; r < 4; ++r)
#pragma unroll
                  for (int j = 0; j < 2; ++j) hb[r][j] = *(const h16x8*)(h + (size_t)(tb * 64 + wave * 8 + ib + r) * D + 8 * (lane + 64 * j));
#pragma unroll
              for (int r = 0; r < 4; ++r)
#pragma unroll
                  for (int j = 0; j < 2; ++j) vb[r][j] = __builtin_convertvector(hb[r][j], f32x8);
          }
          if (combine) {
#pragma unroll
              for (int r = 0; r < 4; ++r) { const int t = tb * 64 + wave * 8 + ib + r; pp0[r] = pos[2 * t]; pp1[r] = pos[2 * t + 1]; ww0[r] = ew[2 * t]; ww1[r] = ew[2 * t + 1]; }
          }
#pragma unroll
          for (int r = 0; r < 4; ++r) {
            const int t = tb * 64 + wave * 8 + ib + r; f32x8 v[2]; v[0] = vb[r][0]; v[1] = vb[r][1];
            if (combine) {
                const int p0 = pp0[r], p1 = pp1[r]; const float w0 = ww0[r], w1 = ww1[r];
#pragma unroll
                for (int j = 0; j < 2; ++j) { const size_t o0 = (size_t)p0 * D + 8 * (lane + 64 * j), o1 = (size_t)p1 * D + 8 * (lane + 64 * j);
                    u32x4 a, b;
                    if (p0 < MOE_FULL * 256) a = *(const u32x4*)(Y + o0); else a = sum_partials(Y1 + o0 - (size_t)MOE_FULL * 256 * D);
                    if (p1 < MOE_FULL * 256) b = *(const u32x4*)(Y + o1); else b = sum_partials(Y1 + o1 - (size_t)MOE_FULL * 256 * D);
                    if (MOE_KS == 2) { const u32x4 a2 = *(const u32x4*)(Y1 + o0), b2 = *(const u32x4*)(Y1 + o1);
#pragma unroll
                        for (int q = 0; q < 4; ++q) { v[j][2 * q] += w0 * (bflo(a[q]) + bflo(a2[q])) + w1 * (bflo(b[q]) + bflo(b2[q])); v[j][2 * q + 1] += w0 * (bfhi(a[q]) + bfhi(a2[q])) + w1 * (bfhi(b[q]) + bfhi(b2[q])); }
                    } else {
#pragma unroll
                        for (int q = 0; q < 4; ++q) { v[j][2 * q] += w0 * bflo(a[q]) + w1 * bflo(b[q]); v[j][2 * q + 1] += w0 * bfhi(a[q]) + w1 * bfhi(b[q]); } } }
                if (MODE != 3) {
#pragma unroll
                    for (int j = 0; j < 2; ++j) *(h16x8*)(h + (size_t)t * D + 8 * (lane + 64 * j)) = __builtin_convertvector(v[j], h16x8); }
            }
            float s = 0.f;
#pragma unroll
            for (int j = 0; j < 2; ++j)
#pragma unroll
                for (int q = 0; q < 8; ++q) s += v[j][q] * v[j][q];
            const float rn = rsqrtf(wave_sum(s) * (1.f / D) + EPS);
#pragma unroll
            for (int j = 0; j < 2; ++j) v[j] = v[j] * rn * gg[j];
            if (MODE == 3) {
#pragma unroll
                for (int j = 0; j < 2; ++j) *(f32x8*)(c.out + (size_t)t * D + 8 * (lane + 64 * j)) = v[j];
            } else {
#pragma unroll
                for (int j = 0; j < 2; ++j) { u32x4 o; o.x = cvt_pk_bf16(v[j][0], v[j][1]); o.y = cvt_pk_bf16(v[j][2], v[j][3]); o.z = cvt_pk_bf16(v[j][4], v[j][5]); o.w = cvt_pk_bf16(v[j][6], v[j][7]);
                    *(u32x4*)(xn + (size_t)t * D + 8 * (lane + 64 * j)) = o; }
            }
            if (MODE == 1 || MODE == 2) {
                float d8[8];
#pragma unroll
                for (int g = 0; g < 8; ++g) { float a = 0.f;
#pragma unroll
                    for (int rp = 0; rp < DOTREP; ++rp) {
                    { f32x2 a2 = {0.f, 0.f};
#pragma unroll
                    for (int j = 0; j < 2; ++j) { const f32x4 wa = *(const LAS f32x4*)(w8 + g * W8S + 8 * (lane + 64 * j)), wb = *(const LAS f32x4*)(w8 + g * W8S + 8 * (lane + 64 * j) + 4);
                        a2 += (f32x2){v[j][0], v[j][1]} * (f32x2){wa[0], wa[1]}; a2 += (f32x2){v[j][2], v[j][3]} * (f32x2){wa[2], wa[3]};
                        a2 += (f32x2){v[j][4], v[j][5]} * (f32x2){wb[0], wb[1]}; a2 += (f32x2){v[j][6], v[j][7]} * (f32x2){wb[2], wb[3]}; }
                    a += a2[0] + a2[1]; }
                    if (DOTREP > 1) asm volatile("" : "+v"(a) :: "memory"); }
                    a *= (1.0f / DOTREP);
                    d8[g] = (MODE == 2) ? wave_sum(a) : a; }
                if (MODE == 1) {
                    float e4[4], e2[2];
#pragma unroll
                    for (int q = 0; q < 4; ++q) { const bool hi = (lane & 4) != 0; const float keep = hi ? d8[4 + q] : d8[q], send = hi ? d8[q] : d8[4 + q]; e4[q] = keep + __shfl_xor(send, 4); }
#pragma unroll
                    for (int q = 0; q < 2; ++q) { const bool hi = (lane & 2) != 0; const float keep = hi ? e4[2 + q] : e4[q], send = hi ? e4[q] : e4[2 + q]; e2[q] = keep + __shfl_xor(send, 2); }
                    float sel; { const bool hi = (lane & 1) != 0; const float keep = hi ? e2[1] : e2[0], send = hi ? e2[0] : e2[1]; sel = keep + __shfl_xor(send, 1); }
                    sel += __shfl_xor(sel, 8); sel += __shfl_xor(sel, 16); sel += __shfl_xor(sel, 32);
                    if (lane < 8) ((float*)(c.ws + WS_IFP))[(size_t)t * 8 + lane] = sel + c.in[IN_ML_B_IF][l * 8 + lane];
                } else {
                    int i0 = 0; float v0 = d8[0];
#pragma unroll
                    for (int e = 1; e < NE; ++e) if (d8[e] > v0) { v0 = d8[e]; i0 = e; }
                    int i1 = -1; float v1 = -3.4e38f;
#pragma unroll
                    for (int e = 0; e < NE; ++e) if (e != i0 && d8[e] > v1) { v1 = d8[e]; i1 = e; }
                    if (lane == 0) { int* eidx = (int*)(c.ws + WS_EIDX); float* eww = (float*)(c.ws + WS_EW); eidx[2 * t] = i0; eidx[2 * t + 1] = i1;
                        const float w0 = 1.f / (1.f + __expf(v1 - v0)); eww[2 * t] = w0; eww[2 * t + 1] = 1.f - w0;
                        __hip_atomic_fetch_add(&cnt[i0], 1, __ATOMIC_RELAXED, __HIP_MEMORY_SCOPE_WORKGROUP); __hip_atomic_fetch_add(&cnt[i1], 1, __ATOMIC_RELAXED, __HIP_MEMORY_SCOPE_WORKGROUP); }
                }
            }
        }
        }
        if (MODE == 2) { __syncthreads(); if (tid < 8) ((int*)(c.ws + WS_BLKCNT))[tb * 8 + tid] = cnt[tid]; }
    }
}

constexpr int RS_OFF = 131072, RS_MAXU = 24;
template <class Sched>
__device__ __forceinline__ void prep_rstd(const Sched& S, const float* SSQ, LAS unsigned char* lds) {
    int tid_o = threadIdx.x; asm volatile("" : "+v"(tid_o));
    const int tid = tid_o, r = tid >> 1, hf = tid & 1; LAS float* RS = (LAS float*)(lds + RS_OFF); pg8::Unit u;
    for (int i = 0; i < RS_MAXU && S.next(i, u); ++i) {
        const float* p = SSQ + (size_t)(u.pm * 256 + r) * 16 + 8 * hf; const f32x4 a = *(const f32x4*)p, b = *(const f32x4*)(p + 4);
        float s = ((a[0] + a[1]) + (a[2] + a[3])) + ((b[0] + b[1]) + (b[2] + b[3])); s += __shfl_xor(s, 1);
        if (hf == 0) RS[i * 256 + r] = rsqrtf(s * (1.f / D) + EPS);
    }
    __syncthreads();
}
__device__ __forceinline__ void gate_job(const Ctx& c, int l, LAS unsigned char* lds) {
    int tid_o = threadIdx.x; asm volatile("" : "+v"(tid_o));
    const int tid = tid_o, lane = tid & 63, wave = __builtin_amdgcn_readfirstlane(tid >> 6);
    LAS float* w8 = (LAS float*)lds; const bf16* xa = (const bf16*)(c.ws + WS_XN); const float* SSQ = (const float*)(c.ws + WS_SSQ);
    { const float* wsrc = c.in[IN_W_IN] + (size_t)l * D * DIN + 2048;
      for (int i = tid; i < 8 * D; i += NTHR) { const int k = i >> 3, j = i & 7; w8[j * W8S + k] = wsrc[(size_t)k * DIN + j]; } }
    for (int tb = opaque_bid(); tb < T / 64; tb += gridDim.x) {
        __syncthreads();
        for (int i = 0; i < 8; ++i) {
            const int t = tb * 64 + wave * 8 + i; f32x8 v[2];
#pragma unroll
            for (int j = 0; j < 2; ++j) { const u32x4 q = *(const u32x4*)(xa + (size_t)t * D + 8 * (lane + 64 * j));
                v[j][0] = bflo(q.x); v[j][1] = bfhi(q.x); v[j][2] = bflo(q.y); v[j][3] = bfhi(q.y); v[j][4] = bflo(q.z); v[j][5] = bfhi(q.z); v[j][6] = bflo(q.w); v[j][7] = bfhi(q.w); }
            const float sp = lane < 16 ? SSQ[(size_t)t * 16 + lane] : 0.f; const float r = rsqrtf(wave_sum(sp) * (1.f / D) + EPS);
            float d8[8];
#pragma unroll
            for (int g = 0; g < 8; ++g) { float a = 0.f;
#pragma unroll
                for (int j = 0; j < 2; ++j) { const f32x4 wa = *(const LAS f32x4*)(w8 + g * W8S + 8 * (lane + 64 * j)), wb = *(const LAS f32x4*)(w8 + g * W8S + 8 * (lane + 64 * j) + 4);
                    a += (v[j][0] * wa[0] + v[j][1] * wa[1]) + (v[j][2] * wa[2] + v[j][3] * wa[3]) + (v[j][4] * wb[0] + v[j][5] * wb[1]) + (v[j][6] * wb[2] + v[j][7] * wb[3]); }
                d8[g] = wave_sum(a); }
            float sel = d8[0];
#pragma unroll
            for (int g = 1; g < 8; ++g) sel = (lane == g) ? d8[g] : sel;
            if (lane < 8) ((float*)(c.ws + WS_IFP))[(size_t)t * 8 + lane] = sel * r + c.in[IN_ML_B_IF][l * 8 + lane];
        }
    }
}

__device__ __forceinline__ void moe_gather_phase(const Ctx& c, LAS unsigned char* lds) {
    int tid_o = threadIdx.x; asm volatile("" : "+v"(tid_o));
    const int tid = tid_o, lane = tid & 63, wave = __builtin_amdgcn_readfirstlane(tid >> 6);
    LAS int* tot = (LAS int*)lds; LAS int* bef = tot + 8; LAS int* off = tot + 16; LAS int* lpos = tot + 32;
    const int* blkcnt = (const int*)(c.ws + WS_BLKCNT); const int* eidx = (const int*)(c.ws + WS_EIDX); int* pos = (int*)(c.ws + WS_POS); int* meta = (int*)(c.ws + WS_META);
    const bf16* xn = (const bf16*)(c.ws + WS_XN); bf16* Xg = (bf16*)(c.ws + WS_XG);
    for (int tb = opaque_bid(); tb < T / 64; tb += gridDim.x) {
        __syncthreads();
        if (tid < 16) tot[tid] = 0;
        __syncthreads();
        { const int e = tid & 7, part = tid >> 3; int st = 0, sb = 0;
#pragma unroll
          for (int q = 0; q < 4; ++q) { const int b = part * 4 + q; const int v = blkcnt[b * 8 + e]; st += v; sb += (b < tb) ? v : 0; }
          __hip_atomic_fetch_add(&tot[e], st, __ATOMIC_RELAXED, __HIP_MEMORY_SCOPE_WORKGROUP); __hip_atomic_fetch_add(&bef[e], sb, __ATOMIC_RELAXED, __HIP_MEMORY_SCOPE_WORKGROUP); }
        __syncthreads();
        if (tid == 0) { int o = 0; for (int e = 0; e < NE; ++e) { off[e] = o; o += (tot[e] + 255) & ~255; } off[NE] = o; }
        __syncthreads();
        if (wave == 0) {
            const int t = tb * 64 + lane; const int e0 = eidx[2 * t], e1 = eidx[2 * t + 1]; int r0 = 0, r1 = 0; const unsigned long long lt = (1ull << lane) - 1ull;
#pragma unroll
            for (int e = 0; e < NE; ++e) { const unsigned long long m0 = __ballot(e0 == e), m1 = __ballot(e1 == e);
                if (e0 == e) r0 = __popcll(m0 & lt); if (e1 == e) r1 = __popcll(m0) + __popcll(m1 & lt); }
            const int p0 = off[e0] + bef[e0] + r0, p1 = off[e1] + bef[e1] + r1;
            pos[2 * t] = p0; pos[2 * t + 1] = p1; lpos[2 * lane] = p0; lpos[2 * lane + 1] = p1;
        }
        __syncthreads();
        for (int q0 = wave; q0 < 128; q0 += 4 * NWAVES) { u32x4 ra[4], rb[4]; int pq[4];
#pragma unroll
            for (int r = 0; r < 4; ++r) { const int q = q0 + r * NWAVES; const u32x4* s = (const u32x4*)(xn + (size_t)(tb * 64 + (q >> 1)) * D); ra[r] = s[lane]; rb[r] = s[lane + 64]; pq[r] = lpos[q]; }
#pragma unroll
            for (int r = 0; r < 4; ++r) { u32x4* d = (u32x4*)(Xg + (size_t)pq[r] * D); d[lane] = ra[r]; d[lane + 64] = rb[r]; } }
        if (tb < NE) { const int r0 = off[tb] + tot[tb], r1 = off[tb + 1]; const u32x4 zz = {0u, 0u, 0u, 0u};
            for (int r = r0 + wave; r < r1; r += NWAVES) { u32x4* d = (u32x4*)(Xg + (size_t)r * D); d[lane] = zz; d[lane + 64] = zz; } }
        if (tb == 0) { if (tid < 9) meta[tid] = off[tid]; if (tid == 0) meta[16] = off[NE] >> 8;
            for (int tl = tid; tl < MAXT256; tl += NTHR) { const int r = tl * 256; int e = 0;
#pragma unroll
                for (int q = 0; q < NE; ++q) if (r >= off[q]) e = q;
                meta[32 + tl] = e; } }
    }
}


typedef short s16x4 __attribute__((ext_vector_type(4)));
#ifndef REP_MASK
#define REP_MASK 0
#endif
constexpr size_t SM_CG = WS_SMALL, SM_CM = WS_SMALL + 4096, SM_MP = WS_SMALL + 8192;
constexpr size_t SM_NL = WS_SMALL + 65536, SM_NP = WS_SMALL + 327680;
constexpr size_t SM_RGA = WS_SMALL + 589824, SM_RGH = WS_SMALL + 1114112;
constexpr size_t SM_RGC = 5 * MiB;
constexpr int TROW = 272;
constexpr int TILE_B = 128 * TROW;
constexpr float KSC = 0.08838834764831845f;

__device__ __forceinline__ float wscan_add(float v, int lane) {
#pragma unroll
    for (int o = 1; o < 64; o <<= 1) { const float t = __shfl_up(v, o); v = (lane >= o) ? v + t : v; }
    return v;
}
__device__ __forceinline__ float wscan_max(float v, int lane) {
#pragma unroll
    for (int o = 1; o < 64; o <<= 1) { const float t = __shfl_up(v, o); v = (lane >= o) ? fmaxf(v, t) : v; }
    return v;
}
__device__ __forceinline__ float wave_max(float v) {
#pragma unroll
    for (int o = 1; o < 64; o <<= 1) v = fmaxf(v, __shfl_xor(v, o));
    return v;
}
__device__ __forceinline__ float logsigmoidf_(float x) { return -log1pf(__expf(-x)); }
__device__ __forceinline__ void stage_tile(const bf16* __restrict__ g, int ldg, LAS unsigned char* tile, int tid) {
#pragma unroll
    for (int i = 0; i < 4; ++i) { const int ch = tid + NTHR * i, r = ch >> 4, c16 = ch & 15; const u32x4 v = *(const u32x4*)(g + (size_t)r * ldg + c16 * 8); *(LAS u32x4*)(tile + r * TROW + c16 * 16) = v; }
}
__device__ __forceinline__ bf16x8 frag_row(const LAS unsigned char* tile, int row, int ks, int fq) { return *(const LAS bf16x8*)(tile + row * TROW + (32 * ks + 8 * fq) * 2); }
__device__ __forceinline__ bf16x8 frag_tr(const LAS unsigned char* tile, int n0, int ks, int lane) {
    const int i16 = lane & 15, q = i16 >> 2, p = i16 & 3, fq = lane >> 4;
    const LAS unsigned char* a = tile + (32 * ks + 8 * fq + q) * TROW + n0 * 2 + 8 * p;
    const s16x4 lo = __builtin_amdgcn_ds_read_tr16_b64_v4i16((LAS s16x4*)a), hi = __builtin_amdgcn_ds_read_tr16_b64_v4i16((LAS s16x4*)(a + 4 * TROW));
    return __builtin_shufflevector(lo, hi, 0, 1, 2, 3, 4, 5, 6, 7);
}
#define MFMA16(a, b, c) __builtin_amdgcn_mfma_f32_16x16x32_bf16((a), (b), (c), 0, 0, 0)

constexpr int CGRP_B = 73728;
__device__ __forceinline__ void mix_c_mlstm(const Ctx& c, int u, LAS unsigned char* lds, int tid, int lane, int wave) {
    const int bh = u >> 5, ck = u & 31, b = bh >> 2, h = bh & 3; const size_t t0 = (size_t)b * SEQ + (size_t)ck * 128;
    LAS unsigned char* TKW = lds; LAS unsigned char* TV = lds + TILE_B; LAS float* fw = (LAS float*)(lds + 2 * TILE_B); LAS float* np = fw + 128;
    const float* ifp = (const float*)(c.ws + WS_IFP); const bf16* z = (const bf16*)(c.ws + WS_Z);
    u32x4 kv[8], vv[8];
#pragma unroll
    for (int i = 0; i < 8; ++i) { const int ch = tid + 256 * i, r = ch >> 4, c16 = ch & 15; const bf16* row = z + (t0 + r) * NZ + h * DH + c16 * 8; kv[i] = *(const u32x4*)(row + ZK); vv[i] = *(const u32x4*)(row + ZV); }
    if (wave == 0) {
        const float x0 = ifp[(t0 + 2 * lane) * 8 + 4 + h], x1 = ifp[(t0 + 2 * lane + 1) * 8 + 4 + h];
        const float li0 = ifp[(t0 + 2 * lane) * 8 + h], li1 = ifp[(t0 + 2 * lane + 1) * 8 + h];
        const float lf0 = logsigmoidf_(x0), lf1 = logsigmoidf_(x1), s = lf0 + lf1, inc = wscan_add(s, lane), ex = inc - s, b0 = ex + lf0, b1 = b0 + lf1;
        const float g = __shfl(inc, 63);
        const float a0 = g - b0 + li0, a1 = g - b1 + li1, m = wave_max(fmaxf(a0, a1));
        fw[2 * lane] = __expf(a0 - m) * KSC; fw[2 * lane + 1] = __expf(a1 - m) * KSC;
        if (lane == 0) { ((float*)(c.ws + SM_CG))[bh * 32 + ck] = g; ((float*)(c.ws + SM_CM))[bh * 32 + ck] = m; }
    }
    __syncthreads();
#pragma unroll
    for (int i = 0; i < 8; ++i) { const int ch = tid + 256 * i, r = ch >> 4, c16 = ch & 15; const float sc = fw[r]; u32x4 ko;
        ko.x = cvt_pk_bf16(bflo(kv[i].x) * sc, bfhi(kv[i].x) * sc); ko.y = cvt_pk_bf16(bflo(kv[i].y) * sc, bfhi(kv[i].y) * sc); ko.z = cvt_pk_bf16(bflo(kv[i].z) * sc, bfhi(kv[i].z) * sc); ko.w = cvt_pk_bf16(bflo(kv[i].w) * sc, bfhi(kv[i].w) * sc);
        *(LAS u32x4*)(TKW + r * TROW + c16 * 16) = ko; *(LAS u32x4*)(TV + r * TROW + c16 * 16) = vv[i]; }
    __syncthreads();
    { const int d = tid & 127, q = tid >> 7; float s = 0.f;
#pragma unroll 16
      for (int l = 64 * q; l < 64 * q + 64; ++l) s += bf2f(*(const LAS bf16*)(TKW + l * TROW + d * 2));
      np[q * 128 + d] = s; }
    const int wr = wave >> 1, wc = wave & 1, fr = lane & 15, fq = lane >> 4;
    f32x4 acc[4][4];
#pragma unroll
    for (int i = 0; i < 4; ++i)
#pragma unroll
        for (int j = 0; j < 4; ++j) acc[i][j] = (f32x4){0.f, 0.f, 0.f, 0.f};
#pragma unroll
    for (int ks = 0; ks < 4; ++ks) { bf16x8 A[4], B[4];
#pragma unroll
        for (int dt = 0; dt < 4; ++dt) A[dt] = frag_tr(TKW, 64 * wr + 16 * dt, ks, lane);
#pragma unroll
        for (int et = 0; et < 4; ++et) B[et] = frag_tr(TV, 64 * wc + 16 * et, ks, lane);
#pragma unroll
        for (int dt = 0; dt < 4; ++dt)
#pragma unroll
            for (int et = 0; et < 4; ++et) acc[dt][et] = MFMA16(A[dt], B[et], acc[dt][et]); }
    bf16* CTL = (bf16*)(c.ws + WS_CTL_LOC) + ((size_t)(bh * 32 + ck) << 14);
#pragma unroll
    for (int dt = 0; dt < 4; ++dt)
#pragma unroll
        for (int et = 0; et < 4; ++et) { u32x2 o; o.x = cvt_pk_bf16_c(acc[dt][et][0], acc[dt][et][1]); o.y = cvt_pk_bf16_c(acc[dt][et][2], acc[dt][et][3]);
            *(u32x2*)(CTL + (size_t)(64 * wc + 16 * et + fr) * 128 + 64 * wr + 16 * dt + 4 * fq) = o; }
    __syncthreads();
    if (tid < 128) ((float*)(c.ws + SM_NL))[(size_t)(bh * 32 + ck) * 128 + tid] = np[tid] + np[128 + tid];
    __syncthreads();
}

__device__ __forceinline__ float fsig(float x) { return __builtin_amdgcn_rcpf(1.f + __expf(-x)); }
__device__ __forceinline__ void mix_c_rg(const Ctx& c, int l, int u, LAS unsigned char* lds, int lane, int wave) {
    const int b = u >> 6, ck = u & 63, g = wave; const size_t t0 = (size_t)b * SEQ + (size_t)ck * 64;
    LAS unsigned char* XC = lds + wave * 9216;
    const bf16* z = (const bf16*)(c.ws + WS_Z); const int l15 = lane & 15, fq = lane >> 4;
    {
        const int c4 = 64 * g + 4 * l15; const float* cw = c.in[IN_CONV_W] + l * 4 * RGW + c4; const f32x4 w0 = *(const f32x4*)cw, w1 = *(const f32x4*)(cw + RGW), w2 = *(const f32x4*)(cw + 2 * RGW), w3 = *(const f32x4*)(cw + 3 * RGW), cb = *(const f32x4*)(c.in[IN_CONV_B] + l * RGW + c4);
        u32x2 xr[19];
#pragma unroll
        for (int j = 0; j < 19; ++j) { const int tt = 16 * fq - 3 + j; const bool okk = (ck * 64 + tt >= 0); const u32x2 v = *(const u32x2*)(z + (size_t)((long)t0 + (okk ? tt : 0)) * NZ + ZRX + c4); xr[j].x = okk ? v.x : 0u; xr[j].y = okk ? v.y : 0u; }
#pragma unroll
        for (int j = 0; j < 16; ++j) { f32x4 xc;
            xc[0] = cb[0] + w0[0] * bflo(xr[j].x) + w1[0] * bflo(xr[j + 1].x) + w2[0] * bflo(xr[j + 2].x) + w3[0] * bflo(xr[j + 3].x);
            xc[1] = cb[1] + w0[1] * bfhi(xr[j].x) + w1[1] * bfhi(xr[j + 1].x) + w2[1] * bfhi(xr[j + 2].x) + w3[1] * bfhi(xr[j + 3].x);
            xc[2] = cb[2] + w0[2] * bflo(xr[j].y) + w1[2] * bflo(xr[j + 1].y) + w2[2] * bflo(xr[j + 2].y) + w3[2] * bflo(xr[j + 3].y);
            xc[3] = cb[3] + w0[3] * bfhi(xr[j].y) + w1[3] * bfhi(xr[j + 1].y) + w2[3] * bfhi(xr[j + 2].y) + w3[3] * bfhi(xr[j + 3].y);
            u32x2 o; o.x = cvt_pk_bf16(xc[0], xc[1]); o.y = cvt_pk_bf16(xc[2], xc[3]); *(LAS u32x2*)(XC + (16 * fq + j) * 144 + l15 * 8) = o; }
    }
    bf16x8 Af[4][2];
#pragma unroll
    for (int m = 0; m < 4; ++m)
#pragma unroll
        for (int ks = 0; ks < 2; ++ks) Af[m][ks] = *(const LAS bf16x8*)(XC + (16 * m + l15) * 144 + (32 * ks + 8 * fq) * 2);
    const bf16* WTa = (const bf16*)(c.ws + WS_WRG) + (size_t)((l * 2 + 0) * RGB + g) * RGD * RGD; const bf16* WTx = (const bf16*)(c.ws + WS_WRG) + (size_t)((l * 2 + 1) * RGB + g) * RGD * RGD;
    unsigned* RP = (unsigned*)(c.ws + WS_RA);
#pragma unroll
    for (int n = 0; n < 4; ++n) {
        const int jo = 16 * n + l15, cc = 64 * g + jo;
        f32x4 aa[4], ax[4];
#pragma unroll
        for (int m = 0; m < 4; ++m) { aa[m] = (f32x4){0.f, 0.f, 0.f, 0.f}; ax[m] = (f32x4){0.f, 0.f, 0.f, 0.f}; }
#pragma unroll
        for (int ks = 0; ks < 2; ++ks) { const bf16x8 Ba = *(const bf16x8*)(WTa + jo * RGD + 32 * ks + 8 * fq), Bx = *(const bf16x8*)(WTx + jo * RGD + 32 * ks + 8 * fq);
#pragma unroll
            for (int m = 0; m < 4; ++m) { aa[m] = MFMA16(Af[m][ks], Ba, aa[m]); ax[m] = MFMA16(Af[m][ks], Bx, ax[m]); } }
        const float ba = c.in[IN_RG_B_A][l * RGW + cc], bx = c.in[IN_RG_B_X][l * RGW + cc], sp8 = -8.f * __logf(1.f + __expf(-c.in[IN_RG_LAM][l * RGW + cc]));
        float cA[4][4], hL[4][4], SA[4], SH[4];
#pragma unroll
        for (int m = 0; m < 4; ++m) { float Ar = 1.f, Hr = 0.f;
#pragma unroll
            for (int r = 0; r < 4; ++r) { const int t = 16 * m + 4 * fq + r;
                const float la = sp8 * fsig(aa[m][r] + ba), a = __expf(la), ig = fsig(ax[m][r] + bx), xcv = bf2f(*(const LAS bf16*)(XC + t * 144 + jo * 2));
                const float tt = -2.f * la, ser = tt * (1.f - tt * (0.5f - tt * (0.16666667f - tt * (0.041666668f - tt * 0.0083333333f)))), om = tt < 0.25f ? ser : 1.f - a * a;
                const float uu = __builtin_amdgcn_sqrtf(om) * (ig * xcv);
                Hr = a * Hr + uu; Ar *= a; cA[m][r] = Ar; hL[m][r] = Hr; }
            SA[m] = Ar; SH[m] = Hr; }
        float CA = 1.f, CH = 0.f; unsigned* rp = RP + (t0 + 4 * fq) * RGW + cc;
#pragma unroll
        for (int m = 0; m < 4; ++m) {
            float IA = SA[m], IH = SH[m];
            { const float Ap = __shfl_up(IA, 16), Hp = __shfl_up(IH, 16); if (fq >= 1) { IH = IA * Hp + IH; IA = IA * Ap; } }
            { const float Ap = __shfl_up(IA, 32), Hp = __shfl_up(IH, 32); if (fq >= 2) { IH = IA * Hp + IH; IA = IA * Ap; } }
            float EA = __shfl_up(IA, 16), EH = __shfl_up(IH, 16); if (fq == 0) { EA = 1.f; EH = 0.f; }
            const float TA = __shfl(IA, l15 + 48), TH = __shfl(IH, l15 + 48);
            const float PA = CA * EA, PH = EA * CH + EH;
#pragma unroll
            for (int r = 0; r < 4; ++r) rp[(size_t)(16 * m + r) * RGW] = cvt_pk_bf16(PA * cA[m][r], hL[m][r] + cA[m][r] * PH);
            CH = TA * CH + TH; CA = CA * TA;
        }
        if (fq == 0) { ((float*)(c.ws + SM_RGA))[(size_t)(b * 64 + ck) * RGW + cc] = CA; ((float*)(c.ws + SM_RGH))[(size_t)(b * 64 + ck) * RGW + cc] = CH; }
    }
}

__device__ __forceinline__ void mix_d(const Ctx& c, LAS unsigned char* lds, int tid, int lane, int wave) {
    for (int w = opaque_bid(); w < 256; w += gridDim.x) {
        const int bh = w >> 4, sl = w & 15; LAS float* sg = (LAS float*)lds; LAS float* sm = sg + 32;
        __syncthreads();
        if (tid < 32) { sg[tid] = ((const float*)(c.ws + SM_CG))[bh * 32 + tid]; sm[tid] = ((const float*)(c.ws + SM_CM))[bh * 32 + tid]; }
        __syncthreads();
        const int idx = tid * 2, el = idx >> 7, d = idx & 127; const size_t off = (size_t)(8 * sl + el) * 128 + d;
        const bf16* CTL = (const bf16*)(c.ws + WS_CTL_LOC) + ((size_t)(bh * 32) << 14) + off; bf16* CTP = (bf16*)(c.ws + WS_CTP) + ((size_t)(bh * 32) << 14) + off;
        const bool nown = (sl == 0 && tid < 128);
        const float* NL = (const float*)(c.ws + SM_NL) + (size_t)(bh * 32) * 128 + (tid & 127); float* NP = (float*)(c.ws + SM_NP) + (size_t)(bh * 32) * 128 + (tid & 127);
        unsigned ldw[32]; float nl[32];
#pragma unroll
        for (int ck = 0; ck < 32; ++ck) { ldw[ck] = *(const unsigned*)(CTL + ((size_t)ck << 14)); nl[ck] = nown ? NL[ck * 128] : 0.f; }
        f32x2 st = {0.f, 0.f}; float nst = 0.f, m = 0.f;
#pragma unroll
        for (int ck = 0; ck < 32; ++ck) {
            *(unsigned*)(CTP + ((size_t)ck << 14)) = cvt_pk_bf16(st.x, st.y);
            if (nown) NP[ck * 128] = nst;
            if (sl == 0 && tid == 0) ((float*)(c.ws + SM_MP))[bh * 32 + ck] = m;
            const float g = sg[ck], ml = sm[ck], mn = fmaxf(g + m, ml), so = __expf(g + m - mn), sc = __expf(ml - mn);
            st.x = st.x * so + bflo(ldw[ck]) * sc; st.y = st.y * so + bfhi(ldw[ck]) * sc; nst = nst * so + nl[ck] * sc; m = mn;
        }
    }
    for (int gw = opaque_bid() * NWAVES + wave; gw < BATCH * RGW; gw += gridDim.x * NWAVES) {
        const int b = gw >> 9, ch = gw & 511; const size_t o = (size_t)(b * 64 + lane) * RGW + ch;
        float A = ((const float*)(c.ws + SM_RGA))[o], H = ((const float*)(c.ws + SM_RGH))[o];
#pragma unroll
        for (int s = 1; s < 64; s <<= 1) { const float Ap = __shfl_up(A, s), Hp = __shfl_up(H, s); if (lane >= s) { H = A * Hp + H; A = A * Ap; } }
        float cin = __shfl_up(H, 1); if (lane == 0) cin = 0.f;
        ((float*)(c.ws + SM_RGC))[o] = cin;
    }
}

__device__ __forceinline__ void mix_e_mlstm(const Ctx& c, int l, int u, LAS unsigned char* lds, int tid, int lane, int wave) {
    const int bh = u >> 5, ck = u & 31, b = bh >> 2, h = bh & 3; const size_t t0 = (size_t)b * SEQ + (size_t)ck * 128;
    LAS unsigned char* TQ = lds; LAS unsigned char* TK = lds + TILE_B; LAS unsigned char* TV = lds + 2 * TILE_B; LAS unsigned char* TC = lds + 3 * TILE_B; LAS unsigned char* TS = TK;
    LAS float* fb = (LAS float*)(lds + 4 * TILE_B); LAS float* fcs = fb + 128; LAS float* fpm = fb + 256; LAS float* fisc = fb + 384; LAS float* fqn = fb + 512; LAS float* fnp = fb + 640;
    LAS float* pden = fb + 768; LAS float* pss = fb + 1280;
    const float* ifp = (const float*)(c.ws + WS_IFP); const bf16* z = (const bf16*)(c.ws + WS_Z);
    u32x4 sq[4], sk[4], sv[4], scp[4];
    { const bf16* cp = (const bf16*)(c.ws + WS_CTP) + ((size_t)(bh * 32 + ck) << 14);
#pragma unroll
      for (int i = 0; i < 4; ++i) { const int ch = tid + NTHR * i, r = ch >> 4, c16 = ch & 15; const bf16* row = z + (t0 + r) * NZ + h * DH + c16 * 8;
          sq[i] = *(const u32x4*)(row + ZQ); sk[i] = *(const u32x4*)(row + ZK); sv[i] = *(const u32x4*)(row + ZV); scp[i] = *(const u32x4*)(cp + (size_t)r * 128 + c16 * 8); } }
    const float npv = (tid < 128) ? ((const float*)(c.ws + SM_NP))[(size_t)(bh * 32 + ck) * 128 + tid] : 0.f;
    if (wave == 0) {
        const float x0 = ifp[(t0 + 2 * lane) * 8 + 4 + h], x1 = ifp[(t0 + 2 * lane + 1) * 8 + 4 + h];
        const float lf0 = logsigmoidf_(x0), lf1 = logsigmoidf_(x1), s = lf0 + lf1, inc = wscan_add(s, lane), ex = inc - s, b0 = ex + lf0, b1 = b0 + lf1;
        const float li0 = ifp[(t0 + 2 * lane) * 8 + h], li1 = ifp[(t0 + 2 * lane + 1) * 8 + h];
        const float cs0 = li0 - b0, cs1 = li1 - b1, p1 = fmaxf(cs0, cs1), incm = wscan_max(p1, lane);
        float exm = __shfl_up(incm, 1); if (lane == 0) exm = -3.0e38f;
        const float mp = ((const float*)(c.ws + SM_MP))[bh * 32 + ck];
        const float pm0 = fmaxf(fmaxf(exm, cs0), mp), pm1 = fmaxf(fmaxf(exm, p1), mp);
        fb[2 * lane] = b0; fb[2 * lane + 1] = b1; fcs[2 * lane] = cs0; fcs[2 * lane + 1] = cs1; fpm[2 * lane] = pm0; fpm[2 * lane + 1] = pm1;
        fisc[2 * lane] = __expf(mp - pm0); fisc[2 * lane + 1] = __expf(mp - pm1);
    }
#pragma unroll
    for (int i = 0; i < 4; ++i) { const int ch = tid + NTHR * i, r = ch >> 4, c16 = ch & 15; const int o = r * TROW + c16 * 16;
        *(LAS u32x4*)(TQ + o) = sq[i]; *(LAS u32x4*)(TK + o) = sk[i]; *(LAS u32x4*)(TV + o) = sv[i]; *(LAS u32x4*)(TC + o) = scp[i]; }
    if (tid < 128) fnp[tid] = npv;
    __syncthreads();
    { const int row = tid >> 2, qt = tid & 3; float s = 0.f;
#pragma unroll
      for (int i = 0; i < 4; ++i) { const u32x4 qv = *(const LAS u32x4*)(TQ + row * TROW + (32 * qt + 8 * i) * 2); const LAS float* nn = fnp + 32 * qt + 8 * i;
          s += bflo(qv.x) * nn[0] + bfhi(qv.x) * nn[1] + bflo(qv.y) * nn[2] + bfhi(qv.y) * nn[3] + bflo(qv.z) * nn[4] + bfhi(qv.z) * nn[5] + bflo(qv.w) * nn[6] + bfhi(qv.w) * nn[7]; }
      s += __shfl_xor(s, 1); s += __shfl_xor(s, 2); if (qt == 0) fqn[row] = s; }
    const int wr = wave >> 2, wc = wave & 3, fr = lane & 15, fq = lane >> 4;
    f32x4 aS[4][2];
#pragma unroll
    for (int i = 0; i < 4; ++i)
#pragma unroll
        for (int j = 0; j < 2; ++j) aS[i][j] = (f32x4){0.f, 0.f, 0.f, 0.f};
#pragma unroll
    for (int ks = 0; ks < 4; ++ks) { bf16x8 A[4], B[2];
#pragma unroll
        for (int m = 0; m < 4; ++m) A[m] = frag_row(TQ, 64 * wr + 16 * m + fr, ks, fq);
#pragma unroll
        for (int n = 0; n < 2; ++n) B[n] = frag_row(TK, 32 * wc + 16 * n + fr, ks, fq);
#pragma unroll
        for (int m = 0; m < 4; ++m)
#pragma unroll
            for (int n = 0; n < 2; ++n) aS[m][n] = MFMA16(B[n], A[m], aS[m][n]); }
    __syncthreads();
#pragma unroll
    for (int m = 0; m < 4; ++m) { const int lr = 64 * wr + 16 * m + fr; const float pm = fpm[lr]; float ds = 0.f;
#pragma unroll
        for (int n = 0; n < 2; ++n) { const int s0 = 32 * wc + 16 * n + 4 * fq; float v[4];
#pragma unroll
            for (int j = 0; j < 4; ++j) { const int s = s0 + j; const float wgt = (s <= lr) ? __expf(fcs[s] - pm) : 0.f; v[j] = aS[m][n][j] * wgt * KSC; ds += v[j]; }
            u32x2 o; o.x = cvt_pk_bf16(v[0], v[1]); o.y = cvt_pk_bf16(v[2], v[3]); *(LAS u32x2*)(TS + lr * TROW + s0 * 2) = o; }
        ds += __shfl_xor(ds, 16); ds += __shfl_xor(ds, 32); if (fq == 0) pden[lr * 4 + wc] = ds; }
    __syncthreads();
    f32x4 a1[4][2], a2[4][2];
#pragma unroll
    for (int i = 0; i < 4; ++i)
#pragma unroll
        for (int j = 0; j < 2; ++j) { a1[i][j] = (f32x4){0.f, 0.f, 0.f, 0.f}; a2[i][j] = (f32x4){0.f, 0.f, 0.f, 0.f}; }
#pragma unroll
    for (int ks = 0; ks < 4; ++ks) { bf16x8 A[4], B[2];
#pragma unroll
        for (int m = 0; m < 4; ++m) A[m] = frag_row(TS, 64 * wr + 16 * m + fr, ks, fq);
#pragma unroll
        for (int n = 0; n < 2; ++n) B[n] = frag_tr(TV, 32 * wc + 16 * n, ks, lane);
#pragma unroll
        for (int m = 0; m < 4; ++m)
#pragma unroll
            for (int n = 0; n < 2; ++n) a1[m][n] = MFMA16(B[n], A[m], a1[m][n]); }
#pragma unroll
    for (int ks = 0; ks < 4; ++ks) { bf16x8 A[4], B[2];
#pragma unroll
        for (int m = 0; m < 4; ++m) A[m] = frag_row(TQ, 64 * wr + 16 * m + fr, ks, fq);
#pragma unroll
        for (int n = 0; n < 2; ++n) B[n] = frag_row(TC, 32 * wc + 16 * n + fr, ks, fq);
#pragma unroll
        for (int m = 0; m < 4; ++m)
#pragma unroll
            for (int n = 0; n < 2; ++n) a2[m][n] = MFMA16(B[n], A[m], a2[m][n]); }
#pragma unroll
    for (int m = 0; m < 4; ++m) { const int lr = 64 * wr + 16 * m + fr; const float isc = fisc[lr];
        const float den = (pden[lr * 4] + pden[lr * 4 + 1]) + (pden[lr * 4 + 2] + pden[lr * 4 + 3]) + isc * fqn[lr];
        const float inv = 1.f / fmaxf(fabsf(den), __expf(-(fb[lr] + fpm[lr]))); float ss = 0.f;
#pragma unroll
        for (int n = 0; n < 2; ++n) { a1[m][n] = (a1[m][n] + a2[m][n] * isc) * inv; ss += (a1[m][n][0] * a1[m][n][0] + a1[m][n][1] * a1[m][n][1]) + (a1[m][n][2] * a1[m][n][2] + a1[m][n][3] * a1[m][n][3]); }
        ss += __shfl_xor(ss, 16); ss += __shfl_xor(ss, 32); if (fq == 0) pss[lr * 4 + wc] = ss; }
    __syncthreads();
    const float* gn = c.in[IN_ML_NORM_G] + l * MLW + h * DH; bf16* Y = (bf16*)(c.ws + WS_Y);
#pragma unroll
    for (int m = 0; m < 4; ++m) { const int lr = 64 * wr + 16 * m + fr; const float rstd = rsqrtf(((pss[lr * 4] + pss[lr * 4 + 1]) + (pss[lr * 4 + 2] + pss[lr * 4 + 3])) * (1.f / DH) + EPS);
#pragma unroll
        for (int n = 0; n < 2; ++n) { const int e0 = 32 * wc + 16 * n + 4 * fq; const u32x2 ov = *(const u32x2*)(z + (t0 + lr) * NZ + ZO + h * DH + e0); const f32x4 gv = *(const f32x4*)(gn + e0);
            const float y0 = sigmoidf_(bflo(ov.x)) * a1[m][n][0] * rstd * gv[0], y1 = sigmoidf_(bfhi(ov.x)) * a1[m][n][1] * rstd * gv[1];
            const float y2 = sigmoidf_(bflo(ov.y)) * a1[m][n][2] * rstd * gv[2], y3 = sigmoidf_(bfhi(ov.y)) * a1[m][n][3] * rstd * gv[3];
            u32x2 o; o.x = cvt_pk_bf16(y0, y1); o.y = cvt_pk_bf16(y2, y3); *(u32x2*)(Y + (t0 + lr) * D + h * DH + e0) = o; } }
    __syncthreads();
}

__device__ __forceinline__ void mix_e_rg(const Ctx& c, int l, int u, int lane, int wave) {
    const int b = u >> 6, ck = u & 63; const size_t t0 = (size_t)b * SEQ + (size_t)ck * 64;
    const unsigned* RP = (const unsigned*)(c.ws + WS_RA); const bf16* z = (const bf16*)(c.ws + WS_Z); bf16* Y = (bf16*)(c.ws + WS_Y);
    const float* cinp = (const float*)(c.ws + SM_RGC) + (size_t)(b * 64 + ck) * RGW + 8 * lane; const float* gp = c.in[IN_RG_NORM_G] + l * RGW + 8 * lane;
    const f32x4 ci0 = *(const f32x4*)cinp, ci1 = *(const f32x4*)(cinp + 4), g0 = *(const f32x4*)gp, g1 = *(const f32x4*)(gp + 4);
    u32x4 pa[8], pb[8], rgv[8];
#pragma unroll
    for (int i = 0; i < 8; ++i) { const size_t t = t0 + wave * 8 + i; pa[i] = *(const u32x4*)(RP + t * RGW + 8 * lane); pb[i] = *(const u32x4*)(RP + t * RGW + 8 * lane + 4); rgv[i] = *(const u32x4*)(z + t * NZ + ZRG + 8 * lane); }
#pragma unroll
    for (int i = 0; i < 8; ++i) { const size_t t = t0 + wave * 8 + i;
        const u32x4 p0 = pa[i], p1 = pb[i], rg = rgv[i];
        const f32x4 h0 = {bfhi(p0.x), bfhi(p0.y), bfhi(p0.z), bfhi(p0.w)}, h1 = {bfhi(p1.x), bfhi(p1.y), bfhi(p1.z), bfhi(p1.w)}, c0 = {bflo(p0.x), bflo(p0.y), bflo(p0.z), bflo(p0.w)}, c1 = {bflo(p1.x), bflo(p1.y), bflo(p1.z), bflo(p1.w)};
        const float gt[8] = {bflo(rg.x), bfhi(rg.x), bflo(rg.y), bfhi(rg.y), bflo(rg.z), bfhi(rg.z), bflo(rg.w), bfhi(rg.w)};
        const f32x4 hh0 = h0 + c0 * ci0, hh1 = h1 + c1 * ci1; float v[8]; float s = 0.f;
#pragma unroll
        for (int j = 0; j < 8; ++j) { const float x = gt[j], uu = 1.5957691216057308f * (x + 0.044715f * x * x * x), ge = x * __builtin_amdgcn_rcpf(1.f + __expf(-uu)); v[j] = (j < 4 ? hh0[j] : hh1[j - 4]) * ge; s += v[j] * v[j]; }
        const float r = rsqrtf(wave_sum(s) * (1.f / RGW) + EPS);
        u32x4 o; o.x = cvt_pk_bf16(v[0] * r * g0[0], v[1] * r * g0[1]); o.y = cvt_pk_bf16(v[2] * r * g0[2], v[3] * r * g0[3]); o.z = cvt_pk_bf16(v[4] * r * g1[0], v[5] * r * g1[1]); o.w = cvt_pk_bf16(v[6] * r * g1[2], v[7] * r * g1[3]);
        *(u32x4*)(Y + t * D + MLW + 8 * lane) = o; }
}
__device__ __forceinline__ void mix_c_phase(const Ctx& c, int l, LAS unsigned char* lds) {
    int tid_o = threadIdx.x; asm volatile("" : "+v"(tid_o)); const int tid = tid_o, lane = tid & 63, wave = __builtin_amdgcn_readfirstlane(tid >> 6);
    for (int rq = 0; rq < (((REP_MASK) >> 16) & 1 ? 2 : 1); ++rq) for (int w = opaque_bid(); w < 256; w += gridDim.x) mix_c_mlstm(c, 2 * w + (wave >> 2), lds + (wave >> 2) * CGRP_B, tid & 255, lane, wave & 3);
    for (int rq = 0; rq < (((REP_MASK) >> 17) & 1 ? 2 : 1); ++rq) for (int u = opaque_bid(); u < 256; u += gridDim.x) { mix_c_rg(c, l, u, lds, lane, wave); __syncthreads(); }
}
__device__ __forceinline__ void mix_d_phase(const Ctx& c, LAS unsigned char* lds) {
    int tid_o = threadIdx.x; asm volatile("" : "+v"(tid_o)); const int tid = tid_o, lane = tid & 63, wave = __builtin_amdgcn_readfirstlane(tid >> 6);
    mix_d(c, lds, tid, lane, wave);
}
__device__ __forceinline__ void mix_e_phase(const Ctx& c, int l, LAS unsigned char* lds) {
    int tid_o = threadIdx.x; asm volatile("" : "+v"(tid_o)); const int tid = tid_o, lane = tid & 63, wave = __builtin_amdgcn_readfirstlane(tid >> 6);
    for (int rq = 0; rq < (((REP_MASK) >> 18) & 1 ? 2 : 1); ++rq) for (int u = opaque_bid(); u < 512; u += gridDim.x) mix_e_mlstm(c, l, u, lds, tid, lane, wave);
    for (int rq = 0; rq < (((REP_MASK) >> 19) & 1 ? 2 : 1); ++rq) for (int u = opaque_bid(); u < 256; u += gridDim.x) mix_e_rg(c, l, u, lane, wave);
}
#ifndef TAILH
#define TAILH 0
#endif
#ifndef MOE_MERGE
#define MOE_MERGE 0
#endif
#ifndef FOLD
#define FOLD 0
#endif
#ifndef SP2_E
#define SP2_E true
#endif
#ifndef ALIGN_E
#define ALIGN_E true
#endif
#ifndef STAG
#define STAG 0
#endif
#ifndef NULL_EPI
#define NULL_EPI 0
#endif
#ifndef REP_MASK
#define REP_MASK 0
#endif
#ifndef ONE_LAUNCH
#define ONE_LAUNCH 1
#endif
__device__ __forceinline__ void load_texp_lds(const int* meta, LAS unsigned char* lds) {
    int t = threadIdx.x; asm volatile("" : "+v"(t));
    LAS int* tl = (LAS int*)(lds + RS_OFF); if (t < MAXT256) tl[t] = meta[32 + t]; __syncthreads();
}
__global__ void __launch_bounds__(NTHR, 2) mega(Ctx c) {
    extern __shared__ __attribute__((aligned(16))) unsigned char lds_raw[];
    LAS unsigned char* lds = (LAS unsigned char*)lds_raw;
    const int tid = threadIdx.x;
    if (tid < 64) ((LAS unsigned*)(lds + MISC_OFF))[tid] = 0u;
    __syncthreads();
    XcdBarrier bar; bar.bar = (unsigned*)(c.ws + WS_CTL) + CW_BAR; bar.x = 0; bar.st = (volatile LAS unsigned*)(lds + MISC_OFF + 32);
    if (c.s_hi - c.s_lo > 1) bar = xcd_barrier_post((unsigned*)(c.ws + WS_CTL) + CW_BAR, (volatile LAS unsigned*)(lds + MISC_OFF + 32));
#define BG_TAIL(S, unit_us) do { if (BG_ON) { const int nmax_ = (S.nwg + S.G - 1) / S.G, nc_ = S.c < S.nwg ? (S.nwg - S.c + S.G - 1) / S.G : 0; \
        if (nc_ < nmax_) bg_cvt(c, lds, t_ph + (unsigned long long)((nmax_ * (unit_us) * 92) - 300)); } } while (0)
#define STEP_ON(s) (c.s_lo <= (s) && (s) < c.s_hi)
#define REPN(id) ((((REP_MASK) >> (id)) & 1) ? 2 : 1)
#define RP(id) for (int rr = 0; rr < REPN(id); ++rr)
#define SEAM(s) do { if ((s) + 1 < c.s_hi) { RP(15) xcd_barrier(bar); } } while (0)
    if (STEP_ON(0)) { RP(0) cvt_phase(c, lds); SEAM(0); }
    for (int l = 0; l < DEPTH; ++l) {
        const int s0 = 1 + 10 * l; const bool moe = (l & 1) != 0; const int jl = l >> 1;
        if (s0 + 9 < c.s_lo || s0 >= c.s_hi) continue;
        const bool fold_in = FOLD && moe;
        if (!fold_in && STEP_ON(s0 + 0)) { RP(1) norm_phase<1>(c, l, l == 2 && rr == 0, lds); SEAM(s0 + 0); }
        if (STEP_ON(s0 + 1)) {
            pg8::Gemm g{(const bf16*)(c.ws + WS_XN), (const bf16*)(c.ws + WS_WIN) + (size_t)l * NZ * D, T, NZ, D, D, STAG}; pg8::StaticOrder S; S.init(T, NZ, gridDim.x, opaque_bid());
            if (fold_in) prep_rstd(S, (const float*)(c.ws + WS_SSQ), lds);
            RP(2) { if (fold_in) { pg8::EpiBf16T<true> E{(bf16*)(c.ws + WS_Z), NZ, 0, (const LAS float*)(lds + RS_OFF)}; pg8::gemm_phase<pg8::EpiBf16T<true>, pg8::StaticOrder, ALIGN_E, SP2_E>(lds, g, S, E); }
                    else { pg8::EpiBf16 E{(bf16*)(c.ws + WS_Z), NZ, 0, nullptr}; pg8::gemm_phase<pg8::EpiBf16, pg8::StaticOrder, ALIGN_E, SP2_E>(lds, g, S, E); } }
            if (fold_in) { RP(1) gate_job(c, l, lds); } SEAM(s0 + 1); }
        if (STEP_ON(s0 + 2)) { RP(3) mix_c_phase(c, l, lds); SEAM(s0 + 2); }
        if (STEP_ON(s0 + 3)) { RP(4) mix_d_phase(c, lds); SEAM(s0 + 3); }
        if (STEP_ON(s0 + 4)) { RP(5) mix_e_phase(c, l, lds); SEAM(s0 + 4); }
        if (STEP_ON(s0 + 5)) {
            pg8::Gemm g{(const bf16*)(c.ws + WS_Y), (const bf16*)(c.ws + WS_WOUT) + (size_t)l * D * D, T, D, D, D, 0}; pg8::StaticOrder S; S.init(T, D, gridDim.x, opaque_bid());
            RP(6) { const bool fo = FOLD && !moe && !rr;
            if (FOLD && fo) { pg8::EpiResF16T<FOLD != 0> E{(l == 0 && !rr) ? c.in[IN_X] : nullptr, (_Float16*)(c.ws + WS_H), D, (bf16*)(c.ws + WS_XN), c.in[IN_NORM_FFN_G] + l * D, (float*)(c.ws + WS_SSQ)}; pg8::gemm_phase<pg8::EpiResF16T<FOLD != 0>, pg8::StaticOrder, ALIGN_E, SP2_E>(lds, g, S, E); }
            else { pg8::EpiResF16 E{(l == 0 && !rr) ? c.in[IN_X] : nullptr, rr ? (_Float16*)(c.ws + WS_SCR) : (_Float16*)(c.ws + WS_H), D, nullptr, nullptr, nullptr}; pg8::gemm_phase<pg8::EpiResF16, pg8::StaticOrder, ALIGN_E, SP2_E>(lds, g, S, E); } } SEAM(s0 + 5); }
        if (!moe) {
            if (!FOLD && STEP_ON(s0 + 6)) { RP(7) norm_phase<0>(c, l, false, lds); SEAM(s0 + 6); }
            if (STEP_ON(s0 + 7)) {
                pg8::Gemm g{(const bf16*)(c.ws + WS_XN), (const bf16*)(c.ws + WS_WGU) + (size_t)jl * 2 * FFD * D, T, 2 * FFD, D, D, STAG}; pg8::StaticOrder S; S.init(T, 2 * FFD, gridDim.x, opaque_bid());
                if (FOLD) prep_rstd(S, (const float*)(c.ws + WS_SSQ), lds);
                pg8::EpiSwigluT<FOLD != 0> E{(bf16*)(c.ws + WS_HID), FFD, (const LAS float*)(lds + RS_OFF)};
                const int Lw = TAILH ? (S.nwg / S.G) * S.G : S.nwg; S.L1 = Lw;
                RP(8) pg8::gemm_phase<pg8::EpiSwigluT<FOLD != 0>, pg8::StaticOrder, ALIGN_E, SP2_E>(lds, g, S, E);
                if (TAILH && Lw < S.nwg) { pg8::StaticOrder S2 = S; S2.L0 = Lw; S2.L1 = S.nwg; S2.halves = 1;
                    pg8::EpiSwigluT<false, false, true> E2{(bf16*)(c.ws + WS_HID), FFD, nullptr, 0};
                    pg8::gemm_phase<pg8::EpiSwigluT<false, false, true>, pg8::StaticOrder, ALIGN_E, SP2_E, true>(lds, g, S2, E2); }
                SEAM(s0 + 7); }
            if (STEP_ON(s0 + 8)) {
                pg8::Gemm g{(const bf16*)(c.ws + WS_HID), (const bf16*)(c.ws + WS_WD) + (size_t)jl * D * FFD, T, D, FFD, FFD, 0}; pg8::StaticOrder S; S.init(T, D, gridDim.x, opaque_bid());
                RP(9) { const bool fo = FOLD && !rr;
                if (FOLD && fo) { pg8::EpiResF16T<FOLD != 0> E{nullptr, (_Float16*)(c.ws + WS_H), D, (bf16*)(c.ws + WS_XN), c.in[IN_NORM_MIX_G] + (l + 1) * D, (float*)(c.ws + WS_SSQ)}; pg8::gemm_phase<pg8::EpiResF16T<FOLD != 0>, pg8::StaticOrder, ALIGN_E, SP2_E>(lds, g, S, E); }
                else { pg8::EpiResF16 E{nullptr, rr ? (_Float16*)(c.ws + WS_SCR) : (_Float16*)(c.ws + WS_H), D, nullptr, nullptr, nullptr}; pg8::gemm_phase<pg8::EpiResF16, pg8::StaticOrder, ALIGN_E, SP2_E>(lds, g, S, E); } } SEAM(s0 + 8); }
        } else {
            if (STEP_ON(s0 + 6)) { RP(7) norm_phase<2>(c, l, false, lds); SEAM(s0 + 6); }
            if (STEP_ON(s0 + 7)) { RP(10) moe_gather_phase(c, lds); if (l == 3) { __syncthreads(); bg_cvt(c, lds, ~0ull); } SEAM(s0 + 7); }
#if MOE_MERGE
            if (STEP_ON(s0 + 8)) {
                const int* meta = (const int*)(c.ws + WS_META); const int nM = __builtin_amdgcn_readfirstlane(meta[16]);
                unsigned* ctl = (unsigned*)(c.ws + WS_CTL); unsigned* pcnt = ctl + CW_MOECNT + jl * MAXT256 * 64;
                load_texp_lds(meta, lds);
                const int G = gridDim.x, cb = opaque_bid();
                { pg8::Gemm g{(const bf16*)(c.ws + WS_XG), (const bf16*)(c.ws + WS_MWGU) + (size_t)jl * NE * 2 * FFE * D, nM * 256, 2 * FFE, D, D, 0};
                  pg8::MoeOrderPub S; S.init(nM, 2 * FFE, 1, G, cb, (const LAS int*)(lds + RS_OFF)); S.cnt = pcnt; S.prev_pm = -1;
                  pg8::EpiSwigluT<false, true> E{(bf16*)(c.ws + WS_MHID), FFE, nullptr, (int)((size_t)MAXROWS * FFE * 2)};
                  pg8::gemm_phase<pg8::EpiSwigluT<false, true>, pg8::MoeOrderPub, ALIGN_E, SP2_E>(lds, g, S, E); S.flush(); }
                { const int nwg_gu = nM * (2 * FFE / 256), ex = nwg_gu % G, exr = (ex + 7) & ~7; const int c2 = (cb - exr + 2 * G) % G;
                  pg8::Gemm g{(const bf16*)(c.ws + WS_MHID), (const bf16*)(c.ws + WS_MWD) + (size_t)jl * NE * D * FFE, nM * 256, D, FFE / MOE_KS, FFE, 0};
                  pg8::MoeOrderWait S; S.init(nM, D, MOE_KS, G, c2, (const LAS int*)(lds + RS_OFF)); S.cnt = pcnt; S.need = (unsigned)(2 * FFE / 256) * 8u; S.tmo = ctl;
                  pg8::EpiBf16 E{(bf16*)(c.ws + WS_XG), D, (size_t)(WS_Y1 - WS_XG) / 2, nullptr};
                  pg8::gemm_phase<pg8::EpiBf16, pg8::MoeOrderWait, ALIGN_E, SP2_E>(lds, g, S, E); }
                SEAM(s0 + 9); }
#else
            if (STEP_ON(s0 + 8)) {
                const int* meta = (const int*)(c.ws + WS_META); const int nM = __builtin_amdgcn_readfirstlane(meta[16]);
                load_texp_lds(meta, lds);
                pg8::Gemm g{(const bf16*)(c.ws + WS_XG), (const bf16*)(c.ws + WS_MWGU) + (size_t)jl * NE * 2 * FFE * D, nM * 256, 2 * FFE, D, D, 0}; pg8::MoeOrder S; S.init(nM, 2 * FFE, 1, gridDim.x, opaque_bid(), (const LAS int*)(lds + RS_OFF));
                pg8::EpiSwiglu E{(bf16*)(c.ws + WS_MHID), FFE, nullptr, 0};
                const int Lw = TAILH ? (S.nwg / S.G) * S.G : S.nwg; S.L1 = Lw;
                RP(11) pg8::gemm_phase<pg8::EpiSwiglu, pg8::MoeOrder, ALIGN_E, SP2_E>(lds, g, S, E);
                if (TAILH && Lw < S.nwg) { pg8::MoeOrder S2 = S; S2.L0 = Lw; S2.L1 = S.nwg; S2.halves = 1;
                    pg8::EpiSwigluT<false, false, true> E2{(bf16*)(c.ws + WS_MHID), FFE, nullptr, 0};
                    pg8::gemm_phase<pg8::EpiSwigluT<false, false, true>, pg8::MoeOrder, ALIGN_E, SP2_E, true>(lds, g, S2, E2); }
                SEAM(s0 + 8); }
            if (STEP_ON(s0 + 9)) {
                const int* meta = (const int*)(c.ws + WS_META); const int nM = __builtin_amdgcn_readfirstlane(meta[16]);
                load_texp_lds(meta, lds);
                const int nFull = nM < MOE_FULL ? nM : MOE_FULL;
                {
                    pg8::Gemm g{(const bf16*)(c.ws + WS_MHID), (const bf16*)(c.ws + WS_MWD) + (size_t)jl * NE * D * FFE, nFull * 256, D, FFE, FFE, 0}; pg8::MoeOrder S; S.init(nFull, D, 1, gridDim.x, opaque_bid(), (const LAS int*)(lds + RS_OFF));
                    pg8::EpiBf16 E{(bf16*)(c.ws + WS_XG), D, 0, nullptr};
                    RP(12) pg8::gemm_phase<pg8::EpiBf16, pg8::MoeOrder, ALIGN_E, SP2_E>(lds, g, S, E); }
                if (nM > MOE_FULL) {
                    pg8::Gemm g{(const bf16*)(c.ws + WS_MHID), (const bf16*)(c.ws + WS_MWD) + (size_t)jl * NE * D * FFE, (nM - MOE_FULL) * 256, D, FFE / MOE_TS, FFE, 0}; pg8::MoeOrder S; S.init(nM - MOE_FULL, D, MOE_TS, gridDim.x, opaque_bid(), (const LAS int*)(lds + RS_OFF)); S.pm0 = MOE_FULL;
                    pg8::EpiBf16 E{(bf16*)(c.ws + WS_Y1) - (size_t)MOE_FULL * 256 * D, D, (size_t)8 * 256 * D, nullptr};
                    pg8::gemm_phase<pg8::EpiBf16, pg8::MoeOrder, ALIGN_E, SP2_E>(lds, g, S, E); }
                SEAM(s0 + 9); }
#endif
        }
    }
    if (STEP_ON(41)) { RP(13) norm_phase<3>(c, 0, true, lds); }
}

namespace nv {
__global__ __launch_bounds__(256) void mlstm_rec(const bf16* __restrict__ z, const float* __restrict__ ifp, float* __restrict__ ht) {
    const int wave = (blockIdx.x * 256 + threadIdx.x) >> 6, lane = threadIdx.x & 63;
    const int bh = wave >> 5, es = wave & 31, b = bh >> 2, h = bh & 3, e0 = es * 4;
    float C[2][4] = {}, n[2] = {0.f, 0.f};
    const float ksc = 0.08838834764831845f;
    for (int t0 = 0; t0 < SEQ; t0 += 8) {
        float kk[8][2], qq[8][2], vv[8][4], ii[8], ff[8];
#pragma unroll
        for (int j = 0; j < 8; ++j) { const size_t t = (size_t)(b * SEQ + t0 + j); const bf16* row = z + t * NZ;
            kk[j][0] = bf2f(row[ZK + h * DH + lane]) * ksc; kk[j][1] = bf2f(row[ZK + h * DH + lane + 64]) * ksc; qq[j][0] = bf2f(row[ZQ + h * DH + lane]); qq[j][1] = bf2f(row[ZQ + h * DH + lane + 64]);
#pragma unroll
            for (int e = 0; e < 4; ++e) vv[j][e] = bf2f(row[ZV + h * DH + e0 + e]);
            ii[j] = __expf(ifp[t * 8 + h]); ff[j] = sigmoidf_(ifp[t * 8 + 4 + h]); }
#pragma unroll
        for (int j = 0; j < 8; ++j) { float s[5] = {0.f, 0.f, 0.f, 0.f, 0.f};
#pragma unroll
            for (int d = 0; d < 2; ++d) { n[d] = ff[j] * n[d] + ii[j] * kk[j][d]; s[4] += n[d] * qq[j][d];
#pragma unroll
                for (int e = 0; e < 4; ++e) { C[d][e] = ff[j] * C[d][e] + ii[j] * kk[j][d] * vv[j][e]; s[e] += C[d][e] * qq[j][d]; } }
#pragma unroll
            for (int e = 0; e < 5; ++e) s[e] = wave_sum(s[e]);
            const float den = fmaxf(fabsf(s[4]), 1.f);
            if (lane == 0) { float* o = ht + (size_t)(b * SEQ + t0 + j) * MLW + h * DH + e0; o[0] = s[0] / den; o[1] = s[1] / den; o[2] = s[2] / den; o[3] = s[3] / den; } }
    }
}
__global__ __launch_bounds__(256) void ml_out(const bf16* __restrict__ z, const float* __restrict__ ht, const float* __restrict__ g, bf16* __restrict__ y) {
    const int w = (blockIdx.x * 256 + threadIdx.x) >> 6, lane = threadIdx.x & 63, t = w >> 2, h = w & 3;
    const float a = ht[(size_t)t * MLW + h * DH + lane], b = ht[(size_t)t * MLW + h * DH + lane + 64];
    const float r = rsqrtf(wave_sum(a * a + b * b) * (1.f / DH) + EPS);
    const float oa = bf2f(z[(size_t)t * NZ + ZO + h * DH + lane]), ob = bf2f(z[(size_t)t * NZ + ZO + h * DH + lane + 64]);
    y[(size_t)t * D + h * DH + lane] = f2bf(sigmoidf_(oa) * a * r * g[h * DH + lane]); y[(size_t)t * D + h * DH + lane + 64] = f2bf(sigmoidf_(ob) * b * r * g[h * DH + lane + 64]);
}
__global__ __launch_bounds__(512) void rg_gates(const bf16* __restrict__ z, const float* __restrict__ cw, const float* __restrict__ cb, const float* __restrict__ wa, const float* __restrict__ ba,
                                                const float* __restrict__ wx, const float* __restrict__ bx, const float* __restrict__ lam, float* __restrict__ av, float* __restrict__ uv) {
    __shared__ float xs[RGW]; const int t = blockIdx.x, c = threadIdx.x, tl = t % SEQ;
    float xc = cb[c];
#pragma unroll
    for (int j = 0; j < 4; ++j) { const int tt = tl - 3 + j; if (tt >= 0) xc += cw[j * RGW + c] * bf2f(z[(size_t)(t - 3 + j) * NZ + ZRX + c]); }
    xs[c] = xc; __syncthreads();
    const int g = c >> 6, jj = c & 63; float ra = ba[c], rx = bx[c];
    for (int i = 0; i < RGD; ++i) { const float xv = xs[g * RGD + i]; ra += xv * wa[(g * RGD + i) * RGD + jj]; rx += xv * wx[(g * RGD + i) * RGD + jj]; }
    const float r = sigmoidf_(ra), ig = sigmoidf_(rx);
    const float sp = log1pf(__expf(-lam[c])); const float la = -8.f * r * sp;
    av[(size_t)t * RGW + c] = __expf(la); uv[(size_t)t * RGW + c] = sqrtf(-expm1f(2.f * la)) * (ig * xc);
}
__global__ __launch_bounds__(256) void rg_scan(const float* __restrict__ av, float* __restrict__ uv) {
    const int id = blockIdx.x * 256 + threadIdx.x, b = id / RGW, c = id % RGW; float h = 0.f;
    for (int t0 = 0; t0 < SEQ; t0 += 8) { float a[8], u[8];
#pragma unroll
        for (int j = 0; j < 8; ++j) { a[j] = av[(size_t)(b * SEQ + t0 + j) * RGW + c]; u[j] = uv[(size_t)(b * SEQ + t0 + j) * RGW + c]; }
#pragma unroll
        for (int j = 0; j < 8; ++j) { h = a[j] * h + u[j]; uv[(size_t)(b * SEQ + t0 + j) * RGW + c] = h; } }
}
__global__ __launch_bounds__(256) void rg_out(const bf16* __restrict__ z, const float* __restrict__ hr, const float* __restrict__ g, bf16* __restrict__ y) {
    const int t = (blockIdx.x * 256 + threadIdx.x) >> 6, lane = threadIdx.x & 63; float v[8]; float s = 0.f;
#pragma unroll
    for (int j = 0; j < 8; ++j) { const int c = lane + 64 * j; v[j] = hr[(size_t)t * RGW + c] * gelu_tanh(bf2f(z[(size_t)t * NZ + ZRG + c])); s += v[j] * v[j]; }
    const float r = rsqrtf(wave_sum(s) * (1.f / RGW) + EPS);
#pragma unroll
    for (int j = 0; j < 8; ++j) { const int c = lane + 64 * j; y[(size_t)t * D + MLW + c] = f2bf(v[j] * r * g[c]); }
}
}

extern "C" void kernel_launch(void* const* d_in, const int* in_sizes, int n_in, void* d_out, int out_size, void* d_ws, size_t ws_size, hipStream_t stream) {
    static int ok = 0; static int grid_g = 256;
    if (ok == 0) {
        if (n_in != 23 || ws_size < WS_END || out_size != T * D) { fprintf(stderr, "kernel_launch: unexpected shapes (n_in %d, ws %zu, out %d)\n", n_in, ws_size, out_size); ok = -1; return; }
        if (hipFuncSetAttribute((const void*)mega, hipFuncAttributeMaxDynamicSharedMemorySize, LDS_BYTES) != hipSuccess) { fprintf(stderr, "kernel_launch: hipFuncSetAttribute failed\n"); ok = -1; return; }
        int dev = 0, cus = 0, per_cu = 0; (void)hipGetDevice(&dev); (void)hipDeviceGetAttribute(&cus, hipDeviceAttributeMultiprocessorCount, dev);
        if (hipOccupancyMaxActiveBlocksPerMultiprocessor(&per_cu, (const void*)mega, NTHR, LDS_BYTES) != hipSuccess || per_cu < 1) { fprintf(stderr, "kernel_launch: occupancy query says %d blocks per CU\n", per_cu); (void)hipGetLastError(); }
        grid_g = cus > 0 ? cus : 256;
        ok = 1;
    }
    if (ok < 0) return;
    unsigned char* ws = (unsigned char*)d_ws;
    (void)hipMemsetAsync(ws + WS_CTL, 0, MOE_MERGE ? (size_t)(1 * MiB) : (size_t)(CW_BAR + XCD_BAR_WORDS) * 4, stream);
    Ctx base{}; for (int i = 0; i < 23; ++i) base.in[i] = (const float*)d_in[i]; base.out = (float*)d_out; base.ws = ws;
    auto run = [&](int lo, int hi) { Ctx a = base; a.s_lo = lo; a.s_hi = hi; hipLaunchKernelGGL(mega, dim3(grid_g), dim3(NTHR), LDS_BYTES, stream, a); };
    const bf16* z = (const bf16*)(ws + WS_Z); bf16* y = (bf16*)(ws + WS_Y); const float* ifp = (const float*)(ws + WS_IFP);
    float* ht = (float*)(ws + WS_CTL_LOC); float* ra = (float*)(ws + WS_RA); float* ru = (float*)(ws + WS_RU);
#if ONE_LAUNCH
    run(0, 42);
#else
    run(0, 1);
    for (int l = 0; l < DEPTH; ++l) {
        const int s0 = 1 + 10 * l;
        run(s0, s0 + 1); run(s0 + 1, s0 + 2);
#if MIX_FAST
        run(s0 + 2, s0 + 3); run(s0 + 3, s0 + 4); run(s0 + 4, s0 + 5);
#endif
#if !MIX_FAST || NV_ML
        nv::mlstm_rec<<<128, 256, 0, stream>>>(z, ifp, ht);
        nv::ml_out<<<T, 256, 0, stream>>>(z, ht, (const float*)d_in[IN_ML_NORM_G] + l * MLW, y);
#endif
#if !MIX_FAST || NV_RG
        nv::rg_gates<<<T, 512, 0, stream>>>(z, (const float*)d_in[IN_CONV_W] + l * 4 * RGW, (const float*)d_in[IN_CONV_B] + l * RGW, (const float*)d_in[IN_RG_W_A] + (size_t)l * RGB * RGD * RGD,
                                            (const float*)d_in[IN_RG_B_A] + l * RGW, (const float*)d_in[IN_RG_W_X] + (size_t)l * RGB * RGD * RGD, (const float*)d_in[IN_RG_B_X] + l * RGW, (const float*)d_in[IN_RG_LAM] + l * RGW, ra, ru);
        nv::rg_scan<<<BATCH * RGW / 256, 256, 0, stream>>>(ra, ru);
        nv::rg_out<<<T / 4, 256, 0, stream>>>(z, ru, (const float*)d_in[IN_RG_NORM_G] + l * RGW, y);
#endif
        run(s0 + 5, s0 + 6); run(s0 + 6, s0 + 7); run(s0 + 7, s0 + 8); run(s0 + 8, s0 + 9);
        if (l & 1) run(s0 + 9, s0 + 10);
    }
    run(41, 42);
#endif
}
```
